# Optimizing an MI355X kernel written in HIP

```python
import math
import jax, jax.numpy as jnp
from jax import lax
import numpy as np

D_MODEL = 1024
BATCH = 16
SEQ = 4096
DEPTH = 2

RW_HEADS = 8
RW_HEAD_DIM = 64
RW_W = RW_HEADS * RW_HEAD_DIM
DECAY_LORA = 64
ICLR_LORA = 64
GATE_LORA = 128
LNX_EPS = 64e-5
RW_COLS = 3 * RW_W + DECAY_LORA + ICLR_LORA + GATE_LORA
POOL_GROUPS = 4
POOL_W = 512
POOL_GW = POOL_W // POOL_GROUPS
POOL_WINDOWS = (2, 4, 8, 16)
POOL_MAXW = 16
CONV_W = 512
CONV_K = 3
ATT_HQ = 8
ATT_HKV = 2
ATT_G = ATT_HQ // ATT_HKV
ATT_HD = 64
ATT_WINDOW = 128
ATT_BLOCK = 128
ROPE_THETA = 10000.0
ATT_COLS = (ATT_HQ + 2 * ATT_HKV) * ATT_HD
N_BRANCH = 4
GATE_COLS = N_BRANCH * D_MODEL
IN_COLS = RW_COLS + POOL_W + 3 * CONV_W + ATT_COLS + GATE_COLS
IN_SPLITS = (RW_COLS, RW_COLS + POOL_W, RW_COLS + POOL_W + 3 * CONV_W, RW_COLS + POOL_W + 3 * CONV_W + ATT_COLS)
D_FF = ((8 * D_MODEL // 3 + 255) // 256) * 256
NORM_EPS = 1e-6

kernel_name = 'hybrid_gated_parallel_block'


def rms_norm(x, g):
    xf = x.astype(jnp.float32)
    y = xf * lax.rsqrt(jnp.mean(xf * xf, axis=-1, keepdims=True) + NORM_EPS)
    return (y * g.astype(jnp.float32)).astype(x.dtype)


def token_shift(u):
    return jnp.pad(u, ((0, 0), (1, 0), (0, 0)))[:, :-1]


def wkv7_scan(r, decay, k, v, kk, a):
    b, s, h, n = r.shape

    def step(state, inp):
        r_t, w_t, k_t, v_t, kk_t, a_t = inp
        s_kk = jnp.einsum('bhij,bhj->bhi', state, kk_t)
        state = (state * w_t[:, :, None, :]
                 - s_kk[..., None] * (kk_t * a_t)[:, :, None, :]
                 + v_t[..., None] * k_t[:, :, None, :])
        y_t = jnp.einsum('bhij,bhj->bhi', state, r_t)
        return state, y_t

    xs = tuple(jnp.moveaxis(t, 1, 0) for t in (r, decay, k, v, kk, a))
    state0 = jnp.zeros((b, h, n, n), jnp.float32)
    _, ys = lax.scan(step, state0, xs)
    return jnp.moveaxis(ys, 0, 1)


def rwkv7_mixer(p, mu, w_decay_up, w0, a_up, a0, g_up, k_k, k_a, r_k, lnx_g, lnx_b):
    dt = p.dtype
    b, s, _ = p.shape
    p = p.astype(jnp.float32)
    p = p + (token_shift(p) - p) * mu.astype(jnp.float32)
    r, k, v, wd, ad, gd = jnp.split(
        p, [RW_W, 2 * RW_W, 3 * RW_W, 3 * RW_W + DECAY_LORA, 3 * RW_W + DECAY_LORA + ICLR_LORA], axis=-1)
    w = -jax.nn.softplus(-(w0 + jnp.tanh(wd) @ w_decay_up)) - 0.5
    decay = jnp.exp(-jnp.exp(w))
    a = jax.nn.sigmoid(a0 + ad @ a_up)
    g = jax.nn.sigmoid(gd) @ g_up
    heads = lambda t: t.reshape(b, s, RW_HEADS, RW_HEAD_DIM)
    kk = heads(k * k_k)
    kk = kk / jnp.maximum(jnp.sqrt(jnp.sum(kk * kk, axis=-1, keepdims=True)), 1e-12)
    k = k * (1.0 + (a - 1.0) * k_a)
    rh, kh, vh, ah = heads(r), heads(k), heads(v), heads(a)
    y = wkv7_scan(rh, heads(decay), kh, vh, kk, ah)
    mean = jnp.mean(y, axis=-1, keepdims=True)
    var = jnp.mean(jnp.square(y - mean), axis=-1, keepdims=True)
    y = ((y - mean) * lax.rsqrt(var + LNX_EPS)).reshape(b, s, RW_W) * lnx_g + lnx_b
    bonus = jnp.sum(rh * kh * r_k.astype(jnp.float32), axis=-1, keepdims=True) * vh
    y = y + bonus.reshape(b, s, RW_W)
    return (y * g).astype(dt)


def pool_mixer(u, pool_w, pool_scale):
    dt = u.dtype
    b, s, _ = u.shape
    uf = u.astype(jnp.float32)
    cs = jnp.cumsum(uf, axis=1)
    cs_pad = jnp.pad(cs, ((0, 0), (POOL_MAXW, 0), (0, 0)))
    t = jnp.arange(s)
    outs = []
    for gi, win in enumerate(POOL_WINDOWS):
        sl = slice(gi * POOL_GW, (gi + 1) * POOL_GW)
        lag = cs_pad[:, POOL_MAXW - win:POOL_MAXW - win + s, sl]
        count = jnp.minimum(t + 1, win).astype(jnp.float32)[None, :, None]
        outs.append((cs[..., sl] - lag) / count - uf[..., sl])
    z = jnp.stack(outs, axis=2)
    z = jnp.einsum('bsgc,gcd->bsgd', z, pool_w.astype(jnp.float32)).reshape(b, s, POOL_W)
    return (z * pool_scale.astype(jnp.float32)).astype(dt)


def causal_depthwise_conv(u, w):
    c = u.shape[-1]
    return lax.conv_general_dilated(
        u, w[:, None, :].astype(u.dtype), window_strides=(1,), padding=[(CONV_K - 1, 0)],
        dimension_numbers=('NWC', 'WIO', 'NWC'), feature_group_count=c)


def short_conv_mixer(p, conv_w):
    b_gate, c_gate, u = jnp.split(p, [CONV_W, 2 * CONV_W], axis=-1)
    return b_gate * causal_depthwise_conv(c_gate * u, conv_w)


def rope(x, positions):
    half = x.shape[-1] // 2
    inv = ROPE_THETA ** (-jnp.arange(half, dtype=jnp.float32) * 2.0 / x.shape[-1])
    ang = positions.astype(jnp.float32)[..., None] * inv
    cos, sin = jnp.cos(ang)[:, :, None, :], jnp.sin(ang)[:, :, None, :]
    x1, x2 = x[..., :half], x[..., half:]
    return jnp.concatenate([x1 * cos - x2 * sin, x2 * cos + x1 * sin], axis=-1)


def swa_sink_attention(p, positions, q_norm_g, k_norm_g, sinks):
    dt = p.dtype
    b, s, _ = p.shape
    q, k, v = jnp.split(p, [ATT_HQ * ATT_HD, (ATT_HQ + ATT_HKV) * ATT_HD], axis=-1)
    q = rope(rms_norm(q.reshape(b, s, ATT_HQ, ATT_HD), q_norm_g).astype(jnp.float32), positions)
    k = rope(rms_norm(k.reshape(b, s, ATT_HKV, ATT_HD), k_norm_g).astype(jnp.float32), positions)
    v = v.reshape(b, s, ATT_HKV, ATT_HD).astype(jnp.float32)
    nb = s // ATT_BLOCK
    qb = q.reshape(b, nb, ATT_BLOCK, ATT_HKV, ATT_G, ATT_HD)

    def with_prev(t):
        t = t.reshape(b, nb, ATT_BLOCK, ATT_HKV, ATT_HD)
        prev = jnp.pad(t, ((0, 0), (1, 0), (0, 0), (0, 0), (0, 0)))[:, :-1]
        return jnp.concatenate([prev, t], axis=2)

    kc, vc = with_prev(k), with_prev(v)
    scores = jnp.einsum('bnqkgd,bnjkd->bnkgqj', qb, kc) * (ATT_HD ** -0.5)
    qi = jnp.arange(ATT_BLOCK)[:, None] + ATT_BLOCK
    kj = jnp.arange(2 * ATT_BLOCK)[None, :]
    dist = qi - kj
    band = (dist >= 0) & (dist < ATT_WINDOW)
    has_prev = (jnp.arange(nb)[:, None, None] > 0) | (kj >= ATT_BLOCK)[None]
    mask = band[None] & has_prev
    scores = jnp.where(mask[None, :, None, None], scores, -jnp.inf)
    sink = sinks.astype(jnp.float32).reshape(ATT_HKV, ATT_G)[None, None, :, :, None, None]
    m = jnp.maximum(jnp.max(scores, axis=-1, keepdims=True), sink)
    e = jnp.exp(scores - m)
    probs = e / (jnp.sum(e, axis=-1, keepdims=True) + jnp.exp(sink - m))
    o = jnp.einsum('bnkgqj,bnjkd->bnqkgd', probs, vc).reshape(b, s, ATT_HQ * ATT_HD)
    return o.astype(dt)


def setup_inputs(seed: int = 0) -> dict:
    key = jax.random.key(seed)
    ks = jax.random.split(key, 32)
    f32 = jnp.float32
    nrm = lambda i, shape, scale: jax.random.normal(ks[i], shape, f32) * scale
    L = DEPTH
    x = jax.random.normal(ks[0], (BATCH, SEQ, D_MODEL), f32)
    offset = jax.random.randint(ks[1], (BATCH, 1), 0, 1024, dtype=jnp.int32)
    positions = offset + jnp.arange(SEQ, dtype=jnp.int32)[None, :]
    return {
        'x': x,
        'positions': positions,
        'norm1_g': 1.0 + nrm(2, (L, D_MODEL), 0.02),
        'w_in': nrm(3, (L, D_MODEL, IN_COLS), D_MODEL ** -0.5),
        'shift_mu': jax.random.uniform(ks[4], (L, RW_COLS), f32),
        'w_decay_up': nrm(5, (L, DECAY_LORA, RW_W), 0.1 * DECAY_LORA ** -0.5),
        'w0': jax.random.uniform(ks[6], (L, RW_W), f32, -5.0, -0.5),
        'a_up': nrm(7, (L, ICLR_LORA, RW_W), ICLR_LORA ** -0.5),
        'a0': nrm(8, (L, RW_W), 0.1),
        'g_up': nrm(9, (L, GATE_LORA, RW_W), GATE_LORA ** -0.5),
        'k_k': 0.85 + nrm(10, (L, RW_W), 0.05),
        'k_a': 1.0 + nrm(11, (L, RW_W), 0.05),
        'r_k': nrm(12, (L, RW_HEADS, RW_HEAD_DIM), 0.1),
        'lnx_g': 1.0 + nrm(13, (L, RW_W), 0.02),
        'lnx_b': nrm(14, (L, RW_W), 0.02),
        'w_rwkv_out': nrm(15, (L, RW_W, D_MODEL), RW_W ** -0.5),
        'pool_w': nrm(16, (L, POOL_GROUPS, POOL_GW, POOL_GW), POOL_GW ** -0.5),
        'pool_scale': 1.0 + nrm(17, (L, POOL_W), 0.1),
        'w_pool_out': nrm(18, (L, POOL_W, D_MODEL), POOL_W ** -0.5),
        'conv_w': nrm(19, (L, CONV_K, CONV_W), CONV_K ** -0.5),
        'w_conv_out': nrm(20, (L, CONV_W, D_MODEL), CONV_W ** -0.5),
        'q_norm_g': 1.0 + nrm(21, (L, ATT_HD), 0.02),
        'k_norm_g': 1.0 + nrm(22, (L, ATT_HD), 0.02),
        'sinks': nrm(23, (L, ATT_HQ), 1.0),
        'w_attn_out': nrm(24, (L, ATT_HQ * ATT_HD, D_MODEL), (ATT_HQ * ATT_HD) ** -0.5),
        'w_o': nrm(25, (L, D_MODEL, D_MODEL), D_MODEL ** -0.5),
        'norm2_g': 1.0 + nrm(26, (L, D_MODEL), 0.02),
        'w_ffn_gate': nrm(27, (L, D_MODEL, D_FF), D_MODEL ** -0.5),
        'w_ffn_up': nrm(28, (L, D_MODEL, D_FF), D_MODEL ** -0.5),
        'w_ffn_down': nrm(29, (L, D_FF, D_MODEL), D_FF ** -0.5),
    }


def reference(x, positions, norm1_g, w_in, shift_mu, w_decay_up, w0, a_up, a0, g_up, k_k, k_a, r_k,
              lnx_g, lnx_b, w_rwkv_out, pool_w, pool_scale, w_pool_out, conv_w, w_conv_out,
              q_norm_g, k_norm_g, sinks, w_attn_out, w_o, norm2_g, w_ffn_gate, w_ffn_up, w_ffn_down):
    b, s, d = x.shape
    for i in range(DEPTH):
        h = rms_norm(x, norm1_g[i])
        p = h @ w_in[i]
        p_rw, p_pool, p_conv, p_att, p_gate = jnp.split(p, IN_SPLITS, axis=-1)
        y_a = rwkv7_mixer(p_rw, shift_mu[i], w_decay_up[i], w0[i], a_up[i], a0[i], g_up[i],
                          k_k[i], k_a[i], r_k[i], lnx_g[i], lnx_b[i]) @ w_rwkv_out[i]
        y_b = pool_mixer(p_pool, pool_w[i], pool_scale[i]) @ w_pool_out[i]
        y_c = short_conv_mixer(p_conv, conv_w[i]) @ w_conv_out[i]
        y_d = swa_sink_attention(p_att, positions, q_norm_g[i], k_norm_g[i], sinks[i]) @ w_attn_out[i]
        gates = jax.nn.sigmoid(p_gate.astype(jnp.float32)).reshape(b, s, N_BRANCH, d).astype(x.dtype)
        mixed = (gates[:, :, 0] * y_a + gates[:, :, 1] * y_b
                 + gates[:, :, 2] * y_c + gates[:, :, 3] * y_d)
        x = x + mixed @ w_o[i]
        h = rms_norm(x, norm2_g[i])
        x = x + (jax.nn.silu(h @ w_ffn_gate[i]) * (h @ w_ffn_up[i])) @ w_ffn_down[i]
    return x
```

```cpp
#include <hip/hip_runtime.h>
#include <hip/hip_cooperative_groups.h>
#include <cstdio>
#include <cstdint>
namespace cg = cooperative_groups;
#define MULTI_LAUNCH 1

#define LAS __attribute__((address_space(3)))
typedef unsigned short bf16_t;
typedef short bf16x8 __attribute__((ext_vector_type(8)));
typedef float f32x4 __attribute__((ext_vector_type(4)));
typedef float f32x2 __attribute__((ext_vector_type(2)));
typedef unsigned u32x4 __attribute__((ext_vector_type(4)));
typedef unsigned u32x2 __attribute__((ext_vector_type(2)));

constexpr int MTOK = 65536, SEQ = 4096, DM = 1024, NL = 2;
constexpr int RWC = 1792, INC = 8704, DFF = 2816;
constexpr int NTHR = 512;
constexpr size_t MiB = 1u << 20;
constexpr size_t OW_IN = 0, OW_LORA = 8912896, OW_BR = OW_LORA + 393216, OW_O = OW_BR + 2097152, OW_GU = OW_O + 1048576, OW_D = OW_GU + 5767168, LW_ELEMS = OW_D + 2883584;
constexpr size_t WS_W = 0, WS_BONUS = 82 * MiB, WS_ROPE = 84 * MiB, WS_H = 92 * MiB, WS_M3 = 220 * MiB, WS_PRW = 412 * MiB, WS_PPOOL = 636 * MiB,
                 WS_PCONV = 700 * MiB, WS_PATT = 892 * MiB, WS_ALORA = 988 * MiB, WS_END = 1020 * MiB;
constexpr size_t WS_LORA = 636 * MiB, WS_YRAW = 828 * MiB, WS_MA = 892 * MiB, WS_GSCR = 956 * MiB, WS_MIXED = 412 * MiB, WS_ACT = 220 * MiB;
static_assert(2 * LW_ELEMS * 2 <= WS_BONUS, "weights fit");
constexpr int LDS_BYTES = 147456;

struct Params { const void* in[30]; float* out; unsigned char* ws; int ph_lo, ph_hi; };

__device__ __forceinline__ unsigned cvt_pk_bf16(float lo, float hi) { unsigned r; asm volatile("v_cvt_pk_bf16_f32 %0, %1, %2" : "=v"(r) : "v"(lo), "v"(hi)); return r; }
__device__ __forceinline__ void unpack8(const u32x4 w, float (&f)[8]) {
    f[0] = __uint_as_float(w.x << 16); f[1] = __uint_as_float(w.x & 0xffff0000u); f[2] = __uint_as_float(w.y << 16); f[3] = __uint_as_float(w.y & 0xffff0000u);
    f[4] = __uint_as_float(w.z << 16); f[5] = __uint_as_float(w.z & 0xffff0000u); f[6] = __uint_as_float(w.w << 16); f[7] = __uint_as_float(w.w & 0xffff0000u);
}
__device__ __forceinline__ u32x4 pack8(const float (&f)[8]) { u32x4 w; w.x = cvt_pk_bf16(f[0], f[1]); w.y = cvt_pk_bf16(f[2], f[3]); w.z = cvt_pk_bf16(f[4], f[5]); w.w = cvt_pk_bf16(f[6], f[7]); return w; }
__device__ __forceinline__ u32x4 ld16(const bf16_t* p) { return *(const u32x4*)p; }
__device__ __forceinline__ void ld8f(const float* p, float (&f)[8]) { const f32x4 a = *(const f32x4*)p, b = *(const f32x4*)(p + 4); f[0] = a.x; f[1] = a.y; f[2] = a.z; f[3] = a.w; f[4] = b.x; f[5] = b.y; f[6] = b.z; f[7] = b.w; }
__device__ __forceinline__ float sigmoidf_(float x) { return 1.0f / (1.0f + __expf(-x)); }
__device__ __forceinline__ int tid_() { int t = threadIdx.x; asm volatile("" : "+v"(t)); return t; }
__device__ __forceinline__ int bid_() { int b = blockIdx.x; asm volatile("" : "+s"(b)); return b; }
__device__ __forceinline__ float dpp_sum8(float v) {
    v += __builtin_bit_cast(float, __builtin_amdgcn_mov_dpp(__builtin_bit_cast(int, v), 0xB1, 0xF, 0xF, true));
    v += __builtin_bit_cast(float, __builtin_amdgcn_mov_dpp(__builtin_bit_cast(int, v), 0x4E, 0xF, 0xF, true));
    v += __builtin_bit_cast(float, __builtin_amdgcn_mov_dpp(__builtin_bit_cast(int, v), 0x141, 0xF, 0xF, true));
    return v;
}

namespace pg {
constexpr int BM = 256, BK = 64, HALF = 128, HTB = HALF * BK * 2, NXCD = 8, WGM = 8;
__device__ __forceinline__ int lds_byte(int r, int c) { const int st = (r >> 4) * 2 + (c >> 5), rr = r & 15, cc = c & 31, ob = rr * 64 + cc * 2; return st * 1024 + (ob ^ (((ob >> 9) & 1) << 5)); }
__device__ __forceinline__ void stage_rc(int b, int& R, int& C) { const int st = b / 1024, sb = b % 1024, swz = sb ^ (((sb >> 9) & 1) << 5); R = (st >> 1) * 16 + swz / 64; C = (st & 1) * 32 + (swz % 64) / 2; }
__device__ __forceinline__ int perm32(int rho) { const int n = rho >> 4, i = rho & 15; return 8 * (i >> 2) + 4 * n + (i & 3); }

struct GUnit { const char* A; const char* B; unsigned lda2, ldb2; int nt, pm, pn, aux; };

__device__ __forceinline__ bool tile_order(int i, int G, int c, int nM, int nN, int& pm, int& pn) {
    const int nwg = nM * nN; const long L = (long)i * G + c; if (L >= nwg) return false;
    int wgid = (int)L; { const int q = nwg / NXCD, r = nwg % NXCD, xcd = wgid % NXCD, off = wgid / NXCD; wgid = (xcd < r ? xcd * (q + 1) : r * (q + 1) + (xcd - r) * q) + off; }
    const int nig = WGM * nN, gid = wgid / nig, fm = gid * WGM, gsz = (nM - fm) < WGM ? (nM - fm) : WGM;
    pm = fm + ((wgid % nig) % gsz); pn = (wgid % nig) / gsz; return true;
}
struct DenseSched {
    const char* A; const char* B; unsigned lda2, ldb2; int nt, nM, nN, G, c;
    __device__ __forceinline__ bool next(int i, GUnit& u) const {
        int pm, pn; if (!tile_order(i, G, c, nM, nN, pm, pn)) return false;
        u.A = A + (size_t)pm * 256 * lda2; u.B = B + (size_t)pn * 256 * ldb2; u.lda2 = lda2; u.ldb2 = ldb2; u.nt = nt; u.pm = pm; u.pn = pn; u.aux = 0; return true;
    }
};
struct BRSched {
    const char* H; const char* WIN; const char* MA; const char* M3; const char* WBR; int G, c;
    __device__ __forceinline__ bool next(int i, GUnit& u) const {
        int pm, pn; if (!tile_order(i >> 3, G, c, 256, 4, pm, pn)) return false;
        const int sub = i & 7, b = sub >> 1;
        if ((sub & 1) == 0) { u.A = H + (size_t)pm * 256 * 2048; u.lda2 = 2048; u.B = WIN + (size_t)(4608 + b * 1024 + pn * 256) * 2048; u.ldb2 = 2048; u.nt = 16; }
        else { if (b == 0) { u.A = MA + (size_t)pm * 256 * 1024; u.lda2 = 1024; } else { u.A = M3 + (size_t)(b - 1) * 1024 + (size_t)pm * 256 * 3072; u.lda2 = 3072; }
               u.B = WBR + (size_t)b * (1024 * 512 * 2) + (size_t)pn * 256 * 1024; u.ldb2 = 1024; u.nt = 8; }
        u.pm = pm; u.pn = pn; u.aux = sub; return true;
    }
};

template <class Epi, class Sched>
__device__ __forceinline__ void gemm_phase(LAS unsigned char* lds, const Sched& S, const Epi& E) {
    const int tid = tid_(), wid = __builtin_amdgcn_readfirstlane(tid >> 6), lane = tid & 63, wr = wid >> 2, wc = wid & 3, fr = lane & 15, fq = lane >> 4;
    const size_t kstep = (size_t)(BK * 2);
    const unsigned ldsw = (unsigned)wid * 1024u;
    const int aoff = lds_byte(wr * 64 + fr, fq * 8), boff = lds_byte(wc * 32 + fr, fq * 8);
#define PG_SA(b, h) (((b) * 2 + (h)) * HTB)
#define PG_SB(b, h) ((4 + (b) * 2 + (h)) * HTB)
#define PG_STAGE(bufoff, gbase, voff, ld2) do { \
        __builtin_amdgcn_global_load_lds((const unsigned*)((const char*)(gbase) + (voff)), (LAS unsigned*)(lds + (bufoff) + ldsw), 16, 0, 0); \
        __builtin_amdgcn_global_load_lds((const unsigned*)((const char*)(gbase) + (size_t)64 * (ld2) + (voff)), (LAS unsigned*)(lds + (bufoff) + ldsw + 8192), 16, 0, 0); } while (0)
#define PG_LDA(dst, b, h) do { _Pragma("unroll") for (int m = 0; m < 4; ++m) _Pragma("unroll") for (int k = 0; k < 2; ++k) dst[m][k] = *(const LAS bf16x8*)(lds + PG_SA(b, h) + aoff + m * 2048 + k * 1024); } while (0)
#define PG_LDB(dst, b, h) do { _Pragma("unroll") for (int n = 0; n < 2; ++n) _Pragma("unroll") for (int k = 0; k < 2; ++k) dst[n][k] = *(const LAS bf16x8*)(lds + PG_SB(b, h) + boff + n * 2048 + k * 1024); } while (0)
#define PG_MMA(ai, bj, At, Bt) do { __builtin_amdgcn_s_setprio(1); _Pragma("unroll") for (int m = 0; m < 4; ++m) _Pragma("unroll") for (int n = 0; n < 2; ++n) _Pragma("unroll") for (int k = 0; k < 2; ++k) \
        acc[ai][bj][m][n] = __builtin_amdgcn_mfma_f32_16x16x32_bf16(Bt[n][k], At[m][k], acc[ai][bj][m][n], 0, 0, 0); __builtin_amdgcn_s_setprio(0); } while (0)
#define PG_WAIT_V(n) asm volatile("s_waitcnt vmcnt(" #n ")" ::: "memory")
#define PG_WAIT_L(n) asm volatile("s_waitcnt lgkmcnt(" #n ")" ::: "memory")
#define PG_BAR __builtin_amdgcn_s_barrier()
#define PG_SCHED __builtin_amdgcn_sched_barrier(0)
#define PG_BODY(a1, vA1, la1, a2, b2, vA2, vB2, la2, lb2) do { \
            const size_t hA1 = (size_t)128 * (la1), hA2 = (size_t)128 * (la2), hB2 = (size_t)128 * (lb2); \
            const char* a3 = (a2) + kstep; const char* b3 = (b2) + kstep; \
            PG_LDB(B0, 0, 0); PG_LDB(B1, 0, 1); PG_SCHED; PG_LDA(At, 0, 0); PG_STAGE(PG_SA(1, 1), (a1) + hA1, vA1, la1); \
            PG_WAIT_V(8); PG_WAIT_L(0); PG_BAR; PG_MMA(0, 0, At, B0); PG_MMA(0, 1, At, B1); PG_BAR; PG_SCHED; \
            PG_LDA(At, 0, 1); PG_STAGE(PG_SB(0, 0), (b2), vB2, lb2); PG_STAGE(PG_SB(0, 1), (b2) + hB2, vB2, lb2); PG_STAGE(PG_SA(0, 0), (a2), vA2, la2); \
            PG_WAIT_V(8); PG_WAIT_L(0); PG_BAR; PG_MMA(1, 0, At, B0); PG_MMA(1, 1, At, B1); PG_BAR; PG_SCHED; \
            PG_LDB(B0, 1, 0); PG_LDB(B1, 1, 1); PG_SCHED; PG_LDA(At, 1, 0); PG_STAGE(PG_SA(0, 1), (a2) + hA2, vA2, la2); \
            PG_WAIT_V(8); PG_WAIT_L(0); PG_BAR; PG_MMA(0, 0, At, B0); PG_MMA(0, 1, At, B1); PG_BAR; PG_SCHED; \
            PG_LDA(At, 1, 1); PG_STAGE(PG_SB(1, 0), b3, vB2, lb2); PG_STAGE(PG_SB(1, 1), b3 + hB2, vB2, lb2); PG_STAGE(PG_SA(1, 0), a3, vA2, la2); \
            PG_WAIT_V(8); PG_WAIT_L(0); PG_BAR; PG_MMA(1, 0, At, B0); PG_MMA(1, 1, At, B1); PG_BAR; PG_SCHED; } while (0)
    GUnit cur, nxt; int ui = 0;
    if (!S.next(0, cur)) return;
    f32x4 acc[2][2][4][2];
#pragma unroll
    for (int a = 0; a < 2; ++a)
#pragma unroll
        for (int b = 0; b < 2; ++b)
#pragma unroll
            for (int m = 0; m < 4; ++m)
#pragma unroll
                for (int n = 0; n < 2; ++n) acc[a][b][m][n] = (f32x4){0.f, 0.f, 0.f, 0.f};
    bf16x8 At[4][2], B0[2][2], B1[2][2];
    unsigned vAc, vBc;
    { int R0, C0; stage_rc(tid * 16, R0, C0); const int Rb0 = (R0 & ~31) + perm32(R0 & 31); vAc = (unsigned)R0 * cur.lda2 + (unsigned)C0 * 2u; vBc = (unsigned)Rb0 * cur.ldb2 + (unsigned)C0 * 2u; }
    {
        const char* cA = cur.A; const char* cB = cur.B; const size_t hA = (size_t)128 * cur.lda2, hB = (size_t)128 * cur.ldb2;
        PG_STAGE(PG_SB(0, 0), cB, vBc, cur.ldb2); PG_STAGE(PG_SB(0, 1), cB + hB, vBc, cur.ldb2); PG_STAGE(PG_SA(0, 0), cA, vAc, cur.lda2); PG_STAGE(PG_SA(0, 1), cA + hA, vAc, cur.lda2);
        if (wr == 1) PG_BAR;
        PG_WAIT_V(2); PG_BAR;
        PG_STAGE(PG_SB(1, 0), cB + kstep, vBc, cur.ldb2); PG_STAGE(PG_SA(1, 0), cA + kstep, vAc, cur.lda2); PG_STAGE(PG_SB(1, 1), cB + hB + kstep, vBc, cur.ldb2);
        PG_WAIT_V(6); PG_BAR;
    }
    for (;;) {
        const bool has_next = S.next(ui + 1, nxt);
        if (!has_next) nxt = cur;
        const int nt = cur.nt;
        const char* cA = cur.A; const char* cB = cur.B;
        for (int t = 0; t < nt - 2; t += 2)
            PG_BODY(cA + (size_t)(t + 1) * kstep, vAc, cur.lda2, cA + (size_t)(t + 2) * kstep, cB + (size_t)(t + 2) * kstep, vAc, vBc, cur.lda2, cur.ldb2);
        unsigned vAn, vBn;
        { int t2 = tid; asm volatile("" : "+v"(t2)); int R0, C0; stage_rc(t2 * 16, R0, C0); const int Rb0 = (R0 & ~31) + perm32(R0 & 31);
          vAn = (unsigned)R0 * nxt.lda2 + (unsigned)C0 * 2u; vBn = (unsigned)Rb0 * nxt.ldb2 + (unsigned)C0 * 2u; }
        PG_BODY(cA + (size_t)(nt - 1) * kstep, vAc, cur.lda2, nxt.A, nxt.B, vAn, vBn, nxt.lda2, nxt.ldb2);
        if (wr == 0) PG_BAR;
        E(acc, cur, wr, wc, fr, fq);
        if (!has_next) break;
#pragma unroll
        for (int a = 0; a < 2; ++a)
#pragma unroll
            for (int b = 0; b < 2; ++b)
#pragma unroll
                for (int m = 0; m < 4; ++m)
#pragma unroll
                    for (int n = 0; n < 2; ++n) acc[a][b][m][n] = (f32x4){0.f, 0.f, 0.f, 0.f};
        cur = nxt; vAc = vAn; vBc = vBn; ++ui;
        if (wr == 1) PG_BAR;
    }
    PG_WAIT_V(0);
    PG_BAR;
#undef PG_SA
#undef PG_SB
#undef PG_STAGE
#undef PG_LDA
#undef PG_LDB
#undef PG_MMA
#undef PG_WAIT_V
#undef PG_WAIT_L
#undef PG_BAR
#undef PG_SCHED
#undef PG_BODY
}

#define EPI_LOOP(...) \
    _Pragma("unroll") for (int ai = 0; ai < 2; ++ai) _Pragma("unroll") for (int m = 0; m < 4; ++m) _Pragma("unroll") for (int bj = 0; bj < 2; ++bj) { \
        const int row = u.pm * 256 + ai * 128 + wr * 64 + m * 16 + fr; const int tcol = bj * 128 + wc * 32 + 8 * fq; \
        const f32x4 v0 = acc[ai][bj][m][0], v1 = acc[ai][bj][m][1]; float v[8] = {v0[0], v0[1], v0[2], v0[3], v1[0], v1[1], v1[2], v1[3]}; __VA_ARGS__ }

struct EpiIn {
    bf16_t *prw, *ppool, *pconv, *patt;
    __device__ __forceinline__ void operator()(const f32x4 (&acc)[2][2][4][2], const GUnit& u, int wr, int wc, int fr, int fq) const {
        asm volatile("" : "+v"(fr), "+v"(fq));
        bf16_t* base; int ld, ct;
        if (u.pn < 7) { base = prw; ld = 1792; ct = u.pn; } else if (u.pn < 9) { base = ppool; ld = 512; ct = u.pn - 7; }
        else if (u.pn < 15) { base = pconv; ld = 1536; ct = u.pn - 9; } else { base = patt; ld = 768; ct = u.pn - 15; }
        EPI_LOOP({ *(u32x4*)(base + (size_t)row * ld + ct * 256 + tcol) = pack8(v); })
    }
};
struct EpiLora {
    bf16_t* out; const float* w0; const float* a0;
    __device__ __forceinline__ void operator()(const f32x4 (&acc)[2][2][4][2], const GUnit& u, int wr, int wc, int fr, int fq) const {
        asm volatile("" : "+v"(fr), "+v"(fq));
        const float* bias = u.pn < 2 ? w0 + u.pn * 256 : a0 + (u.pn - 2) * 256;
        const bool sg = u.pn < 4;
        EPI_LOOP({ if (sg) { float bv[8]; ld8f(bias + tcol, bv); _Pragma("unroll") for (int j = 0; j < 8; ++j) v[j] = sigmoidf_(v[j] + bv[j]); }
                   *(u32x4*)(out + (size_t)row * 1536 + u.pn * 256 + tcol) = pack8(v); })
    }
};
struct EpiBR {
    u32x4* scr; bf16_t* mixed;
    __device__ __forceinline__ void operator()(const f32x4 (&acc)[2][2][4][2], const GUnit& u, int wr, int wc, int fr, int fq) const {
        asm volatile("" : "+v"(fr), "+v"(fq));
        const bool gate = (u.aux & 1) == 0; const bool first = (u.aux >> 1) == 0;
        EPI_LOOP({ u32x4* sp = scr + ((ai * 4 + m) * 2 + bj) * 512 + ((wr * 4 + wc) * 64 + fq * 16 + fr);
                   if (gate) { _Pragma("unroll") for (int j = 0; j < 8; ++j) v[j] = sigmoidf_(v[j]); *sp = pack8(v); }
                   else { float g[8]; unpack8(*sp, g); bf16_t* mp = mixed + (size_t)row * 1024 + u.pn * 256 + tcol;
                          _Pragma("unroll") for (int j = 0; j < 8; ++j) v[j] *= g[j];
                          if (!first) { float o[8]; unpack8(*(const u32x4*)mp, o); _Pragma("unroll") for (int j = 0; j < 8; ++j) v[j] += o[j]; }
                          *(u32x4*)mp = pack8(v); } })
    }
};
struct EpiRes {
    const float* base; float* out;
    __device__ __forceinline__ void operator()(const f32x4 (&acc)[2][2][4][2], const GUnit& u, int wr, int wc, int fr, int fq) const {
        asm volatile("" : "+v"(fr), "+v"(fq));
        EPI_LOOP({ const size_t off = (size_t)row * 1024 + u.pn * 256 + tcol; const f32x4 b0 = *(const f32x4*)(base + off), b1 = *(const f32x4*)(base + off + 4);
                   *(f32x4*)(out + off) = (f32x4){b0[0] + v[0], b0[1] + v[1], b0[2] + v[2], b0[3] + v[3]}; *(f32x4*)(out + off + 4) = (f32x4){b1[0] + v[4], b1[1] + v[5], b1[2] + v[6], b1[3] + v[7]}; })
    }
};
struct EpiGU {
    bf16_t* act;
    __device__ __forceinline__ void operator()(const f32x4 (&acc)[2][2][4][2], const GUnit& u, int wr, int wc, int fr, int fq) const {
        asm volatile("" : "+v"(fr), "+v"(fq));
#pragma unroll
        for (int ai = 0; ai < 2; ++ai)
#pragma unroll
            for (int m = 0; m < 4; ++m) {
                const int row = u.pm * 256 + ai * 128 + wr * 64 + m * 16 + fr; const int col = u.pn * 128 + wc * 32 + 8 * fq;
                const f32x4 g0 = acc[ai][0][m][0], g1 = acc[ai][0][m][1], u0 = acc[ai][1][m][0], u1 = acc[ai][1][m][1];
                float v[8];
#pragma unroll
                for (int j = 0; j < 4; ++j) { v[j] = g0[j] * sigmoidf_(g0[j]) * u0[j]; v[4 + j] = g1[j] * sigmoidf_(g1[j]) * u1[j]; }
                *(u32x4*)(act + (size_t)row * DFF + col) = pack8(v);
            }
    }
};
}

__device__ __forceinline__ float wave_sum(float v) {
#pragma unroll
    for (int o = 1; o < 64; o <<= 1) v += __shfl_xor(v, o);
    return v;
}
__device__ __forceinline__ void transpose_item(const float* W, int ldw, int k0, int n0, bf16_t* WT, int drow0, int ldd, int dk0, LAS float* scr, int lane) {
#pragma unroll 8
    for (int i = 0; i < 32; ++i) { const int kk = 2 * i + (lane >> 5); scr[kk * 33 + (lane & 31)] = W[(size_t)(k0 + kk) * ldw + n0 + (lane & 31)]; }
    asm volatile("s_waitcnt lgkmcnt(0)" ::: "memory");
    const int c = lane & 7;
#pragma unroll
    for (int j = 0; j < 4; ++j) { const int n = (lane >> 3) + 8 * j; const LAS float* s = scr + (8 * c) * 33 + n;
        u32x4 o; o.x = cvt_pk_bf16(s[0 * 33], s[1 * 33]); o.y = cvt_pk_bf16(s[2 * 33], s[3 * 33]); o.z = cvt_pk_bf16(s[4 * 33], s[5 * 33]); o.w = cvt_pk_bf16(s[6 * 33], s[7 * 33]);
        *(u32x4*)(WT + (size_t)(drow0 + n) * ldd + dk0 + k0 + 8 * c) = o; }
    asm volatile("s_waitcnt lgkmcnt(0)" ::: "memory");
}

__device__ __forceinline__ void prologue_phase(const Params& p, LAS unsigned char* lds) {
    const int tid = tid_(), lane = tid & 63, wave = __builtin_amdgcn_readfirstlane(tid >> 6);
    const int G = gridDim.x; const int gw = bid_() * 8 + wave, NGW = G * 8;
    LAS float* scr = (LAS float*)(lds + wave * 8448);
    bf16_t* Wb = (bf16_t*)(p.ws + WS_W);
    constexpr int PER_LAYER = 4352 + 16 + 16 + 32 + 256 * 3 + 512 + 1408 * 3;
    for (int it = gw; it < NL * PER_LAYER; it += NGW) {
        const int l = it / PER_LAYER; int r = it % PER_LAYER;
        bf16_t* wl = Wb + (size_t)l * LW_ELEMS;
        const float* src; int K, N, ldd, dk0 = 0, mode = 0; bf16_t* dst; int rowoff = 0;
        if (r < 4352) { src = (const float*)p.in[3] + (size_t)l * 1024 * INC; K = 1024; N = INC; dst = wl + OW_IN; ldd = 1024; }
        else if ((r -= 4352) < 16) { src = (const float*)p.in[5] + (size_t)l * 64 * 512; K = 64; N = 512; dst = wl + OW_LORA; ldd = 256; }
        else if ((r -= 16) < 16) { src = (const float*)p.in[7] + (size_t)l * 64 * 512; K = 64; N = 512; dst = wl + OW_LORA; ldd = 256; rowoff = 512; dk0 = 64; }
        else if ((r -= 16) < 32) { src = (const float*)p.in[9] + (size_t)l * 128 * 512; K = 128; N = 512; dst = wl + OW_LORA; ldd = 256; rowoff = 1024; dk0 = 128; }
        else if ((r -= 32) < 256) { src = (const float*)p.in[15] + (size_t)l * 512 * 1024; K = 512; N = 1024; dst = wl + OW_BR; ldd = 512; }
        else if ((r -= 256) < 256) { src = (const float*)p.in[20] + (size_t)l * 512 * 1024; K = 512; N = 1024; dst = wl + OW_BR + 2 * 524288; ldd = 512; }
        else if ((r -= 256) < 256) { src = (const float*)p.in[24] + (size_t)l * 512 * 1024; K = 512; N = 1024; dst = wl + OW_BR + 3 * 524288; ldd = 512; }
        else if ((r -= 256) < 512) { src = (const float*)p.in[25] + (size_t)l * 1024 * 1024; K = 1024; N = 1024; dst = wl + OW_O; ldd = 1024; }
        else if ((r -= 512) < 1408) { src = (const float*)p.in[27] + (size_t)l * 1024 * DFF; K = 1024; N = DFF; dst = wl + OW_GU; ldd = 1024; mode = 1; }
        else if ((r -= 1408) < 1408) { src = (const float*)p.in[28] + (size_t)l * 1024 * DFF; K = 1024; N = DFF; dst = wl + OW_GU; ldd = 1024; mode = 2; }
        else { r -= 1408; src = (const float*)p.in[29] + (size_t)l * DFF * 1024; K = DFF; N = 1024; dst = wl + OW_D; ldd = DFF; }
        const int nblk = N / 32, kb = r / nblk, nb = r % nblk, n0 = nb * 32;
        int drow0 = rowoff + n0;
        if (mode) drow0 = (n0 >> 7) * 256 + (n0 & 127) + (mode == 2 ? 128 : 0);
        transpose_item(src, N, kb * 64, n0, dst, drow0, ldd, dk0, scr, lane);
    }
    const int gt = bid_() * NTHR + tid, NGT = G * NTHR;
    for (int idx = gt; idx < NL * 1536 * 32; idx += NGT) {
        const int l = idx / (1536 * 32), r = idx % (1536 * 32), row = r >> 5, kc = (r & 31) * 8;
        const bool diag = row < 512 ? (kc < 64) : row < 1024 ? (kc >= 64 && kc < 128) : (kc >= 128);
        if (!diag) *(u32x4*)(Wb + (size_t)l * LW_ELEMS + OW_LORA + (size_t)row * 256 + kc) = (u32x4){0u, 0u, 0u, 0u};
    }
    for (int idx = gt; idx < NL * 1024 * 64; idx += NGT) {
        const int l = idx >> 16, r = idx & 65535, n = r & 1023, k0 = (r >> 10) * 8, g = k0 >> 7;
        const float* pw = (const float*)p.in[16] + (size_t)l * 65536 + (size_t)g * 16384 + (size_t)(k0 & 127) * 128;
        const float* sc = (const float*)p.in[17] + l * 512 + g * 128;
        const float* wo = (const float*)p.in[18] + (size_t)l * 512 * 1024 + (size_t)g * 128 * 1024 + n;
        float a[8] = {0.f, 0.f, 0.f, 0.f, 0.f, 0.f, 0.f, 0.f};
        for (int j = 0; j < 128; ++j) { const float w = sc[j] * wo[(size_t)j * 1024];
#pragma unroll
            for (int i = 0; i < 8; ++i) a[i] += pw[i * 128 + j] * w; }
        *(u32x4*)(Wb + (size_t)l * LW_ELEMS + OW_BR + 524288 + (size_t)n * 512 + k0) = pack8(a);
    }
    _Float16* rope = (_Float16*)(p.ws + WS_ROPE);
    const int* pos = (const int*)p.in[1];
    for (int idx = gt; idx < MTOK * 32; idx += NGT) {
        const int m = idx >> 5, i = idx & 31;
        const float inv = powf(10000.0f, -(float)i * 2.0f / 64.0f);
        const float ang = (float)pos[m] * inv;
        rope[(size_t)m * 64 + i] = (_Float16)cosf(ang); rope[(size_t)m * 64 + 32 + i] = (_Float16)sinf(ang);
    }
}

__device__ __forceinline__ void norm_phase(const float* x, const float* g, bf16_t* out) {
    const int tid = tid_(), lane = tid & 63, wave = tid >> 6;
    f32x4 gv[4];
#pragma unroll
    for (int j = 0; j < 4; ++j) gv[j] = *((const f32x4*)g + lane + 64 * j);
    for (int m = bid_() * 8 + wave; m < MTOK; m += gridDim.x * 8) {
        const f32x4* xr = (const f32x4*)(x + (size_t)m * DM) + lane;
        f32x4 v[4]; float s = 0.f;
#pragma unroll
        for (int j = 0; j < 4; ++j) { v[j] = xr[64 * j]; s += (v[j].x * v[j].x + v[j].y * v[j].y) + (v[j].z * v[j].z + v[j].w * v[j].w); }
        const float rstd = 1.0f / sqrtf(wave_sum(s) * (1.0f / DM) + 1e-6f);
        u32x2* o = (u32x2*)(out + (size_t)m * DM) + lane;
#pragma unroll
        for (int j = 0; j < 4; ++j) { u32x2 w; w.x = cvt_pk_bf16(v[j].x * rstd * gv[j].x, v[j].y * rstd * gv[j].y); w.y = cvt_pk_bf16(v[j].z * rstd * gv[j].z, v[j].w * rstd * gv[j].w); o[64 * j] = w; }
    }
}

__device__ __forceinline__ u32x4 qk_prep(const u32x4 raw, const float* g, const _Float16* rp, int c, float scale) {
    float x[8]; unpack8(raw, x);
    float ss = 0.f;
#pragma unroll
    for (int j = 0; j < 8; ++j) ss += x[j] * x[j];
    ss = dpp_sum8(ss);
    const float rstd = 1.0f / sqrtf(ss * (1.0f / 64.0f) + 1e-6f);
    float gg[8]; ld8f(g + c * 8, gg);
    const int ci = (c & 3) * 8;
    float o[8];
#pragma unroll
    for (int j = 0; j < 8; ++j) {
        const float y = x[j] * rstd * gg[j];
        const float pr = __shfl_xor(y, 4);
        const float cs = (float)rp[ci + j], sn = (float)rp[32 + ci + j];
        o[j] = (c < 4 ? y * cs - pr * sn : y * cs + pr * sn) * scale;
    }
    return pack8(o);
}

__device__ __forceinline__ void attn_item(const Params& p, int l, int item, LAS unsigned char* lds) {
    const int tid = tid_(), lane = tid & 63, wave = __builtin_amdgcn_readfirstlane(tid >> 6), fr = lane & 15, fq = lane >> 4;
    const int b = item >> 6, kvh = (item >> 5) & 1, nbk = item & 31;
    const int tok0 = b * SEQ + nbk * 128;
    const bf16_t* PATT = (const bf16_t*)(p.ws + WS_PATT);
    bf16_t* M3 = (bf16_t*)(p.ws + WS_M3);
    const _Float16* rope = (const _Float16*)(p.ws + WS_ROPE);
    const float* qg = (const float*)p.in[21] + l * 64; const float* kg = (const float*)p.in[22] + l * 64;
    LAS bf16_t* Ks = (LAS bf16_t*)lds;
    LAS bf16_t* Vt = (LAS bf16_t*)(lds + 36864);
    LAS bf16_t* Qs = (LAS bf16_t*)(lds + 70656);
    const int c = tid & 7;
#pragma unroll 1
    for (int pass = 0; pass < 4; ++pass) {
        const int row = pass * 64 + (tid >> 3); const int tokk = tok0 - 128 + row; const bool valid = (nbk > 0) || (row >= 128);
        u32x4 kraw = (u32x4){0u, 0u, 0u, 0u}, vraw = kraw;
        const int tk = valid ? tokk : tok0;
        if (valid) { kraw = ld16(PATT + (size_t)tokk * 768 + 512 + kvh * 64 + c * 8); vraw = ld16(PATT + (size_t)tokk * 768 + 640 + kvh * 64 + c * 8); }
        const u32x4 kp = qk_prep(kraw, kg, rope + (size_t)tk * 64, c, 1.0f);
        *(LAS u32x4*)(Ks + row * 72 + c * 8) = kp;
        LAS bf16_t* vp = Vt + (c * 8) * 264 + row;
        vp[0 * 264] = (bf16_t)(vraw.x & 0xffffu); vp[1 * 264] = (bf16_t)(vraw.x >> 16); vp[2 * 264] = (bf16_t)(vraw.y & 0xffffu); vp[3 * 264] = (bf16_t)(vraw.y >> 16);
        vp[4 * 264] = (bf16_t)(vraw.z & 0xffffu); vp[5 * 264] = (bf16_t)(vraw.z >> 16); vp[6 * 264] = (bf16_t)(vraw.w & 0xffffu); vp[7 * 264] = (bf16_t)(vraw.w >> 16);
    }
#pragma unroll 1
    for (int pass = 0; pass < 8; ++pass) {
        const int row = pass * 64 + (tid >> 3); const int g = row >> 7, ql = row & 127; const int tokq = tok0 + ql; const int hq = kvh * 4 + g;
        const u32x4 qraw = ld16(PATT + (size_t)tokq * 768 + hq * 64 + c * 8);
        *(LAS u32x4*)(Qs + row * 72 + c * 8) = qk_prep(qraw, qg, rope + (size_t)tokq * 64, c, 0.125f);
    }
    __syncthreads();
    const int g = wave >> 1; const int hq = kvh * 4 + g;
    const float sink = ((const float*)p.in[23])[l * 8 + hq];
#pragma unroll 1
    for (int pp = 0; pp < 2; ++pp) {
        const int ql0 = (wave & 1) * 64 + pp * 32;
        f32x4 sacc[10][2];
#pragma unroll
        for (int n = 0; n < 10; ++n) { sacc[n][0] = (f32x4){0.f, 0.f, 0.f, 0.f}; sacc[n][1] = sacc[n][0]; }
#pragma unroll
        for (int kk2 = 0; kk2 < 2; ++kk2) {
            const bf16x8 q0 = *(const LAS bf16x8*)(Qs + (g * 128 + ql0 + fr) * 72 + 32 * kk2 + 8 * fq);
            const bf16x8 q1 = *(const LAS bf16x8*)(Qs + (g * 128 + ql0 + 16 + fr) * 72 + 32 * kk2 + 8 * fq);
#pragma unroll
            for (int n = 0; n < 10; ++n) {
                const bf16x8 kf = *(const LAS bf16x8*)(Ks + (ql0 + 16 * n + fr) * 72 + 32 * kk2 + 8 * fq);
                sacc[n][0] = __builtin_amdgcn_mfma_f32_16x16x32_bf16(kf, q0, sacc[n][0], 0, 0, 0);
                sacc[n][1] = __builtin_amdgcn_mfma_f32_16x16x32_bf16(kf, q1, sacc[n][1], 0, 0, 0);
            }
        }
        u32x2 pb[10][2];
#pragma unroll
        for (int mq = 0; mq < 2; ++mq) {
            const int qi = 128 + ql0 + 16 * mq + fr;
            float mx = -__builtin_inff();
#pragma unroll
            for (int n = 0; n < 10; ++n)
#pragma unroll
                for (int j = 0; j < 4; ++j) {
                    const int kj = ql0 + 16 * n + 4 * fq + j; const int dist = qi - kj;
                    const bool ok = (dist >= 0) && (dist < 128) && ((nbk > 0) || (kj >= 128));
                    const float s = ok ? sacc[n][mq][j] : -__builtin_inff();
                    sacc[n][mq][j] = s; mx = fmaxf(mx, s);
                }
            mx = fmaxf(mx, __shfl_xor(mx, 16)); mx = fmaxf(mx, __shfl_xor(mx, 32));
            const float mf = fmaxf(mx, sink);
            float sum = 0.f;
#pragma unroll
            for (int n = 0; n < 10; ++n)
#pragma unroll
                for (int j = 0; j < 4; ++j) { const float e = __expf(sacc[n][mq][j] - mf); sacc[n][mq][j] = e; sum += e; }
            sum += __shfl_xor(sum, 16); sum += __shfl_xor(sum, 32);
            const float inv = 1.0f / (sum + __expf(sink - mf));
#pragma unroll
            for (int n = 0; n < 10; ++n) { pb[n][mq].x = cvt_pk_bf16(sacc[n][mq][0] * inv, sacc[n][mq][1] * inv); pb[n][mq].y = cvt_pk_bf16(sacc[n][mq][2] * inv, sacc[n][mq][3] * inv); }
        }
        f32x4 oacc[4][2];
#pragma unroll
        for (int dt = 0; dt < 4; ++dt) { oacc[dt][0] = (f32x4){0.f, 0.f, 0.f, 0.f}; oacc[dt][1] = oacc[dt][0]; }
#pragma unroll
        for (int kc = 0; kc < 5; ++kc) {
            const u32x4 p0 = (u32x4){pb[2 * kc][0].x, pb[2 * kc][0].y, pb[2 * kc + 1][0].x, pb[2 * kc + 1][0].y};
            const u32x4 p1 = (u32x4){pb[2 * kc][1].x, pb[2 * kc][1].y, pb[2 * kc + 1][1].x, pb[2 * kc + 1][1].y};
#pragma unroll
            for (int dt = 0; dt < 4; ++dt) {
                const LAS bf16_t* vrow = Vt + (16 * dt + fr) * 264 + ql0 + 32 * kc + 4 * fq;
                const u32x2 va = *(const LAS u32x2*)vrow, vb = *(const LAS u32x2*)(vrow + 16);
                const u32x4 vv = (u32x4){va.x, va.y, vb.x, vb.y};
                oacc[dt][0] = __builtin_amdgcn_mfma_f32_16x16x32_bf16(__builtin_bit_cast(bf16x8, vv), __builtin_bit_cast(bf16x8, p0), oacc[dt][0], 0, 0, 0);
                oacc[dt][1] = __builtin_amdgcn_mfma_f32_16x16x32_bf16(__builtin_bit_cast(bf16x8, vv), __builtin_bit_cast(bf16x8, p1), oacc[dt][1], 0, 0, 0);
            }
        }
#pragma unroll
        for (int mq = 0; mq < 2; ++mq)
#pragma unroll
            for (int dt = 0; dt < 4; ++dt) {
                const int ql = ql0 + 16 * mq + fr;
                u32x2 w; w.x = cvt_pk_bf16(oacc[dt][mq][0], oacc[dt][mq][1]); w.y = cvt_pk_bf16(oacc[dt][mq][2], oacc[dt][mq][3]);
                *(u32x2*)(M3 + (size_t)(tok0 + ql) * 1536 + 1024 + hq * 64 + 16 * dt + 4 * fq) = w;
            }
    }
    __syncthreads();
}

__device__ __forceinline__ void mix1_phase(const Params& p, int l, LAS unsigned char* lds) {
    const int tid = tid_(), G = gridDim.x;
    for (int item = bid_(); item < 1024; item += G) attn_item(p, l, item, lds);
    const int gt = bid_() * NTHR + tid, NGT = G * NTHR;
    const bf16_t* PRW = (const bf16_t*)(p.ws + WS_PRW); const bf16_t* PPOOL = (const bf16_t*)(p.ws + WS_PPOOL); const bf16_t* PCONV = (const bf16_t*)(p.ws + WS_PCONV);
    bf16_t* M3 = (bf16_t*)(p.ws + WS_M3); bf16_t* AL = (bf16_t*)(p.ws + WS_ALORA);
    const float* mu = (const float*)p.in[4] + l * RWC;
    for (int idx = gt; idx < MTOK * 32; idx += NGT) {
        const int m = idx >> 5, c8 = (idx & 31) * 8, t = m & (SEQ - 1);
        float cur[8], prv[8], mm[8], o[8];
        unpack8(ld16(PRW + (size_t)m * RWC + 1536 + c8), cur);
        if (t > 0) unpack8(ld16(PRW + (size_t)(m - 1) * RWC + 1536 + c8), prv); else { _Pragma("unroll") for (int j = 0; j < 8; ++j) prv[j] = 0.f; }
        ld8f(mu + 1536 + c8, mm);
#pragma unroll
        for (int j = 0; j < 8; ++j) { const float s = cur[j] + (prv[j] - cur[j]) * mm[j];
            o[j] = c8 < 64 ? (1.0f - 2.0f / (__expf(2.0f * s) + 1.0f)) : (c8 < 128 ? s : sigmoidf_(s)); }
        *(u32x4*)(AL + (size_t)m * 256 + c8) = pack8(o);
    }
    const float* cw = (const float*)p.in[19] + l * 3 * 512;
    for (int idx = gt; idx < MTOK * 64; idx += NGT) {
        const int m = idx >> 6, c8 = (idx & 63) * 8, t = m & (SEQ - 1);
        float bg[8], a[8] = {0.f, 0.f, 0.f, 0.f, 0.f, 0.f, 0.f, 0.f};
        unpack8(ld16(PCONV + (size_t)m * 1536 + c8), bg);
#pragma unroll
        for (int k = 0; k < 3; ++k) {
            if (t - 2 + k >= 0) { float cc[8], uu[8], ww[8];
                unpack8(ld16(PCONV + (size_t)(m - 2 + k) * 1536 + 512 + c8), cc); unpack8(ld16(PCONV + (size_t)(m - 2 + k) * 1536 + 1024 + c8), uu); ld8f(cw + k * 512 + c8, ww);
#pragma unroll
                for (int j = 0; j < 8; ++j) a[j] += ww[j] * (cc[j] * uu[j]); }
        }
#pragma unroll
        for (int j = 0; j < 8; ++j) a[j] *= bg[j];
        *(u32x4*)(M3 + (size_t)m * 1536 + 512 + c8) = pack8(a);
    }
    for (int idx = gt; idx < MTOK * 64; idx += NGT) {
        const int m = idx >> 6, c8 = (idx & 63) * 8, t = m & (SEQ - 1);
        const int win = 2 << (c8 >> 7);
        float u0[8], s[8];
        unpack8(ld16(PPOOL + (size_t)m * 512 + c8), u0);
#pragma unroll
        for (int j = 0; j < 8; ++j) s[j] = u0[j];
        for (int d = 1; d < win; ++d) { if (t - d >= 0) { float uu[8]; unpack8(ld16(PPOOL + (size_t)(m - d) * 512 + c8), uu);
#pragma unroll
                for (int j = 0; j < 8; ++j) s[j] += uu[j]; } }
        const float ic = 1.0f / (float)(t + 1 < win ? t + 1 : win);
#pragma unroll
        for (int j = 0; j < 8; ++j) s[j] = s[j] * ic - u0[j];
        *(u32x4*)(M3 + (size_t)m * 1536 + c8) = pack8(s);
    }
}

constexpr int TC = 32, NCH = SEQ / TC, SROW = 352;
__device__ __forceinline__ void scan_phase(const Params& p, int l, LAS unsigned char* lds) {
    const int tid = tid_(), lane = tid & 63, wave = __builtin_amdgcn_readfirstlane(tid >> 6);
    const bf16_t* PRW = (const bf16_t*)(p.ws + WS_PRW); const bf16_t* LORA = (const bf16_t*)(p.ws + WS_LORA);
    bf16_t* YRAW = (bf16_t*)(p.ws + WS_YRAW); float* BONUS = (float*)(p.ws + WS_BONUS);
    LAS float* inb = (LAS float*)lds;
    LAS float* yb = inb + 2 * TC * SROW;
    for (int item = bid_(); item < 256; item += gridDim.x) {
        const int chain = item >> 1, half = item & 1, b = chain >> 3, head = chain & 7;
        const int pt = tid - 256, t_l = (pt >> 3) & 31, cgi = pt & 7, c0 = cgi * 8, ch = head * 64 + c0;
        float mur[8], muk[8], muv[8], kkc[8], kac[8], rkc[8];
        if (wave >= 4) {
            const float* mu = (const float*)p.in[4] + l * RWC;
            ld8f(mu + ch, mur); ld8f(mu + 512 + ch, muk); ld8f(mu + 1024 + ch, muv);
            ld8f((const float*)p.in[10] + l * 512 + ch, kkc); ld8f((const float*)p.in[11] + l * 512 + ch, kac); ld8f((const float*)p.in[12] + l * 512 + ch, rkc);
        }
        const int row_l = lane >> 3, seg = lane & 7, rr = (wave & 3) * 8 + row_l;
        f32x2 S0 = (f32x2){0.f, 0.f}, S1 = S0, S2 = S0, S3 = S0;
#pragma unroll 1
        for (int n = 0; n <= NCH + 1; ++n) {
            if (wave >= 4) {
                if (n >= 2) {
                    const LAS float* ys = yb + (n & 1) * TC * 32 + t_l * 32 + cgi * 4;
                    const f32x4 yv = *(const LAS f32x4*)ys;
                    u32x2 w; w.x = cvt_pk_bf16(yv[0], yv[1]); w.y = cvt_pk_bf16(yv[2], yv[3]);
                    *(u32x2*)(YRAW + (size_t)(b * SEQ + (n - 2) * TC + t_l) * 512 + head * 64 + half * 32 + cgi * 4) = w;
                }
                if (n < NCH) {
                    const int t = n * TC + t_l; const size_t m = (size_t)b * SEQ + t;
                    float r[8], k[8], v[8], rp[8], kp[8], vp[8], sl[8], al[8];
                    unpack8(ld16(PRW + m * RWC + ch), r); unpack8(ld16(PRW + m * RWC + 512 + ch), k); unpack8(ld16(PRW + m * RWC + 1024 + ch), v);
                    if (t > 0) { unpack8(ld16(PRW + (m - 1) * RWC + ch), rp); unpack8(ld16(PRW + (m - 1) * RWC + 512 + ch), kp); unpack8(ld16(PRW + (m - 1) * RWC + 1024 + ch), vp); }
                    else { _Pragma("unroll") for (int j = 0; j < 8; ++j) { rp[j] = 0.f; kp[j] = 0.f; vp[j] = 0.f; } }
                    unpack8(ld16(LORA + m * 1536 + ch), sl); unpack8(ld16(LORA + m * 1536 + 512 + ch), al);
                    float kkr[8], ss = 0.f, bon = 0.f, dec[8], kpr[8];
#pragma unroll
                    for (int j = 0; j < 8; ++j) {
                        r[j] = r[j] + (rp[j] - r[j]) * mur[j]; k[j] = k[j] + (kp[j] - k[j]) * muk[j]; v[j] = v[j] + (vp[j] - v[j]) * muv[j];
                        dec[j] = __expf(-0.6065306597126334f * sl[j]);
                        kkr[j] = k[j] * kkc[j]; ss += kkr[j] * kkr[j];
                        kpr[j] = k[j] * (1.0f + (al[j] - 1.0f) * kac[j]);
                        bon += r[j] * kpr[j] * rkc[j];
                    }
                    ss = dpp_sum8(ss); bon = dpp_sum8(bon);
                    const float inrm = 1.0f / fmaxf(sqrtf(ss), 1e-12f);
                    LAS float* dst = inb + (n & 1) * TC * SROW + t_l * SROW + c0;
                    f32x4 w0, w1;
                    w0 = (f32x4){kkr[0] * inrm, kkr[1] * inrm, kkr[2] * inrm, kkr[3] * inrm}; w1 = (f32x4){kkr[4] * inrm, kkr[5] * inrm, kkr[6] * inrm, kkr[7] * inrm};
                    *(LAS f32x4*)(dst) = w0; *(LAS f32x4*)(dst + 4) = w1;
                    *(LAS f32x4*)(dst + 192) = (f32x4){w0[0] * al[0], w0[1] * al[1], w0[2] * al[2], w0[3] * al[3]}; *(LAS f32x4*)(dst + 196) = (f32x4){w1[0] * al[4], w1[1] * al[5], w1[2] * al[6], w1[3] * al[7]};
                    *(LAS f32x4*)(dst + 64) = (f32x4){dec[0], dec[1], dec[2], dec[3]}; *(LAS f32x4*)(dst + 68) = (f32x4){dec[4], dec[5], dec[6], dec[7]};
                    *(LAS f32x4*)(dst + 128) = (f32x4){kpr[0], kpr[1], kpr[2], kpr[3]}; *(LAS f32x4*)(dst + 132) = (f32x4){kpr[4], kpr[5], kpr[6], kpr[7]};
                    *(LAS f32x4*)(dst + 256) = (f32x4){r[0], r[1], r[2], r[3]}; *(LAS f32x4*)(dst + 260) = (f32x4){r[4], r[5], r[6], r[7]};
                    if ((cgi >> 2) == half) { LAS float* vd = inb + (n & 1) * TC * SROW + t_l * SROW + 320 + (c0 - 32 * half);
                        *(LAS f32x4*)(vd) = (f32x4){v[0], v[1], v[2], v[3]}; *(LAS f32x4*)(vd + 4) = (f32x4){v[4], v[5], v[6], v[7]}; }
                    if (half == 0 && cgi == 0) BONUS[m * 8 + head] = bon;
                }
            } else if (n >= 1 && n <= NCH) {
                const LAS float* src = inb + ((n - 1) & 1) * TC * SROW + seg * 8;
                LAS float* yd = yb + ((n - 1) & 1) * TC * 32 + rr;
#pragma unroll 2
                for (int tl = 0; tl < TC; ++tl) {
                    const LAS float* s = src + tl * SROW;
                    const f32x4 kkA = *(const LAS f32x4*)(s), kkB = *(const LAS f32x4*)(s + 4);
                    const f32x4 dcA = *(const LAS f32x4*)(s + 64), dcB = *(const LAS f32x4*)(s + 68);
                    const f32x4 kpA = *(const LAS f32x4*)(s + 128), kpB = *(const LAS f32x4*)(s + 132);
                    const f32x4 bvA = *(const LAS f32x4*)(s + 192), bvB = *(const LAS f32x4*)(s + 196);
                    const f32x4 rA = *(const LAS f32x4*)(s + 256), rB = *(const LAS f32x4*)(s + 260);
                    const float vv = s[320 - seg * 8 + rr];
                    f32x2 d2 = S0 * (f32x2){kkA[0], kkA[1]}; d2 += S1 * (f32x2){kkA[2], kkA[3]}; d2 += S2 * (f32x2){kkB[0], kkB[1]}; d2 += S3 * (f32x2){kkB[2], kkB[3]};
                    const float sa = dpp_sum8(d2.x + d2.y);
                    const f32x2 v2 = (f32x2){vv, vv}, nsa = (f32x2){-sa, -sa};
                    S0 = S0 * (f32x2){dcA[0], dcA[1]} + (v2 * (f32x2){kpA[0], kpA[1]} + nsa * (f32x2){bvA[0], bvA[1]});
                    S1 = S1 * (f32x2){dcA[2], dcA[3]} + (v2 * (f32x2){kpA[2], kpA[3]} + nsa * (f32x2){bvA[2], bvA[3]});
                    S2 = S2 * (f32x2){dcB[0], dcB[1]} + (v2 * (f32x2){kpB[0], kpB[1]} + nsa * (f32x2){bvB[0], bvB[1]});
                    S3 = S3 * (f32x2){dcB[2], dcB[3]} + (v2 * (f32x2){kpB[2], kpB[3]} + nsa * (f32x2){bvB[2], bvB[3]});
                    f32x2 y2 = S0 * (f32x2){rA[0], rA[1]}; y2 += S1 * (f32x2){rA[2], rA[3]}; y2 += S2 * (f32x2){rB[0], rB[1]}; y2 += S3 * (f32x2){rB[2], rB[3]};
                    const float y = dpp_sum8(y2.x + y2.y);
                    if (seg == 0) yd[tl * 32] = y;
                }
            }
            __syncthreads();
        }
    }
}

__device__ __forceinline__ void post_phase(const Params& p, int l) {
    const int gt = bid_() * NTHR + tid_(), NGT = gridDim.x * NTHR;
    const bf16_t* PRW = (const bf16_t*)(p.ws + WS_PRW); const bf16_t* LORA = (const bf16_t*)(p.ws + WS_LORA); const bf16_t* YRAW = (const bf16_t*)(p.ws + WS_YRAW);
    const float* BONUS = (const float*)(p.ws + WS_BONUS); bf16_t* MA = (bf16_t*)(p.ws + WS_MA);
    const float* muv = (const float*)p.in[4] + l * RWC + 1024; const float* lg = (const float*)p.in[13] + l * 512; const float* lb = (const float*)p.in[14] + l * 512;
    for (int idx = gt; idx < MTOK * 64; idx += NGT) {
        const int m = idx >> 6, c = (idx & 63) * 8, head = c >> 6, t = m & (SEQ - 1);
        float y[8], cur[8], prv[8], mm[8], g[8], gg[8], bb[8], o[8];
        unpack8(ld16(YRAW + (size_t)m * 512 + c), y);
        float s = 0.f;
#pragma unroll
        for (int j = 0; j < 8; ++j) s += y[j];
        const float mean = dpp_sum8(s) * (1.0f / 64.0f);
        float q = 0.f;
#pragma unroll
        for (int j = 0; j < 8; ++j) { y[j] -= mean; q += y[j] * y[j]; }
        const float rstd = 1.0f / sqrtf(dpp_sum8(q) * (1.0f / 64.0f) + 64e-5f);
        unpack8(ld16(PRW + (size_t)m * RWC + 1024 + c), cur);
        if (t > 0) unpack8(ld16(PRW + (size_t)(m - 1) * RWC + 1024 + c), prv); else { _Pragma("unroll") for (int j = 0; j < 8; ++j) prv[j] = 0.f; }
        ld8f(muv + c, mm); ld8f(lg + c, gg); ld8f(lb + c, bb);
        unpack8(ld16(LORA + (size_t)m * 1536 + 1024 + c), g);
        const float bon = BONUS[(size_t)m * 8 + head];
#pragma unroll
        for (int j = 0; j < 8; ++j) { const float vs = cur[j] + (prv[j] - cur[j]) * mm[j]; o[j] = (y[j] * rstd * gg[j] + bb[j] + bon * vs) * g[j]; }
        *(u32x4*)(MA + (size_t)m * 512 + c) = pack8(o);
    }
}

__global__ void __launch_bounds__(NTHR, 2) hybrid_fwd(Params p) {
    extern __shared__ __attribute__((aligned(16))) unsigned char lds_raw[];
    LAS unsigned char* lds = (LAS unsigned char*)lds_raw;
    cg::grid_group grid = cg::this_grid();
    const int G = gridDim.x;
    unsigned char* ws = p.ws;
    const int lo = p.ph_lo, hi = p.ph_hi;
#define RUN(k) (lo <= (k) && (k) < hi)
#define SYNC(k) do { if (RUN(k) && RUN((k) + 1)) grid.sync(); } while (0)
    if (RUN(0)) {
        prologue_phase(p, lds);
        norm_phase((const float*)p.in[0], (const float*)p.in[2], (bf16_t*)(ws + WS_H));
    }
    SYNC(0);
#pragma unroll 1
    for (int l = 0; l < NL; ++l) {
        const int pb = 1 + 11 * l;
        const char* wl = (const char*)(ws + WS_W) + (size_t)l * LW_ELEMS * 2;
        if (RUN(pb + 0)) {
            pg::DenseSched S{(const char*)(ws + WS_H), wl + OW_IN * 2, 2048u, 2048u, 16, 256, 18, G, bid_()};
            pg::EpiIn E{(bf16_t*)(ws + WS_PRW), (bf16_t*)(ws + WS_PPOOL), (bf16_t*)(ws + WS_PCONV), (bf16_t*)(ws + WS_PATT)};
            pg::gemm_phase(lds, S, E);
        }
        SYNC(pb + 0);
        if (RUN(pb + 1)) mix1_phase(p, l, lds);
        SYNC(pb + 1);
        if (RUN(pb + 2)) {
            pg::DenseSched S{(const char*)(ws + WS_ALORA), wl + OW_LORA * 2, 512u, 512u, 4, 256, 6, G, bid_()};
            pg::EpiLora E{(bf16_t*)(ws + WS_LORA), (const float*)p.in[6] + l * 512, (const float*)p.in[8] + l * 512};
            pg::gemm_phase(lds, S, E);
        }
        SYNC(pb + 2);
        if (RUN(pb + 3)) scan_phase(p, l, lds);
        SYNC(pb + 3);
        if (RUN(pb + 4)) post_phase(p, l);
        SYNC(pb + 4);
        if (RUN(pb + 5)) {
            const int c = bid_();
            pg::BRSched S{(const char*)(ws + WS_H), wl + OW_IN * 2, (const char*)(ws + WS_MA), (const char*)(ws + WS_M3), wl + OW_BR * 2, G, c};
            pg::EpiBR E{(u32x4*)(ws + WS_GSCR + (size_t)c * 131072), (bf16_t*)(ws + WS_MIXED)};
            pg::gemm_phase(lds, S, E);
        }
        SYNC(pb + 5);
        if (RUN(pb + 6)) {
            pg::DenseSched S{(const char*)(ws + WS_MIXED), wl + OW_O * 2, 2048u, 2048u, 16, 256, 4, G, bid_()};
            pg::EpiRes E{l == 0 ? (const float*)p.in[0] : (const float*)p.out, p.out};
            pg::gemm_phase(lds, S, E);
        }
        SYNC(pb + 6);
        if (RUN(pb + 7)) norm_phase(p.out, (const float*)p.in[26] + l * DM, (bf16_t*)(ws + WS_H));
        SYNC(pb + 7);
        if (RUN(pb + 8)) {
            pg::DenseSched S{(const char*)(ws + WS_H), wl + OW_GU * 2, 2048u, 2048u, 16, 256, 22, G, bid_()};
            pg::EpiGU E{(bf16_t*)(ws + WS_ACT)};
            pg::gemm_phase(lds, S, E);
        }
        SYNC(pb + 8);
        if (RUN(pb + 9)) {
            pg::DenseSched S{(const char*)(ws + WS_ACT), wl + OW_D * 2, (unsigned)(DFF * 2), (unsigned)(DFF * 2), 44, 256, 4, G, bid_()};
            pg::EpiRes E{(const float*)p.out, p.out};
            pg::gemm_phase(lds, S, E);
        }
        SYNC(pb + 9);
        if (RUN(pb + 10) && l + 1 < NL) norm_phase(p.out, (const float*)p.in[2] + (l + 1) * DM, (bf16_t*)(ws + WS_H));
        SYNC(pb + 10);
    }
#undef RUN
#undef SYNC
}

constexpr int N_PHASES = 1 + 11 * NL - 1;

extern "C" void kernel_launch(void* const* d_in, const int* in_sizes, int n_in, void* d_out, int out_size, void* d_ws, size_t ws_size, hipStream_t stream) {
    static int grid = 0;
    if (grid == 0) {
        if (n_in != 30 || out_size != MTOK * DM || ws_size < WS_END) { fprintf(stderr, "kernel_launch: unexpected shapes (n_in %d out %d ws %zu)\n", n_in, out_size, ws_size); grid = -1; return; }
        int dev = 0, cus = 0, per_cu = 0;
        (void)hipGetDevice(&dev); (void)hipDeviceGetAttribute(&cus, hipDeviceAttributeMultiprocessorCount, dev);
        (void)hipFuncSetAttribute((const void*)hybrid_fwd, hipFuncAttributeMaxDynamicSharedMemorySize, LDS_BYTES);
        (void)hipOccupancyMaxActiveBlocksPerMultiprocessor(&per_cu, (const void*)hybrid_fwd, NTHR, LDS_BYTES);
        if (per_cu < 1) { fprintf(stderr, "kernel_launch: occupancy query says %d blocks/CU\n", per_cu); per_cu = 1; }
        (void)hipGetLastError();
        grid = cus;
    }
    if (grid < 0) return;
    Params p{};
    for (int i = 0; i < 30; ++i) p.in[i] = d_in[i];
    p.out = (float*)d_out; p.ws = (unsigned char*)d_ws;
#ifdef MULTI_LAUNCH
    for (int ph = 0; ph < N_PHASES; ++ph) { p.ph_lo = ph; p.ph_hi = ph + 1; hipLaunchKernelGGL(hybrid_fwd, dim3(grid), dim3(NTHR), LDS_BYTES, stream, p); }
#else
    p.ph_lo = 0; p.ph_hi = N_PHASES;
    void* args[] = {&p};
    hipError_t e = hipLaunchCooperativeKernel((const void*)hybrid_fwd, dim3(grid), dim3(NTHR), args, LDS_BYTES, stream);
    if (e != hipSuccess) fprintf(stderr, "cooperative launch failed: %s (grid %d)\n", hipGetErrorString(e), grid);
#endif
}
```

```cpp
#include <hip/hip_runtime.h>
#include <hip/hip_cooperative_groups.h>
#include <cstdio>
#include <cstdint>
namespace cg = cooperative_groups;

#define LAS __attribute__((address_space(3)))
typedef unsigned short bf16_t;
typedef short bf16x8 __attribute__((ext_vector_type(8)));
typedef float f32x4 __attribute__((ext_vector_type(4)));
typedef float f32x2 __attribute__((ext_vector_type(2)));
typedef unsigned u32x4 __attribute__((ext_vector_type(4)));
typedef unsigned u32x2 __attribute__((ext_vector_type(2)));

constexpr int MTOK = 65536, SEQ = 4096, DM = 1024, NL = 2;
constexpr int RWC = 1792, INC = 8704, DFF = 2816;
constexpr int NTHR = 512;
constexpr size_t MiB = 1u << 20;
constexpr size_t OW_IN = 0, OW_LORA = 8912896, OW_BR = OW_LORA + 393216, OW_O = OW_BR + 2097152, OW_GU = OW_O + 1048576, OW_D = OW_GU + 5767168, LW_ELEMS = OW_D + 2883584;
constexpr size_t WS_W = 0, WS_BONUS = 82 * MiB, WS_ROPE = 84 * MiB, WS_H = 92 * MiB, WS_M3 = 220 * MiB, WS_PRW = 412 * MiB, WS_PPOOL = 636 * MiB,
                 WS_PCONV = 700 * MiB, WS_PATT = 892 * MiB, WS_ALORA = 988 * MiB, WS_END = 1020 * MiB;
constexpr size_t WS_LORA = 636 * MiB, WS_YRAW = 828 * MiB, WS_MA = 892 * MiB, WS_GSCR = 956 * MiB, WS_MIXED = 412 * MiB, WS_ACT = 220 * MiB;
static_assert(2 * LW_ELEMS * 2 <= WS_BONUS, "weights fit");
constexpr int LDS_BYTES = 147456;

struct Params { const void* in[30]; float* out; unsigned char* ws; int ph_lo, ph_hi; };

__device__ __forceinline__ unsigned cvt_pk_bf16(float lo, float hi) { unsigned r; asm volatile("v_cvt_pk_bf16_f32 %0, %1, %2" : "=v"(r) : "v"(lo), "v"(hi)); return r; }
__device__ __forceinline__ void unpack8(const u32x4 w, float (&f)[8]) {
    f[0] = __uint_as_float(w.x << 16); f[1] = __uint_as_float(w.x & 0xffff0000u); f[2] = __uint_as_float(w.y << 16); f[3] = __uint_as_float(w.y & 0xffff0000u);
    f[4] = __uint_as_float(w.z << 16); f[5] = __uint_as_float(w.z & 0xffff0000u); f[6] = __uint_as_float(w.w << 16); f[7] = __uint_as_float(w.w & 0xffff0000u);
}
__device__ __forceinline__ u32x4 pack8(const float (&f)[8]) { u32x4 w; w.x = cvt_pk_bf16(f[0], f[1]); w.y = cvt_pk_bf16(f[2], f[3]); w.z = cvt_pk_bf16(f[4], f[5]); w.w = cvt_pk_bf16(f[6], f[7]); return w; }
__device__ __forceinline__ u32x4 ld16(const bf16_t* p) { return *(const u32x4*)p; }
__device__ __forceinline__ void ld8f(const float* p, float (&f)[8]) { const f32x4 a = *(const f32x4*)p, b = *(const f32x4*)(p + 4); f[0] = a.x; f[1] = a.y; f[2] = a.z; f[3] = a.w; f[4] = b.x; f[5] = b.y; f[6] = b.z; f[7] = b.w; }
__device__ __forceinline__ float sigmoidf_(float x) { return 1.0f / (1.0f + __expf(-x)); }
__device__ __forceinline__ int tid_() { int t = threadIdx.x; asm volatile("" : "+v"(t)); return t; }
__device__ __forceinline__ int bid_() { int b = blockIdx.x; asm volatile("" : "+s"(b)); return b; }
__device__ __forceinline__ float dpp_sum8(float v) {
    v += __builtin_bit_cast(float, __builtin_amdgcn_mov_dpp(__builtin_bit_cast(int, v), 0xB1, 0xF, 0xF, true));
    v += __builtin_bit_cast(float, __builtin_amdgcn_mov_dpp(__builtin_bit_cast(int, v), 0x4E, 0xF, 0xF, true));
    v += __builtin_bit_cast(float, __builtin_amdgcn_mov_dpp(__builtin_bit_cast(int, v), 0x141, 0xF, 0xF, true));
    return v;
}

namespace pg {
constexpr int BM = 256, BK = 64, HALF = 128, HTB = HALF * BK * 2, NXCD = 8, WGM = 8;
__device__ __forceinline__ int lds_byte(int r, int c) { const int st = (r >> 4) * 2 + (c >> 5), rr = r & 15, cc = c & 31, ob = rr * 64 + cc * 2; return st * 1024 + (ob ^ (((ob >> 9) & 1) << 5)); }
__device__ __forceinline__ void stage_rc(int b, int& R, int& C) { const int st = b / 1024, sb = b % 1024, swz = sb ^ (((sb >> 9) & 1) << 5); R = (st >> 1) * 16 + swz / 64; C = (st & 1) * 32 + (swz % 64) / 2; }
__device__ __forceinline__ int perm32(int rho) { const int n = rho >> 4, i = rho & 15; return 8 * (i >> 2) + 4 * n + (i & 3); }

struct GUnit { const char* A; const char* B; unsigned lda2, ldb2; int nt, pm, pn, aux; };

__device__ __forceinline__ bool tile_order(int i, int G, int c, int nM, int nN, int& pm, int& pn) {
    const int nwg = nM * nN; const long L = (long)i * G + c; if (L >= nwg) return false;
    int wgid = (int)L; { const int q = nwg / NXCD, r = nwg % NXCD, xcd = wgid % NXCD, off = wgid / NXCD; wgid = (xcd < r ? xcd * (q + 1) : r * (q + 1) + (xcd - r) * q) + off; }
    const int nig = WGM * nN, gid = wgid / nig, fm = gid * WGM, gsz = (nM - fm) < WGM ? (nM - fm) : WGM;
    pm = fm + ((wgid % nig) % gsz); pn = (wgid % nig) / gsz; return true;
}
struct DenseSched {
    const char* A; const char* B; unsigned lda2, ldb2; int nt, nM, nN, G, c;
    __device__ __forceinline__ bool next(int i, GUnit& u) const {
        int pm, pn; if (!tile_order(i, G, c, nM, nN, pm, pn)) return false;
        u.A = A + (size_t)pm * 256 * lda2; u.B = B + (size_t)pn * 256 * ldb2; u.lda2 = lda2; u.ldb2 = ldb2; u.nt = nt; u.pm = pm; u.pn = pn; u.aux = 0; return true;
    }
};
struct BRSched {
    const char* H; const char* WIN; const char* MA; const char* M3; const char* WBR; int G, c;
    __device__ __forceinline__ bool next(int i, GUnit& u) const {
        int pm, pn; if (!tile_order(i >> 3, G, c, 256, 4, pm, pn)) return false;
        const int sub = i & 7, b = sub >> 1;
        if ((sub & 1) == 0) { u.A = H + (size_t)pm * 256 * 2048; u.lda2 = 2048; u.B = WIN + (size_t)(4608 + b * 1024 + pn * 256) * 2048; u.ldb2 = 2048; u.nt = 16; }
        else { if (b == 0) { u.A = MA + (size_t)pm * 256 * 1024; u.lda2 = 1024; } else { u.A = M3 + (size_t)(b - 1) * 1024 + (size_t)pm * 256 * 3072; u.lda2 = 3072; }
               u.B = WBR + (size_t)b * (1024 * 512 * 2) + (size_t)pn * 256 * 1024; u.ldb2 = 1024; u.nt = 8; }
        u.pm = pm; u.pn = pn; u.aux = sub; return true;
    }
};

template <class Epi, class Sched>
__device__ __forceinline__ void gemm_phase(LAS unsigned char* lds, const Sched& S, const Epi& E) {
    const int tid = tid_(), wid = __builtin_amdgcn_readfirstlane(tid >> 6), lane = tid & 63, wr = wid >> 2, wc = wid & 3, fr = lane & 15, fq = lane >> 4;
    const size_t kstep = (size_t)(BK * 2);
    const unsigned ldsw = (unsigned)wid * 1024u;
    const int aoff = lds_byte(wr * 64 + fr, fq * 8), boff = lds_byte(wc * 32 + fr, fq * 8);
#define PG_SA(b, h) (((b) * 2 + (h)) * HTB)
#define PG_SB(b, h) ((4 + (b) * 2 + (h)) * HTB)
#define PG_STAGE(bufoff, gbase, voff, ld2) do { \
        __builtin_amdgcn_global_load_lds((const unsigned*)((const char*)(gbase) + (voff)), (LAS unsigned*)(lds + (bufoff) + ldsw), 16, 0, 0); \
        __builtin_amdgcn_global_load_lds((const unsigned*)((const char*)(gbase) + (size_t)64 * (ld2) + (voff)), (LAS unsigned*)(lds + (bufoff) + ldsw + 8192), 16, 0, 0); } while (0)
#define PG_LDA(dst, b, h) do { _Pragma("unroll") for (int m = 0; m < 4; ++m) _Pragma("unroll") for (int k = 0; k < 2; ++k) dst[m][k] = *(const LAS bf16x8*)(lds + PG_SA(b, h) + aoff + m * 2048 + k * 1024); } while (0)
#define PG_LDB(dst, b, h) do { _Pragma("unroll") for (int n = 0; n < 2; ++n) _Pragma("unroll") for (int k = 0; k < 2; ++k) dst[n][k] = *(const LAS bf16x8*)(lds + PG_SB(b, h) + boff + n * 2048 + k * 1024); } while (0)
#define PG_MMA(ai, bj, At, Bt) do { __builtin_amdgcn_s_setprio(1); _Pragma("unroll") for (int m = 0; m < 4; ++m) _Pragma("unroll") for (int n = 0; n < 2; ++n) _Pragma("unroll") for (int k = 0; k < 2; ++k) \
        acc[ai][bj][m][n] = __builtin_amdgcn_mfma_f32_16x16x32_bf16(Bt[n][k], At[m][k], acc[ai][bj][m][n], 0, 0, 0); __builtin_amdgcn_s_setprio(0); } while (0)
#define PG_WAIT_V(n) asm volatile("s_waitcnt vmcnt(" #n ")" ::: "memory")
#define PG_WAIT_L(n) asm volatile("s_waitcnt lgkmcnt(" #n ")" ::: "memory")
#define PG_BAR __builtin_amdgcn_s_barrier()
#define PG_SCHED __builtin_amdgcn_sched_barrier(0)
#define PG_BODY(a1, vA1, la1, a2, b2, vA2, vB2, la2, lb2) do { \
            const size_t hA1 = (size_t)128 * (la1), hA2 = (size_t)128 * (la2), hB2 = (size_t)128 * (lb2); \
            const char* a3 = (a2) + kstep; const char* b3 = (b2) + kstep; \
            PG_LDB(B0, 0, 0); PG_LDB(B1, 0, 1); PG_SCHED; PG_LDA(At, 0, 0); PG_STAGE(PG_SA(1, 1), (a1) + hA1, vA1, la1); \
            PG_WAIT_V(8); PG_WAIT_L(0); PG_BAR; PG_MMA(0, 0, At, B0); PG_MMA(0, 1, At, B1); PG_BAR; PG_SCHED; \
            PG_LDA(At, 0, 1); PG_STAGE(PG_SB(0, 0), (b2), vB2, lb2); PG_STAGE(PG_SB(0, 1), (b2) + hB2, vB2, lb2); PG_STAGE(PG_SA(0, 0), (a2), vA2, la2); \
            PG_WAIT_V(8); PG_WAIT_L(0); PG_BAR; PG_MMA(1, 0, At, B0); PG_MMA(1, 1, At, B1); PG_BAR; PG_SCHED; \
            PG_LDB(B0, 1, 0); PG_LDB(B1, 1, 1); PG_SCHED; PG_LDA(At, 1, 0); PG_STAGE(PG_SA(0, 1), (a2) + hA2, vA2, la2); \
            PG_WAIT_V(8); PG_WAIT_L(0); PG_BAR; PG_MMA(0, 0, At, B0); PG_MMA(0, 1, At, B1); PG_BAR; PG_SCHED; \
            PG_LDA(At, 1, 1); PG_STAGE(PG_SB(1, 0), b3, vB2, lb2); PG_STAGE(PG_SB(1, 1), b3 + hB2, vB2, lb2); PG_STAGE(PG_SA(1, 0), a3, vA2, la2); \
            PG_WAIT_V(8); PG_WAIT_L(0); PG_BAR; PG_MMA(1, 0, At, B0); PG_MMA(1, 1, At, B1); PG_BAR; PG_SCHED; } while (0)
    GUnit cur, nxt; int ui = 0;
    if (!S.next(0, cur)) return;
    f32x4 acc[2][2][4][2];
#pragma unroll
    for (int a = 0; a < 2; ++a)
#pragma unroll
        for (int b = 0; b < 2; ++b)
#pragma unroll
            for (int m = 0; m < 4; ++m)
#pragma unroll
                for (int n = 0; n < 2; ++n) acc[a][b][m][n] = (f32x4){0.f, 0.f, 0.f, 0.f};
    bf16x8 At[4][2], B0[2][2], B1[2][2];
    unsigned vAc, vBc;
    { int R0, C0; stage_rc(tid * 16, R0, C0); const int Rb0 = (R0 & ~31) + perm32(R0 & 31); vAc = (unsigned)R0 * cur.lda2 + (unsigned)C0 * 2u; vBc = (unsigned)Rb0 * cur.ldb2 + (unsigned)C0 * 2u; }
    {
        const char* cA = cur.A; const char* cB = cur.B; const size_t hA = (size_t)128 * cur.lda2, hB = (size_t)128 * cur.ldb2;
        PG_STAGE(PG_SB(0, 0), cB, vBc, cur.ldb2); PG_STAGE(PG_SB(0, 1), cB + hB, vBc, cur.ldb2); PG_STAGE(PG_SA(0, 0), cA, vAc, cur.lda2); PG_STAGE(PG_SA(0, 1), cA + hA, vAc, cur.lda2);
        if (wr == 1) PG_BAR;
        PG_WAIT_V(2); PG_BAR;
        PG_STAGE(PG_SB(1, 0), cB + kstep, vBc, cur.ldb2); PG_STAGE(PG_SA(1, 0), cA + kstep, vAc, cur.lda2); PG_STAGE(PG_SB(1, 1), cB + hB + kstep, vBc, cur.ldb2);
        PG_WAIT_V(6); PG_BAR;
    }
    for (;;) {
        const bool has_next = S.next(ui + 1, nxt);
        if (!has_next) nxt = cur;
        const int nt = cur.nt;
        const char* cA = cur.A; const char* cB = cur.B;
        for (int t = 0; t < nt - 2; t += 2)
            PG_BODY(cA + (size_t)(t + 1) * kstep, vAc, cur.lda2, cA + (size_t)(t + 2) * kstep, cB + (size_t)(t + 2) * kstep, vAc, vBc, cur.lda2, cur.ldb2);
        unsigned vAn, vBn;
        { int t2 = tid; asm volatile("" : "+v"(t2)); int R0, C0; stage_rc(t2 * 16, R0, C0); const int Rb0 = (R0 & ~31) + perm32(R0 & 31);
          vAn = (unsigned)R0 * nxt.lda2 + (unsigned)C0 * 2u; vBn = (unsigned)Rb0 * nxt.ldb2 + (unsigned)C0 * 2u; }
        PG_BODY(cA + (size_t)(nt - 1) * kstep, vAc, cur.lda2, nxt.A, nxt.B, vAn, vBn, nxt.lda2, nxt.ldb2);
        if (wr == 0) PG_BAR;
        E(acc, cur, wr, wc, fr, fq);
        if (!has_next) break;
#pragma unroll
        for (int a = 0; a < 2; ++a)
#pragma unroll
            for (int b = 0; b < 2; ++b)
#pragma unroll
                for (int m = 0; m < 4; ++m)
#pragma unroll
                    for (int n = 0; n < 2; ++n) acc[a][b][m][n] = (f32x4){0.f, 0.f, 0.f, 0.f};
        cur = nxt; vAc = vAn; vBc = vBn; ++ui;
        if (wr == 1) PG_BAR;
    }
    PG_WAIT_V(0);
    PG_BAR;
#undef PG_SA
#undef PG_SB
#undef PG_STAGE
#undef PG_LDA
#undef PG_LDB
#undef PG_MMA
#undef PG_WAIT_V
#undef PG_WAIT_L
#undef PG_BAR
#undef PG_SCHED
#undef PG_BODY
}

#define EPI_LOOP(...) \
    _Pragma("unroll") for (int ai = 0; ai < 2; ++ai) _Pragma("unroll") for (int m = 0; m < 4; ++m) _Pragma("unroll") for (int bj = 0; bj < 2; ++bj) { \
        const int row = u.pm * 256 + ai * 128 + wr * 64 + m * 16 + fr; const int tcol = bj * 128 + wc * 32 + 8 * fq; \
        const f32x4 v0 = acc[ai][bj][m][0], v1 = acc[ai][bj][m][1]; float v[8] = {v0[0], v0[1], v0[2], v0[3], v1[0], v1[1], v1[2], v1[3]}; __VA_ARGS__ }

struct EpiIn {
    bf16_t *prw, *ppool, *pconv, *patt;
    __device__ __forceinline__ void operator()(const f32x4 (&acc)[2][2][4][2], const GUnit& u, int wr, int wc, int fr, int fq) const {
        asm volatile("" : "+v"(fr), "+v"(fq));
        bf16_t* base; int ld, ct;
        if (u.pn < 7) { base = prw; ld = 1792; ct = u.pn; } else if (u.pn < 9) { base = ppool; ld = 512; ct = u.pn - 7; }
        else if (u.pn < 15) { base = pconv; ld = 1536; ct = u.pn - 9; } else { base = patt; ld = 768; ct = u.pn - 15; }
        EPI_LOOP({ *(u32x4*)(base + (size_t)row * ld + ct * 256 + tcol) = pack8(v); })
    }
};
struct EpiLora {
    bf16_t* out; const float* w0; const float* a0;
    __device__ __forceinline__ void operator()(const f32x4 (&acc)[2][2][4][2], const GUnit& u, int wr, int wc, int fr, int fq) const {
        asm volatile("" : "+v"(fr), "+v"(fq));
        const float* bias = u.pn < 2 ? w0 + u.pn * 256 : a0 + (u.pn - 2) * 256;
        const bool sg = u.pn < 4;
        EPI_LOOP({ if (sg) { float bv[8]; ld8f(bias + tcol, bv); _Pragma("unroll") for (int j = 0; j < 8; ++j) v[j] = sigmoidf_(v[j] + bv[j]); }
                   *(u32x4*)(out + (size_t)row * 1536 + u.pn * 256 + tcol) = pack8(v); })
    }
};
struct EpiBR {
    u32x4* scr; bf16_t* mixed;
    __device__ __forceinline__ void operator()(const f32x4 (&acc)[2][2][4][2], const GUnit& u, int wr, int wc, int fr, int fq) const {
        asm volatile("" : "+v"(fr), "+v"(fq));
        const bool gate = (u.aux & 1) == 0; const bool first = (u.aux >> 1) == 0;
        EPI_LOOP({ u32x4* sp = scr + ((ai * 4 + m) * 2 + bj) * 512 + ((wr * 4 + wc) * 64 + fq * 16 + fr);
                   if (gate) { _Pragma("unroll") for (int j = 0; j < 8; ++j) v[j] = sigmoidf_(v[j]); *sp = pack8(v); }
                   else { float g[8]; unpack8(*sp, g); bf16_t* mp = mixed + (size_t)row * 1024 + u.pn * 256 + tcol;
                          _Pragma("unroll") for (int j = 0; j < 8; ++j) v[j] *= g[j];
                          if (!first) { float o[8]; unpack8(*(const u32x4*)mp, o); _Pragma("unroll") for (int j = 0; j < 8; ++j) v[j] += o[j]; }
                          *(u32x4*)mp = pack8(v); } })
    }
};
struct EpiRes {
    const float* base; float* out;
    __device__ __forceinline__ void operator()(const f32x4 (&acc)[2][2][4][2], const GUnit& u, int wr, int wc, int fr, int fq) const {
        asm volatile("" : "+v"(fr), "+v"(fq));
        EPI_LOOP({ const size_t off = (size_t)row * 1024 + u.pn * 256 + tcol; const f32x4 b0 = *(const f32x4*)(base + off), b1 = *(const f32x4*)(base + off + 4);
                   *(f32x4*)(out + off) = (f32x4){b0[0] + v[0], b0[1] + v[1], b0[2] + v[2], b0[3] + v[3]}; *(f32x4*)(out + off + 4) = (f32x4){b1[0] + v[4], b1[1] + v[5], b1[2] + v[6], b1[3] + v[7]}; })
    }
};
struct EpiGU {
    bf16_t* act;
    __device__ __forceinline__ void operator()(const f32x4 (&acc)[2][2][4][2], const GUnit& u, int wr, int wc, int fr, int fq) const {
        asm volatile("" : "+v"(fr), "+v"(fq));
#pragma unroll
        for (int ai = 0; ai < 2; ++ai)
#pragma unroll
            for (int m = 0; m < 4; ++m) {
                const int row = u.pm * 256 + ai * 128 + wr * 64 + m * 16 + fr; const int col = u.pn * 128 + wc * 32 + 8 * fq;
                const f32x4 g0 = acc[ai][0][m][0], g1 = acc[ai][0][m][1], u0 = acc[ai][1][m][0], u1 = acc[ai][1][m][1];
                float v[8];
#pragma unroll
                for (int j = 0; j < 4; ++j) { v[j] = g0[j] * sigmoidf_(g0[j]) * u0[j]; v[4 + j] = g1[j] * sigmoidf_(g1[j]) * u1[j]; }
                *(u32x4*)(act + (size_t)row * DFF + col) = pack8(v);
            }
    }
};
}

__device__ __forceinline__ float wave_sum(float v) {
#pragma unroll
    for (int o = 1; o < 64; o <<= 1) v += __shfl_xor(v, o);
    return v;
}
__device__ __forceinline__ void transpose_item(const float* W, int ldw, int k0, int n0, bf16_t* WT, int drow0, int ldd, int dk0, LAS float* scr, int lane) {
#pragma unroll 8
    for (int i = 0; i < 32; ++i) { const int kk = 2 * i + (lane >> 5); scr[kk * 33 + (lane & 31)] = W[(size_t)(k0 + kk) * ldw + n0 + (lane & 31)]; }
    asm volatile("s_waitcnt lgkmcnt(0)" ::: "memory");
    const int c = lane & 7;
#pragma unroll
    for (int j = 0; j < 4; ++j) { const int n = (lane >> 3) + 8 * j; const LAS float* s = scr + (8 * c) * 33 + n;
        u32x4 o; o.x = cvt_pk_bf16(s[0 * 33], s[1 * 33]); o.y = cvt_pk_bf16(s[2 * 33], s[3 * 33]); o.z = cvt_pk_bf16(s[4 * 33], s[5 * 33]); o.w = cvt_pk_bf16(s[6 * 33], s[7 * 33]);
        *(u32x4*)(WT + (size_t)(drow0 + n) * ldd + dk0 + k0 + 8 * c) = o; }
    asm volatile("s_waitcnt lgkmcnt(0)" ::: "memory");
}

__device__ __forceinline__ void prologue_phase(const Params& p, LAS unsigned char* lds) {
    const int tid = tid_(), lane = tid & 63, wave = __builtin_amdgcn_readfirstlane(tid >> 6);
    const int G = gridDim.x; const int gw = bid_() * 8 + wave, NGW = G * 8;
    LAS float* scr = (LAS float*)(lds + wave * 8448);
    bf16_t* Wb = (bf16_t*)(p.ws + WS_W);
    constexpr int PER_LAYER = 4352 + 16 + 16 + 32 + 256 * 3 + 512 + 1408 * 3;
    for (int it = gw; it < NL * PER_LAYER; it += NGW) {
        const int l = it / PER_LAYER; int r = it % PER_LAYER;
        bf16_t* wl = Wb + (size_t)l * LW_ELEMS;
        const float* src; int K, N, ldd, dk0 = 0, mode = 0; bf16_t* dst; int rowoff = 0;
        if (r < 4352) { src = (const float*)p.in[3] + (size_t)l * 1024 * INC; K = 1024; N = INC; dst = wl + OW_IN; ldd = 1024; }
        else if ((r -= 4352) < 16) { src = (const float*)p.in[5] + (size_t)l * 64 * 512; K = 64; N = 512; dst = wl + OW_LORA; ldd = 256; }
        else if ((r -= 16) < 16) { src = (const float*)p.in[7] + (size_t)l * 64 * 512; K = 64; N = 512; dst = wl + OW_LORA; ldd = 256; rowoff = 512; dk0 = 64; }
        else if ((r -= 16) < 32) { src = (const float*)p.in[9] + (size_t)l * 128 * 512; K = 128; N = 512; dst = wl + OW_LORA; ldd = 256; rowoff = 1024; dk0 = 128; }
        else if ((r -= 32) < 256) { src = (const float*)p.in[15] + (size_t)l * 512 * 1024; K = 512; N = 1024; dst = wl + OW_BR; ldd = 512; }
        else if ((r -= 256) < 256) { src = (const float*)p.in[20] + (size_t)l * 512 * 1024; K = 512; N = 1024; dst = wl + OW_BR + 2 * 524288; ldd = 512; }
        else if ((r -= 256) < 256) { src = (const float*)p.in[24] + (size_t)l * 512 * 1024; K = 512; N = 1024; dst = wl + OW_BR + 3 * 524288; ldd = 512; }
        else if ((r -= 256) < 512) { src = (const float*)p.in[25] + (size_t)l * 1024 * 1024; K = 1024; N = 1024; dst = wl + OW_O; ldd = 1024; }
        else if ((r -= 512) < 1408) { src = (const float*)p.in[27] + (size_t)l * 1024 * DFF; K = 1024; N = DFF; dst = wl + OW_GU; ldd = 1024; mode = 1; }
        else if ((r -= 1408) < 1408) { src = (const float*)p.in[28] + (size_t)l * 1024 * DFF; K = 1024; N = DFF; dst = wl + OW_GU; ldd = 1024; mode = 2; }
        else { r -= 1408; src = (const float*)p.in[29] + (size_t)l * DFF * 1024; K = DFF; N = 1024; dst = wl + OW_D; ldd = DFF; }
        const int nblk = N / 32, kb = r / nblk, nb = r % nblk, n0 = nb * 32;
        int drow0 = rowoff + n0;
        if (mode) drow0 = (n0 >> 7) * 256 + (n0 & 127) + (mode == 2 ? 128 : 0);
        transpose_item(src, N, kb * 64, n0, dst, drow0, ldd, dk0, scr, lane);
    }
    const int gt = bid_() * NTHR + tid, NGT = G * NTHR;
    for (int idx = gt; idx < NL * 1536 * 32; idx += NGT) {
        const int l = idx / (1536 * 32), r = idx % (1536 * 32), row = r >> 5, kc = (r & 31) * 8;
        const bool diag = row < 512 ? (kc < 64) : row < 1024 ? (kc >= 64 && kc < 128) : (kc >= 128);
        if (!diag) *(u32x4*)(Wb + (size_t)l * LW_ELEMS + OW_LORA + (size_t)row * 256 + kc) = (u32x4){0u, 0u, 0u, 0u};
    }
    for (int idx = gt; idx < NL * 1024 * 64; idx += NGT) {
        const int l = idx >> 16, r = idx & 65535, n = r & 1023, k0 = (r >> 10) * 8, g = k0 >> 7;
        const float* pw = (const float*)p.in[16] + (size_t)l * 65536 + (size_t)g * 16384 + (size_t)(k0 & 127) * 128;
        const float* sc = (const float*)p.in[17] + l * 512 + g * 128;
        const float* wo = (const float*)p.in[18] + (size_t)l * 512 * 1024 + (size_t)g * 128 * 1024 + n;
        float a[8] = {0.f, 0.f, 0.f, 0.f, 0.f, 0.f, 0.f, 0.f};
        for (int j = 0; j < 128; ++j) { const float w = sc[j] * wo[(size_t)j * 1024];
#pragma unroll
            for (int i = 0; i < 8; ++i) a[i] += pw[i * 128 + j] * w; }
        *(u32x4*)(Wb + (size_t)l * LW_ELEMS + OW_BR + 524288 + (size_t)n * 512 + k0) = pack8(a);
    }
    _Float16* rope = (_Float16*)(p.ws + WS_ROPE);
    const int* pos = (const int*)p.in[1];
    for (int idx = gt; idx < MTOK * 32; idx += NGT) {
        const int m = idx >> 5, i = idx & 31;
        const float inv = powf(10000.0f, -(float)i * 2.0f / 64.0f);
        const float ang = (float)pos[m] * inv;
        rope[(size_t)m * 64 + i] = (_Float16)cosf(ang); rope[(size_t)m * 64 + 32 + i] = (_Float16)sinf(ang);
    }
}

__device__ __forceinline__ void norm_phase(const float* x, const float* g, bf16_t* out) {
    const int tid = tid_(), lane = tid & 63, wave = tid >> 6;
    f32x4 gv[4];
#pragma unroll
    for (int j = 0; j < 4; ++j) gv[j] = *((const f32x4*)g + lane + 64 * j);
    for (int m = bid_() * 8 + wave; m < MTOK; m += gridDim.x * 8) {
        const f32x4* xr = (const f32x4*)(x + (size_t)m * DM) + lane;
        f32x4 v[4]; float s = 0.f;
#pragma unroll
        for (int j = 0; j < 4; ++j) { v[j] = xr[64 * j]; s += (v[j].x * v[j].x + v[j].y * v[j].y) + (v[j].z * v[j].z + v[j].w * v[j].w); }
        const float rstd = 1.0f / sqrtf(wave_sum(s) * (1.0f / DM) + 1e-6f);
        u32x2* o = (u32x2*)(out + (size_t)m * DM) + lane;
#pragma unroll
        for (int j = 0; j < 4; ++j) { u32x2 w; w.x = cvt_pk_bf16(v[j].x * rstd * gv[j].x, v[j].y * rstd * gv[j].y); w.y = cvt_pk_bf16(v[j].z * rstd * gv[j].z, v[j].w * rstd * gv[j].w); o[64 * j] = w; }
    }
}

__device__ __forceinline__ u32x4 qk_prep(const u32x4 raw, const float* g, const _Float16* rp, int c, float scale) {
    float x[8]; unpack8(raw, x);
    float ss = 0.f;
#pragma unroll
    for (int j = 0; j < 8; ++j) ss += x[j] * x[j];
    ss = dpp_sum8(ss);
    const float rstd = 1.0f / sqrtf(ss * (1.0f / 64.0f) + 1e-6f);
    float gg[8]; ld8f(g + c * 8, gg);
    const int ci = (c & 3) * 8;
    float o[8];
#pragma unroll
    for (int j = 0; j < 8; ++j) {
        const float y = x[j] * rstd * gg[j];
        const float pr = __shfl_xor(y, 4);
        const float cs = (float)rp[ci + j], sn = (float)rp[32 + ci + j];
        o[j] = (c < 4 ? y * cs - pr * sn : y * cs + pr * sn) * scale;
    }
    return pack8(o);
}

__device__ __forceinline__ void attn_item(const Params& p, int l, int item, LAS unsigned char* lds) {
    const int tid = tid_(), lane = tid & 63, wave = __builtin_amdgcn_readfirstlane(tid >> 6), fr = lane & 15, fq = lane >> 4;
    const int b = item >> 6, kvh = (item >> 5) & 1, nbk = item & 31;
    const int tok0 = b * SEQ + nbk * 128;
    const bf16_t* PATT = (const bf16_t*)(p.ws + WS_PATT);
    bf16_t* M3 = (bf16_t*)(p.ws + WS_M3);
    const _Float16* rope = (const _Float16*)(p.ws + WS_ROPE);
    const float* qg = (const float*)p.in[21] + l * 64; const float* kg = (const float*)p.in[22] + l * 64;
    LAS bf16_t* Ks = (LAS bf16_t*)lds;
    LAS bf16_t* Vt = (LAS bf16_t*)(lds + 36864);
    LAS bf16_t* Qs = (LAS bf16_t*)(lds + 70656);
    const int c = tid & 7;
#pragma unroll 1
    for (int pass = 0; pass < 4; ++pass) {
        const int row = pass * 64 + (tid >> 3); const int tokk = tok0 - 128 + row; const bool valid = (nbk > 0) || (row >= 128);
        u32x4 kraw = (u32x4){0u, 0u, 0u, 0u}, vraw = kraw;
        const int tk = valid ? tokk : tok0;
        if (valid) { kraw = ld16(PATT + (size_t)tokk * 768 + 512 + kvh * 64 + c * 8); vraw = ld16(PATT + (size_t)tokk * 768 + 640 + kvh * 64 + c * 8); }
        const u32x4 kp = qk_prep(kraw, kg, rope + (size_t)tk * 64, c, 1.0f);
        *(LAS u32x4*)(Ks + row * 72 + c * 8) = kp;
        LAS bf16_t* vp = Vt + (c * 8) * 264 + row;
        vp[0 * 264] = (bf16_t)(vraw.x & 0xffffu); vp[1 * 264] = (bf16_t)(vraw.x >> 16); vp[2 * 264] = (bf16_t)(vraw.y & 0xffffu); vp[3 * 264] = (bf16_t)(vraw.y >> 16);
        vp[4 * 264] = (bf16_t)(vraw.z & 0xffffu); vp[5 * 264] = (bf16_t)(vraw.z >> 16); vp[6 * 264] = (bf16_t)(vraw.w & 0xffffu); vp[7 * 264] = (bf16_t)(vraw.w >> 16);
    }
#pragma unroll 1
    for (int pass = 0; pass < 8; ++pass) {
        const int row = pass * 64 + (tid >> 3); const int g = row >> 7, ql = row & 127; const int tokq = tok0 + ql; const int hq = kvh * 4 + g;
        const u32x4 qraw = ld16(PATT + (size_t)tokq * 768 + hq * 64 + c * 8);
        *(LAS u32x4*)(Qs + row * 72 + c * 8) = qk_prep(qraw, qg, rope + (size_t)tokq * 64, c, 0.125f);
    }
    __syncthreads();
    const int g = wave >> 1; const int hq = kvh * 4 + g;
    const float sink = ((const float*)p.in[23])[l * 8 + hq];
#pragma unroll 1
    for (int pp = 0; pp < 2; ++pp) {
        const int ql0 = (wave & 1) * 64 + pp * 32;
        f32x4 sacc[10][2];
#pragma unroll
        for (int n = 0; n < 10; ++n) { sacc[n][0] = (f32x4){0.f, 0.f, 0.f, 0.f}; sacc[n][1] = sacc[n][0]; }
#pragma unroll
        for (int kk2 = 0; kk2 < 2; ++kk2) {
            const bf16x8 q0 = *(const LAS bf16x8*)(Qs + (g * 128 + ql0 + fr) * 72 + 32 * kk2 + 8 * fq);
            const bf16x8 q1 = *(const LAS bf16x8*)(Qs + (g * 128 + ql0 + 16 + fr) * 72 + 32 * kk2 + 8 * fq);
#pragma unroll
            for (int n = 0; n < 10; ++n) {
                const bf16x8 kf = *(const LAS bf16x8*)(Ks + (ql0 + 16 * n + fr) * 72 + 32 * kk2 + 8 * fq);
                sacc[n][0] = __builtin_amdgcn_mfma_f32_16x16x32_bf16(kf, q0, sacc[n][0], 0, 0, 0);
                sacc[n][1] = __builtin_amdgcn_mfma_f32_16x16x32_bf16(kf, q1, sacc[n][1], 0, 0, 0);
            }
        }
        u32x2 pb[10][2];
#pragma unroll
        for (int mq = 0; mq < 2; ++mq) {
            const int qi = 128 + ql0 + 16 * mq + fr;
            float mx = -__builtin_inff();
#pragma unroll
            for (int n = 0; n < 10; ++n)
#pragma unroll
                for (int j = 0; j < 4; ++j) {
                    const int kj = ql0 + 16 * n + 4 * fq + j; const int dist = qi - kj;
                    const bool ok = (dist >= 0) && (dist < 128) && ((nbk > 0) || (kj >= 128));
                    const float s = ok ? sacc[n][mq][j] : -__builtin_inff();
                    sacc[n][mq][j] = s; mx = fmaxf(mx, s);
                }
            mx = fmaxf(mx, __shfl_xor(mx, 16)); mx = fmaxf(mx, __shfl_xor(mx, 32));
            const float mf = fmaxf(mx, sink);
            float sum = 0.f;
#pragma unroll
            for (int n = 0; n < 10; ++n)
#pragma unroll
                for (int j = 0; j < 4; ++j) { const float e = __expf(sacc[n][mq][j] - mf); sacc[n][mq][j] = e; sum += e; }
            sum += __shfl_xor(sum, 16); sum += __shfl_xor(sum, 32);
            const float inv = 1.0f / (sum + __expf(sink - mf));
#pragma unroll
            for (int n = 0; n < 10; ++n) { pb[n][mq].x = cvt_pk_bf16(sacc[n][mq][0] * inv, sacc[n][mq][1] * inv); pb[n][mq].y = cvt_pk_bf16(sacc[n][mq][2] * inv, sacc[n][mq][3] * inv); }
        }
        f32x4 oacc[4][2];
#pragma unroll
        for (int dt = 0; dt < 4; ++dt) { oacc[dt][0] = (f32x4){0.f, 0.f, 0.f, 0.f}; oacc[dt][1] = oacc[dt][0]; }
#pragma unroll
        for (int kc = 0; kc < 5; ++kc) {
            const u32x4 p0 = (u32x4){pb[2 * kc][0].x, pb[2 * kc][0].y, pb[2 * kc + 1][0].x, pb[2 * kc + 1][0].y};
            const u32x4 p1 = (u32x4){pb[2 * kc][1].x, pb[2 * kc][1].y, pb[2 * kc + 1][1].x, pb[2 * kc + 1][1].y};
#pragma unroll
            for (int dt = 0; dt < 4; ++dt) {
                const LAS bf16_t* vrow = Vt + (16 * dt + fr) * 264 + ql0 + 32 * kc + 4 * fq;
                const u32x2 va = *(const LAS u32x2*)vrow, vb = *(const LAS u32x2*)(vrow + 16);
                const u32x4 vv = (u32x4){va.x, va.y, vb.x, vb.y};
                oacc[dt][0] = __builtin_amdgcn_mfma_f32_16x16x32_bf16(__builtin_bit_cast(bf16x8, vv), __builtin_bit_cast(bf16x8, p0), oacc[dt][0], 0, 0, 0);
                oacc[dt][1] = __builtin_amdgcn_mfma_f32_16x16x32_bf16(__builtin_bit_cast(bf16x8, vv), __builtin_bit_cast(bf16x8, p1), oacc[dt][1], 0, 0, 0);
            }
        }
#pragma unroll
        for (int mq = 0; mq < 2; ++mq)
#pragma unroll
            for (int dt = 0; dt < 4; ++dt) {
                const int ql = ql0 + 16 * mq + fr;
                u32x2 w; w.x = cvt_pk_bf16(oacc[dt][mq][0], oacc[dt][mq][1]); w.y = cvt_pk_bf16(oacc[dt][mq][2], oacc[dt][mq][3]);
                *(u32x2*)(M3 + (size_t)(tok0 + ql) * 1536 + 1024 + hq * 64 + 16 * dt + 4 * fq) = w;
            }
    }
    __syncthreads();
}

__device__ __forceinline__ void mix1_phase(const Params& p, int l, LAS unsigned char* lds) {
    const int tid = tid_(), G = gridDim.x;
    for (int item = bid_(); item < 1024; item += G) attn_item(p, l, item, lds);
    const int gt = bid_() * NTHR + tid, NGT = G * NTHR;
    const bf16_t* PRW = (const bf16_t*)(p.ws + WS_PRW); const bf16_t* PPOOL = (const bf16_t*)(p.ws + WS_PPOOL); const bf16_t* PCONV = (const bf16_t*)(p.ws + WS_PCONV);
    bf16_t* M3 = (bf16_t*)(p.ws + WS_M3); bf16_t* AL = (bf16_t*)(p.ws + WS_ALORA);
    const float* mu = (const float*)p.in[4] + l * RWC;
    for (int idx = gt; idx < MTOK * 32; idx += NGT) {
        const int m = idx >> 5, c8 = (idx & 31) * 8, t = m & (SEQ - 1);
        float cur[8], prv[8], mm[8], o[8];
        unpack8(ld16(PRW + (size_t)m * RWC + 1536 + c8), cur);
        if (t > 0) unpack8(ld16(PRW + (size_t)(m - 1) * RWC + 1536 + c8), prv); else { _Pragma("unroll") for (int j = 0; j < 8; ++j) prv[j] = 0.f; }
        ld8f(mu + 1536 + c8, mm);
#pragma unroll
        for (int j = 0; j < 8; ++j) { const float s = cur[j] + (prv[j] - cur[j]) * mm[j];
            o[j] = c8 < 64 ? (1.0f - 2.0f / (__expf(2.0f * s) + 1.0f)) : (c8 < 128 ? s : sigmoidf_(s)); }
        *(u32x4*)(AL + (size_t)m * 256 + c8) = pack8(o);
    }
    const float* cw = (const float*)p.in[19] + l * 3 * 512;
    for (int idx = gt; idx < MTOK * 64; idx += NGT) {
        const int m = idx >> 6, c8 = (idx & 63) * 8, t = m & (SEQ - 1);
        float bg[8], a[8] = {0.f, 0.f, 0.f, 0.f, 0.f, 0.f, 0.f, 0.f};
        unpack8(ld16(PCONV + (size_t)m * 1536 + c8), bg);
#pragma unroll
        for (int k = 0; k < 3; ++k) {
            if (t - 2 + k >= 0) { float cc[8], uu[8], ww[8];
                unpack8(ld16(PCONV + (size_t)(m - 2 + k) * 1536 + 512 + c8), cc); unpack8(ld16(PCONV + (size_t)(m - 2 + k) * 1536 + 1024 + c8), uu); ld8f(cw + k * 512 + c8, ww);
#pragma unroll
                for (int j = 0; j < 8; ++j) a[j] += ww[j] * (cc[j] * uu[j]); }
        }
#pragma unroll
        for (int j = 0; j < 8; ++j) a[j] *= bg[j];
        *(u32x4*)(M3 + (size_t)m * 1536 + 512 + c8) = pack8(a);
    }
    for (int idx = gt; idx < MTOK * 64; idx += NGT) {
        const int m = idx >> 6, c8 = (idx & 63) * 8, t = m & (SEQ - 1);
        const int win = 2 << (c8 >> 7);
        float u0[8], s[8];
        unpack8(ld16(PPOOL + (size_t)m * 512 + c8), u0);
#pragma unroll
        for (int j = 0; j < 8; ++j) s[j] = u0[j];
        for (int d = 1; d < win; ++d) { if (t - d >= 0) { float uu[8]; unpack8(ld16(PPOOL + (size_t)(m - d) * 512 + c8), uu);
#pragma unroll
                for (int j = 0; j < 8; ++j) s[j] += uu[j]; } }
        const float ic = 1.0f / (float)(t + 1 < win ? t + 1 : win);
#pragma unroll
        for (int j = 0; j < 8; ++j) s[j] = s[j] * ic - u0[j];
        *(u32x4*)(M3 + (size_t)m * 1536 + c8) = pack8(s);
    }
}

constexpr int TC = 32, NCH = SEQ / TC, SROW = 352;
__device__ __forceinline__ void scan_phase(const Params& p, int l, LAS unsigned char* lds) {
    const int tid = tid_(), lane = tid & 63, wave = __builtin_amdgcn_readfirstlane(tid >> 6);
    const bf16_t* PRW = (const bf16_t*)(p.ws + WS_PRW); const bf16_t* LORA = (const bf16_t*)(p.ws + WS_LORA);
    bf16_t* YRAW = (bf16_t*)(p.ws + WS_YRAW); float* BONUS = (float*)(p.ws + WS_BONUS);
    LAS float* inb = (LAS float*)lds;
    LAS float* yb = inb + 2 * TC * SROW;
    for (int item = bid_(); item < 256; item += gridDim.x) {
        const int chain = item >> 1, half = item & 1, b = chain >> 3, head = chain & 7;
        const int pt = tid - 256, t_l = (pt >> 3) & 31, cgi = pt & 7, c0 = cgi * 8, ch = head * 64 + c0;
        float mur[8], muk[8], muv[8], kkc[8], kac[8], rkc[8];
        if (wave >= 4) {
            const float* mu = (const float*)p.in[4] + l * RWC;
            ld8f(mu + ch, mur); ld8f(mu + 512 + ch, muk); ld8f(mu + 1024 + ch, muv);
            ld8f((const float*)p.in[10] + l * 512 + ch, kkc); ld8f((const float*)p.in[11] + l * 512 + ch, kac); ld8f((const float*)p.in[12] + l * 512 + ch, rkc);
        }
        const int row_l = lane >> 3, seg = lane & 7, rr = (wave & 3) * 8 + row_l;
        f32x2 S0 = (f32x2){0.f, 0.f}, S1 = S0, S2 = S0, S3 = S0;
#pragma unroll 1
        for (int n = 0; n <= NCH + 1; ++n) {
            if (wave >= 4) {
                if (n >= 2) {
                    const LAS float* ys = yb + (n & 1) * TC * 32 + t_l * 32 + cgi * 4;
                    const f32x4 yv = *(const LAS f32x4*)ys;
                    u32x2 w; w.x = cvt_pk_bf16(yv[0], yv[1]); w.y = cvt_pk_bf16(yv[2], yv[3]);
                    *(u32x2*)(YRAW + (size_t)(b * SEQ + (n - 2) * TC + t_l) * 512 + head * 64 + half * 32 + cgi * 4) = w;
                }
                if (n < NCH) {
                    const int t = n * TC + t_l; const size_t m = (size_t)b * SEQ + t;
                    float r[8], k[8], v[8], rp[8], kp[8], vp[8], sl[8], al[8];
                    unpack8(ld16(PRW + m * RWC + ch), r); unpack8(ld16(PRW + m * RWC + 512 + ch), k); unpack8(ld16(PRW + m * RWC + 1024 + ch), v);
                    if (t > 0) { unpack8(ld16(PRW + (m - 1) * RWC + ch), rp); unpack8(ld16(PRW + (m - 1) * RWC + 512 + ch), kp); unpack8(ld16(PRW + (m - 1) * RWC + 1024 + ch), vp); }
                    else { _Pragma("unroll") for (int j = 0; j < 8; ++j) { rp[j] = 0.f; kp[j] = 0.f; vp[j] = 0.f; } }
                    unpack8(ld16(LORA + m * 1536 + ch), sl); unpack8(ld16(LORA + m * 1536 + 512 + ch), al);
                    float kkr[8], ss = 0.f, bon = 0.f, dec[8], kpr[8];
#pragma unroll
                    for (int j = 0; j < 8; ++j) {
                        r[j] = r[j] + (rp[j] - r[j]) * mur[j]; k[j] = k[j] + (kp[j] - k[j]) * muk[j]; v[j] = v[j] + (vp[j] - v[j]) * muv[j];
                        dec[j] = __expf(-0.6065306597126334f * sl[j]);
                        kkr[j] = k[j] * kkc[j]; ss += kkr[j] * kkr[j];
                        kpr[j] = k[j] * (1.0f + (al[j] - 1.0f) * kac[j]);
                        bon += r[j] * kpr[j] * rkc[j];
                    }
                    ss = dpp_sum8(ss); bon = dpp_sum8(bon);
                    const float inrm = 1.0f / fmaxf(sqrtf(ss), 1e-12f);
                    LAS float* dst = inb + (n & 1) * TC * SROW + t_l * SROW + c0;
                    f32x4 w0, w1;
                    w0 = (f32x4){kkr[0] * inrm, kkr[1] * inrm, kkr[2] * inrm, kkr[3] * inrm}; w1 = (f32x4){kkr[4] * inrm, kkr[5] * inrm, kkr[6] * inrm, kkr[7] * inrm};
                    *(LAS f32x4*)(dst) = w0; *(LAS f32x4*)(dst + 4) = w1;
                    *(LAS f32x4*)(dst + 192) = (f32x4){w0[0] * al[0], w0[1] * al[1], w0[2] * al[2], w0[3] * al[3]}; *(LAS f32x4*)(dst + 196) = (f32x4){w1[0] * al[4], w1[1] * al[5], w1[2] * al[6], w1[3] * al[7]};
                    *(LAS f32x4*)(dst + 64) = (f32x4){dec[0], dec[1], dec[2], dec[3]}; *(LAS f32x4*)(dst + 68) = (f32x4){dec[4], dec[5], dec[6], dec[7]};
                    *(LAS f32x4*)(dst + 128) = (f32x4){kpr[0], kpr[1], kpr[2], kpr[3]}; *(LAS f32x4*)(dst + 132) = (f32x4){kpr[4], kpr[5], kpr[6], kpr[7]};
                    *(LAS f32x4*)(dst + 256) = (f32x4){r[0], r[1], r[2], r[3]}; *(LAS f32x4*)(dst + 260) = (f32x4){r[4], r[5], r[6], r[7]};
                    if ((cgi >> 2) == half) { LAS float* vd = inb + (n & 1) * TC * SROW + t_l * SROW + 320 + (c0 - 32 * half);
                        *(LAS f32x4*)(vd) = (f32x4){v[0], v[1], v[2], v[3]}; *(LAS f32x4*)(vd + 4) = (f32x4){v[4], v[5], v[6], v[7]}; }
                    if (half == 0 && cgi == 0) BONUS[m * 8 + head] = bon;
                }
            } else if (n >= 1 && n <= NCH) {
                const LAS float* src = inb + ((n - 1) & 1) * TC * SROW + seg * 8;
                LAS float* yd = yb + ((n - 1) & 1) * TC * 32 + rr;
#pragma unroll 2
                for (int tl = 0; tl < TC; ++tl) {
                    const LAS float* s = src + tl * SROW;
                    const f32x4 kkA = *(const LAS f32x4*)(s), kkB = *(const LAS f32x4*)(s + 4);
                    const f32x4 dcA = *(const LAS f32x4*)(s + 64), dcB = *(const LAS f32x4*)(s + 68);
                    const f32x4 kpA = *(const LAS f32x4*)(s + 128), kpB = *(const LAS f32x4*)(s + 132);
                    const f32x4 bvA = *(const LAS f32x4*)(s + 192), bvB = *(const LAS f32x4*)(s + 196);
                    const f32x4 rA = *(const LAS f32x4*)(s + 256), rB = *(const LAS f32x4*)(s + 260);
                    const float vv = s[320 - seg * 8 + rr];
                    f32x2 d2 = S0 * (f32x2){kkA[0], kkA[1]}; d2 += S1 * (f32x2){kkA[2], kkA[3]}; d2 += S2 * (f32x2){kkB[0], kkB[1]}; d2 += S3 * (f32x2){kkB[2], kkB[3]};
                    const float sa = dpp_sum8(d2.x + d2.y);
                    const f32x2 v2 = (f32x2){vv, vv}, nsa = (f32x2){-sa, -sa};
                    S0 = S0 * (f32x2){dcA[0], dcA[1]} + (v2 * (f32x2){kpA[0], kpA[1]} + nsa * (f32x2){bvA[0], bvA[1]});
                    S1 = S1 * (f32x2){dcA[2], dcA[3]} + (v2 * (f32x2){kpA[2], kpA[3]} + nsa * (f32x2){bvA[2], bvA[3]});
                    S2 = S2 * (f32x2){dcB[0], dcB[1]} + (v2 * (f32x2){kpB[0], kpB[1]} + nsa * (f32x2){bvB[0], bvB[1]});
                    S3 = S3 * (f32x2){dcB[2], dcB[3]} + (v2 * (f32x2){kpB[2], kpB[3]} + nsa * (f32x2){bvB[2], bvB[3]});
                    f32x2 y2 = S0 * (f32x2){rA[0], rA[1]}; y2 += S1 * (f32x2){rA[2], rA[3]}; y2 += S2 * (f32x2){rB[0], rB[1]}; y2 += S3 * (f32x2){rB[2], rB[3]};
                    const float y = dpp_sum8(y2.x + y2.y);
                    if (seg == 0) yd[tl * 32] = y;
                }
            }
            __syncthreads();
        }
    }
}

__device__ __forceinline__ void post_phase(const Params& p, int l) {
    const int gt = bid_() * NTHR + tid_(), NGT = gridDim.x * NTHR;
    const bf16_t* PRW = (const bf16_t*)(p.ws + WS_PRW); const bf16_t* LORA = (const bf16_t*)(p.ws + WS_LORA); const bf16_t* YRAW = (const bf16_t*)(p.ws + WS_YRAW);
    const float* BONUS = (const float*)(p.ws + WS_BONUS); bf16_t* MA = (bf16_t*)(p.ws + WS_MA);
    const float* muv = (const float*)p.in[4] + l * RWC + 1024; const float* lg = (const float*)p.in[13] + l * 512; const float* lb = (const float*)p.in[14] + l * 512;
    for (int idx = gt; idx < MTOK * 64; idx += NGT) {
        const int m = idx >> 6, c = (idx & 63) * 8, head = c >> 6, t = m & (SEQ - 1);
        float y[8], cur[8], prv[8], mm[8], g[8], gg[8], bb[8], o[8];
        unpack8(ld16(YRAW + (size_t)m * 512 + c), y);
        float s = 0.f;
#pragma unroll
        for (int j = 0; j < 8; ++j) s += y[j];
        const float mean = dpp_sum8(s) * (1.0f / 64.0f);
        float q = 0.f;
#pragma unroll
        for (int j = 0; j < 8; ++j) { y[j] -= mean; q += y[j] * y[j]; }
        const float rstd = 1.0f / sqrtf(dpp_sum8(q) * (1.0f / 64.0f) + 64e-5f);
        unpack8(ld16(PRW + (size_t)m * RWC + 1024 + c), cur);
        if (t > 0) unpack8(ld16(PRW + (size_t)(m - 1) * RWC + 1024 + c), prv); else { _Pragma("unroll") for (int j = 0; j < 8; ++j) prv[j] = 0.f; }
        ld8f(muv + c, mm); ld8f(lg + c, gg); ld8f(lb + c, bb);
        unpack8(ld16(LORA + (size_t)m * 1536 + 1024 + c), g);
        const float bon = BONUS[(size_t)m * 8 + head];
#pragma unroll
        for (int j = 0; j < 8; ++j) { const float vs = cur[j] + (prv[j] - cur[j]) * mm[j]; o[j] = (y[j] * rstd * gg[j] + bb[j] + bon * vs) * g[j]; }
        *(u32x4*)(MA + (size_t)m * 512 + c) = pack8(o);
    }
}

__global__ void __launch_bounds__(NTHR, 2) hybrid_fwd(Params p) {
    extern __shared__ __attribute__((aligned(16))) unsigned char lds_raw[];
    LAS unsigned char* lds = (LAS unsigned char*)lds_raw;
    cg::grid_group grid = cg::this_grid();
    const int G = gridDim.x;
    unsigned char* ws = p.ws;
    const int lo = p.ph_lo, hi = p.ph_hi;
#define RUN(k) (lo <= (k) && (k) < hi)
#define SYNC(k) do { if (RUN(k) && RUN((k) + 1)) grid.sync(); } while (0)
    if (RUN(0)) {
        prologue_phase(p, lds);
        norm_phase((const float*)p.in[0], (const float*)p.in[2], (bf16_t*)(ws + WS_H));
    }
    SYNC(0);
#pragma unroll 1
    for (int l = 0; l < NL; ++l) {
        const int pb = 1 + 11 * l;
        const char* wl = (const char*)(ws + WS_W) + (size_t)l * LW_ELEMS * 2;
        if (RUN(pb + 0)) {
            pg::DenseSched S{(const char*)(ws + WS_H), wl + OW_IN * 2, 2048u, 2048u, 16, 256, 18, G, bid_()};
            pg::EpiIn E{(bf16_t*)(ws + WS_PRW), (bf16_t*)(ws + WS_PPOOL), (bf16_t*)(ws + WS_PCONV), (bf16_t*)(ws + WS_PATT)};
            pg::gemm_phase(lds, S, E);
        }
        SYNC(pb + 0);
        if (RUN(pb + 1)) mix1_phase(p, l, lds);
        SYNC(pb + 1);
        if (RUN(pb + 2)) {
            pg::DenseSched S{(const char*)(ws + WS_ALORA), wl + OW_LORA * 2, 512u, 512u, 4, 256, 6, G, bid_()};
            pg::EpiLora E{(bf16_t*)(ws + WS_LORA), (const float*)p.in[6] + l * 512, (const float*)p.in[8] + l * 512};
            pg::gemm_phase(lds, S, E);
        }
        SYNC(pb + 2);
        if (RUN(pb + 3)) scan_phase(p, l, lds);
        SYNC(pb + 3);
        if (RUN(pb + 4)) post_phase(p, l);
        SYNC(pb + 4);
        if (RUN(pb + 5)) {
            const int c = bid_();
            pg::BRSched S{(const char*)(ws + WS_H), wl + OW_IN * 2, (const char*)(ws + WS_MA), (const char*)(ws + WS_M3), wl + OW_BR * 2, G, c};
            pg::EpiBR E{(u32x4*)(ws + WS_GSCR + (size_t)c * 131072), (bf16_t*)(ws + WS_MIXED)};
            pg::gemm_phase(lds, S, E);
        }
        SYNC(pb + 5);
        if (RUN(pb + 6)) {
            pg::DenseSched S{(const char*)(ws + WS_MIXED), wl + OW_O * 2, 2048u, 2048u, 16, 256, 4, G, bid_()};
            pg::EpiRes E{l == 0 ? (const float*)p.in[0] : (const float*)p.out, p.out};
            pg::gemm_phase(lds, S, E);
        }
        SYNC(pb + 6);
        if (RUN(pb + 7)) norm_phase(p.out, (const float*)p.in[26] + l * DM, (bf16_t*)(ws + WS_H));
        SYNC(pb + 7);
        if (RUN(pb + 8)) {
            pg::DenseSched S{(const char*)(ws + WS_H), wl + OW_GU * 2, 2048u, 2048u, 16, 256, 22, G, bid_()};
            pg::EpiGU E{(bf16_t*)(ws + WS_ACT)};
            pg::gemm_phase(lds, S, E);
        }
        SYNC(pb + 8);
        if (RUN(pb + 9)) {
            pg::DenseSched S{(const char*)(ws + WS_ACT), wl + OW_D * 2, (unsigned)(DFF * 2), (unsigned)(DFF * 2), 44, 256, 4, G, bid_()};
            pg::EpiRes E{(const float*)p.out, p.out};
            pg::gemm_phase(lds, S, E);
        }
        SYNC(pb + 9);
        if (RUN(pb + 10) && l + 1 < NL) norm_phase(p.out, (const float*)p.in[2] + (l + 1) * DM, (bf16_t*)(ws + WS_H));
        SYNC(pb + 10);
    }
#undef RUN
#undef SYNC
}

constexpr int N_PHASES = 1 + 11 * NL - 1;

extern "C" void kernel_launch(void* const* d_in, const int* in_sizes, int n_in, void* d_out, int out_size, void* d_ws, size_t ws_size, hipStream_t stream) {
    static int grid = 0;
    if (grid == 0) {
        if (n_in != 30 || out_size != MTOK * DM || ws_size < WS_END) { fprintf(stderr, "kernel_launch: unexpected shapes (n_in %d out %d ws %zu)\n", n_in, out_size, ws_size); grid = -1; return; }
        int dev = 0, cus = 0, per_cu = 0;
        (void)hipGetDevice(&dev); (void)hipDeviceGetAttribute(&cus, hipDeviceAttributeMultiprocessorCount, dev);
        (void)hipFuncSetAttribute((const void*)hybrid_fwd, hipFuncAttributeMaxDynamicSharedMemorySize, LDS_BYTES);
        (void)hipOccupancyMaxActiveBlocksPerMultiprocessor(&per_cu, (const void*)hybrid_fwd, NTHR, LDS_BYTES);
        if (per_cu < 1) { fprintf(stderr, "kernel_launch: occupancy query says %d blocks/CU\n", per_cu); per_cu = 1; }
        (void)hipGetLastError();
        grid = cus;
    }
    if (grid < 0) return;
    Params p{};
    for (int i = 0; i < 30; ++i) p.in[i] = d_in[i];
    p.out = (float*)d_out; p.ws = (unsigned char*)d_ws;
#ifdef MULTI_LAUNCH
    for (int ph = 0; ph < N_PHASES; ++ph) { p.ph_lo = ph; p.ph_hi = ph + 1; hipLaunchKernelGGL(hybrid_fwd, dim3(grid), dim3(NTHR), LDS_BYTES, stream, p); }
#else
    p.ph_lo = 0; p.ph_hi = N_PHASES;
    void* args[] = {&p};
    hipError_t e = hipLaunchCooperativeKernel((const void*)hybrid_fwd, dim3(grid), dim3(NTHR), args, LDS_BYTES, stream);
    if (e != hipSuccess) fprintf(stderr, "cooperative launch failed: %s (grid %d)\n", hipGetErrorString(e), grid);
#endif
}
```

```cpp
#include <hip/hip_runtime.h>
#include <hip/hip_cooperative_groups.h>
#include <cstdio>
#include <cstdint>
namespace cg = cooperative_groups;

#define LAS __attribute__((address_space(3)))
typedef unsigned short bf16_t;
typedef short bf16x8 __attribute__((ext_vector_type(8)));
typedef float f32x4 __attribute__((ext_vector_type(4)));
typedef float f32x2 __attribute__((ext_vector_type(2)));
typedef unsigned u32x4 __attribute__((ext_vector_type(4)));
typedef unsigned u32x2 __attribute__((ext_vector_type(2)));

constexpr int MTOK = 65536, SEQ = 4096, DM = 1024, NL = 2;
constexpr int RWC = 1792, INC = 8704, DFF = 2816;
constexpr int NTHR = 512;
constexpr size_t MiB = 1u << 20;
constexpr size_t OW_IN = 0, OW_LORA = 8912896, OW_BR = OW_LORA + 393216, OW_O = OW_BR + 2097152, OW_GU = OW_O + 1048576, OW_D = OW_GU + 5767168, LW_ELEMS = OW_D + 2883584;
constexpr size_t WS_W = 0, WS_BONUS = 82 * MiB, WS_ROPE = 84 * MiB, WS_H = 92 * MiB, WS_M3 = 220 * MiB, WS_PRW = 412 * MiB, WS_PPOOL = 636 * MiB,
                 WS_PCONV = 700 * MiB, WS_PATT = 892 * MiB, WS_ALORA = 988 * MiB, WS_END = 1020 * MiB;
constexpr size_t WS_LORA = 636 * MiB, WS_YRAW = 828 * MiB, WS_MA = 892 * MiB, WS_GSCR = 956 * MiB, WS_MIXED = 412 * MiB, WS_ACT = 220 * MiB;
static_assert(2 * LW_ELEMS * 2 <= WS_BONUS, "weights fit");
constexpr int LDS_BYTES = 147456;

struct Params { const void* in[30]; float* out; unsigned char* ws; int ph_lo, ph_hi; };

__device__ __forceinline__ unsigned cvt_pk_bf16(float lo, float hi) { unsigned r; asm volatile("v_cvt_pk_bf16_f32 %0, %1, %2" : "=v"(r) : "v"(lo), "v"(hi)); return r; }
__device__ __forceinline__ void unpack8(const u32x4 w, float (&f)[8]) {
    f[0] = __uint_as_float(w.x << 16); f[1] = __uint_as_float(w.x & 0xffff0000u); f[2] = __uint_as_float(w.y << 16); f[3] = __uint_as_float(w.y & 0xffff0000u);
    f[4] = __uint_as_float(w.z << 16); f[5] = __uint_as_float(w.z & 0xffff0000u); f[6] = __uint_as_float(w.w << 16); f[7] = __uint_as_float(w.w & 0xffff0000u);
}
__device__ __forceinline__ u32x4 pack8(const float (&f)[8]) { u32x4 w; w.x = cvt_pk_bf16(f[0], f[1]); w.y = cvt_pk_bf16(f[2], f[3]); w.z = cvt_pk_bf16(f[4], f[5]); w.w = cvt_pk_bf16(f[6], f[7]); return w; }
__device__ __forceinline__ u32x4 ld16(const bf16_t* p) { return *(const u32x4*)p; }
__device__ __forceinline__ void ld8f(const float* p, float (&f)[8]) { const f32x4 a = *(const f32x4*)p, b = *(const f32x4*)(p + 4); f[0] = a.x; f[1] = a.y; f[2] = a.z; f[3] = a.w; f[4] = b.x; f[5] = b.y; f[6] = b.z; f[7] = b.w; }
__device__ __forceinline__ float sigmoidf_(float x) { return 1.0f / (1.0f + __expf(-x)); }
__device__ __forceinline__ const void* karg(int idx) {
    const __attribute__((address_space(4))) unsigned long long* kp = (const __attribute__((address_space(4))) unsigned long long*)__builtin_amdgcn_kernarg_segment_ptr();
    asm volatile("" : "+s"(kp));
    return (const void*)kp[idx];
}
#define KWS ((unsigned char*)karg(31))
#define KOUT ((float*)karg(30))
__device__ __forceinline__ int tid_(int wv) { int t; asm volatile("v_mbcnt_lo_u32_b32 %0, -1, 0\n\tv_mbcnt_hi_u32_b32 %0, -1, %0" : "=v"(t)); return (wv << 6) | t; }
__device__ __forceinline__ int bid_() { int b = blockIdx.x; asm volatile("" : "+s"(b)); return b; }
__device__ __forceinline__ float dpp_sum8(float v) {
    v += __builtin_bit_cast(float, __builtin_amdgcn_mov_dpp(__builtin_bit_cast(int, v), 0xB1, 0xF, 0xF, true));
    v += __builtin_bit_cast(float, __builtin_amdgcn_mov_dpp(__builtin_bit_cast(int, v), 0x4E, 0xF, 0xF, true));
    v += __builtin_bit_cast(float, __builtin_amdgcn_mov_dpp(__builtin_bit_cast(int, v), 0x141, 0xF, 0xF, true));
    return v;
}

namespace pg {
constexpr int BM = 256, BK = 64, HALF = 128, HTB = HALF * BK * 2, NXCD = 8, WGM = 8;
__device__ __forceinline__ int lds_byte(int r, int c) { const int st = (r >> 4) * 2 + (c >> 5), rr = r & 15, cc = c & 31, ob = rr * 64 + cc * 2; return st * 1024 + (ob ^ (((ob >> 9) & 1) << 5)); }
__device__ __forceinline__ void stage_rc(int b, int& R, int& C) { const int st = b / 1024, sb = b % 1024, swz = sb ^ (((sb >> 9) & 1) << 5); R = (st >> 1) * 16 + swz / 64; C = (st & 1) * 32 + (swz % 64) / 2; }
__device__ __forceinline__ int perm32(int rho) { const int n = rho >> 4, i = rho & 15; return 8 * (i >> 2) + 4 * n + (i & 3); }

struct GUnit { const char* A; const char* B; unsigned lda2, ldb2; int nt, pm, pn, aux; };

__device__ __forceinline__ bool tile_order(int i, int G, int c, int nM, int nN, int& pm, int& pn) {
    const int nwg = nM * nN; const long L = (long)i * G + c; if (L >= nwg) return false;
    int wgid = (int)L; { const int q = nwg / NXCD, r = nwg % NXCD, xcd = wgid % NXCD, off = wgid / NXCD; wgid = (xcd < r ? xcd * (q + 1) : r * (q + 1) + (xcd - r) * q) + off; }
    const int nig = WGM * nN, gid = wgid / nig, fm = gid * WGM, gsz = (nM - fm) < WGM ? (nM - fm) : WGM;
    pm = fm + ((wgid % nig) % gsz); pn = (wgid % nig) / gsz; return true;
}
struct DenseSched {
    const char* A; const char* B; unsigned lda2, ldb2; int nt, nM, nN, G, c;
    __device__ __forceinline__ bool next(int i, GUnit& u) const {
        int pm, pn; if (!tile_order(i, G, c, nM, nN, pm, pn)) return false;
        u.A = A + (size_t)pm * 256 * lda2; u.B = B + (size_t)pn * 256 * ldb2; u.lda2 = lda2; u.ldb2 = ldb2; u.nt = nt; u.pm = pm; u.pn = pn; u.aux = 0; return true;
    }
};
struct BRSched {
    const char* H; const char* WIN; const char* MA; const char* M3; const char* WBR; int G, c;
    __device__ __forceinline__ bool next(int i, GUnit& u) const {
        int pm, pn; if (!tile_order(i >> 3, G, c, 256, 4, pm, pn)) return false;
        const int sub = i & 7, b = sub >> 1;
        if ((sub & 1) == 0) { u.A = H + (size_t)pm * 256 * 2048; u.lda2 = 2048; u.B = WIN + (size_t)(4608 + b * 1024 + pn * 256) * 2048; u.ldb2 = 2048; u.nt = 16; }
        else { if (b == 0) { u.A = MA + (size_t)pm * 256 * 1024; u.lda2 = 1024; } else { u.A = M3 + (size_t)(b - 1) * 1024 + (size_t)pm * 256 * 3072; u.lda2 = 3072; }
               u.B = WBR + (size_t)b * (1024 * 512 * 2) + (size_t)pn * 256 * 1024; u.ldb2 = 1024; u.nt = 8; }
        u.pm = pm; u.pn = pn; u.aux = sub; return true;
    }
};

template <class Epi, class Sched>
__device__ __forceinline__ void gemm_phase(LAS unsigned char* lds, const Sched& S, const Epi& E, const int wv) {
    const int tid = tid_(wv), wid = __builtin_amdgcn_readfirstlane(tid >> 6), lane = tid & 63, wr = wid >> 2, wc = wid & 3, fr = lane & 15, fq = lane >> 4;
    const size_t kstep = (size_t)(BK * 2);
    const unsigned ldsw = (unsigned)wid * 1024u;
    const int aoff = lds_byte(wr * 64 + fr, fq * 8), boff = lds_byte(wc * 32 + fr, fq * 8);
#define PG_SA(b, h) (((b) * 2 + (h)) * HTB)
#define PG_SB(b, h) ((4 + (b) * 2 + (h)) * HTB)
#define PG_STAGE(bufoff, gbase, voff, ld2) do { \
        __builtin_amdgcn_global_load_lds((const unsigned*)((const char*)(gbase) + (voff)), (LAS unsigned*)(lds + (bufoff) + ldsw), 16, 0, 0); \
        __builtin_amdgcn_global_load_lds((const unsigned*)((const char*)(gbase) + (size_t)64 * (ld2) + (voff)), (LAS unsigned*)(lds + (bufoff) + ldsw + 8192), 16, 0, 0); } while (0)
#define PG_LDA(dst, b, h) do { _Pragma("unroll") for (int m = 0; m < 4; ++m) _Pragma("unroll") for (int k = 0; k < 2; ++k) dst[m][k] = *(const LAS bf16x8*)(lds + PG_SA(b, h) + aoff + m * 2048 + k * 1024); } while (0)
#define PG_LDB(dst, b, h) do { _Pragma("unroll") for (int n = 0; n < 2; ++n) _Pragma("unroll") for (int k = 0; k < 2; ++k) dst[n][k] = *(const LAS bf16x8*)(lds + PG_SB(b, h) + boff + n * 2048 + k * 1024); } while (0)
#define PG_MMA(ai, bj, At, Bt) do { __builtin_amdgcn_s_setprio(1); _Pragma("unroll") for (int m = 0; m < 4; ++m) _Pragma("unroll") for (int n = 0; n < 2; ++n) _Pragma("unroll") for (int k = 0; k < 2; ++k) \
        acc[ai][bj][m][n] = __builtin_amdgcn_mfma_f32_16x16x32_bf16(Bt[n][k], At[m][k], acc[ai][bj][m][n], 0, 0, 0); __builtin_amdgcn_s_setprio(0); } while (0)
#define PG_WAIT_V(n) asm volatile("s_waitcnt vmcnt(" #n ")" ::: "memory")
#define PG_WAIT_L(n) asm volatile("s_waitcnt lgkmcnt(" #n ")" ::: "memory")
#define PG_BAR __builtin_amdgcn_s_barrier()
#define PG_SCHED __builtin_amdgcn_sched_barrier(0)
#define PG_BODY(a1, vA1, la1, a2, b2, vA2, vB2, la2, lb2) do { \
            const size_t hA1 = (size_t)128 * (la1), hA2 = (size_t)128 * (la2), hB2 = (size_t)128 * (lb2); \
            const char* a3 = (a2) + kstep; const char* b3 = (b2) + kstep; \
            PG_LDB(B0, 0, 0); PG_LDB(B1, 0, 1); PG_SCHED; PG_LDA(At, 0, 0); PG_STAGE(PG_SA(1, 1), (a1) + hA1, vA1, la1); \
            PG_WAIT_V(8); PG_WAIT_L(0); PG_BAR; PG_MMA(0, 0, At, B0); PG_MMA(0, 1, At, B1); PG_BAR; PG_SCHED; \
            PG_LDA(At, 0, 1); PG_STAGE(PG_SB(0, 0), (b2), vB2, lb2); PG_STAGE(PG_SB(0, 1), (b2) + hB2, vB2, lb2); PG_STAGE(PG_SA(0, 0), (a2), vA2, la2); \
            PG_WAIT_V(8); PG_WAIT_L(0); PG_BAR; PG_MMA(1, 0, At, B0); PG_MMA(1, 1, At, B1); PG_BAR; PG_SCHED; \
            PG_LDB(B0, 1, 0); PG_LDB(B1, 1, 1); PG_SCHED; PG_LDA(At, 1, 0); PG_STAGE(PG_SA(0, 1), (a2) + hA2, vA2, la2); \
            PG_WAIT_V(8); PG_WAIT_L(0); PG_BAR; PG_MMA(0, 0, At, B0); PG_MMA(0, 1, At, B1); PG_BAR; PG_SCHED; \
            PG_LDA(At, 1, 1); PG_STAGE(PG_SB(1, 0), b3, vB2, lb2); PG_STAGE(PG_SB(1, 1), b3 + hB2, vB2, lb2); PG_STAGE(PG_SA(1, 0), a3, vA2, la2); \
            PG_WAIT_V(8); PG_WAIT_L(0); PG_BAR; PG_MMA(1, 0, At, B0); PG_MMA(1, 1, At, B1); PG_BAR; PG_SCHED; } while (0)
    GUnit cur, nxt; int ui = 0;
    if (!S.next(0, cur)) return;
    f32x4 acc[2][2][4][2];
#pragma unroll
    for (int a = 0; a < 2; ++a)
#pragma unroll
        for (int b = 0; b < 2; ++b)
#pragma unroll
            for (int m = 0; m < 4; ++m)
#pragma unroll
                for (int n = 0; n < 2; ++n) acc[a][b][m][n] = (f32x4){0.f, 0.f, 0.f, 0.f};
    bf16x8 At[4][2], B0[2][2], B1[2][2];
    unsigned vAc, vBc;
    { int R0, C0; stage_rc(tid * 16, R0, C0); const int Rb0 = (R0 & ~31) + perm32(R0 & 31); vAc = (unsigned)R0 * cur.lda2 + (unsigned)C0 * 2u; vBc = (unsigned)Rb0 * cur.ldb2 + (unsigned)C0 * 2u; }
    {
        const char* cA = cur.A; const char* cB = cur.B; const size_t hA = (size_t)128 * cur.lda2, hB = (size_t)128 * cur.ldb2;
        PG_STAGE(PG_SB(0, 0), cB, vBc, cur.ldb2); PG_STAGE(PG_SB(0, 1), cB + hB, vBc, cur.ldb2); PG_STAGE(PG_SA(0, 0), cA, vAc, cur.lda2); PG_STAGE(PG_SA(0, 1), cA + hA, vAc, cur.lda2);
        if (wr == 1) PG_BAR;
        PG_WAIT_V(2); PG_BAR;
        PG_STAGE(PG_SB(1, 0), cB + kstep, vBc, cur.ldb2); PG_STAGE(PG_SA(1, 0), cA + kstep, vAc, cur.lda2); PG_STAGE(PG_SB(1, 1), cB + hB + kstep, vBc, cur.ldb2);
        PG_WAIT_V(6); PG_BAR;
    }
    for (;;) {
        const bool has_next = S.next(ui + 1, nxt);
        if (!has_next) nxt = cur;
        const int nt = cur.nt;
        const char* cA = cur.A; const char* cB = cur.B;
        for (int t = 0; t < nt - 2; t += 2)
            PG_BODY(cA + (size_t)(t + 1) * kstep, vAc, cur.lda2, cA + (size_t)(t + 2) * kstep, cB + (size_t)(t + 2) * kstep, vAc, vBc, cur.lda2, cur.ldb2);
        unsigned vAn, vBn;
        { int t2 = tid; asm volatile("" : "+v"(t2)); int R0, C0; stage_rc(t2 * 16, R0, C0); const int Rb0 = (R0 & ~31) + perm32(R0 & 31);
          vAn = (unsigned)R0 * nxt.lda2 + (unsigned)C0 * 2u; vBn = (unsigned)Rb0 * nxt.ldb2 + (unsigned)C0 * 2u; }
        PG_BODY(cA + (size_t)(nt - 1) * kstep, vAc, cur.lda2, nxt.A, nxt.B, vAn, vBn, nxt.lda2, nxt.ldb2);
        if (wr == 0) PG_BAR;
        E(acc, cur, wr, wc, fr, fq);
        if (!has_next) break;
#pragma unroll
        for (int a = 0; a < 2; ++a)
#pragma unroll
            for (int b = 0; b < 2; ++b)
#pragma unroll
                for (int m = 0; m < 4; ++m)
#pragma unroll
                    for (int n = 0; n < 2; ++n) acc[a][b][m][n] = (f32x4){0.f, 0.f, 0.f, 0.f};
        cur = nxt; vAc = vAn; vBc = vBn; ++ui;
        if (wr == 1) PG_BAR;
    }
    PG_WAIT_V(0);
    PG_BAR;
#undef PG_SA
#undef PG_SB
#undef PG_STAGE
#undef PG_LDA
#undef PG_LDB
#undef PG_MMA
#undef PG_WAIT_V
#undef PG_WAIT_L
#undef PG_BAR
#undef PG_SCHED
#undef PG_BODY
}

#define EPI_LOOP(...) \
    _Pragma("unroll") for (int ai = 0; ai < 2; ++ai) _Pragma("unroll") for (int m = 0; m < 4; ++m) _Pragma("unroll") for (int bj = 0; bj < 2; ++bj) { \
        const int row = u.pm * 256 + ai * 128 + wr * 64 + m * 16 + fr; const int tcol = bj * 128 + wc * 32 + 8 * fq; \
        const f32x4 v0 = acc[ai][bj][m][0], v1 = acc[ai][bj][m][1]; float v[8] = {v0[0], v0[1], v0[2], v0[3], v1[0], v1[1], v1[2], v1[3]}; __VA_ARGS__ }

struct EpiIn {
    bf16_t *prw, *ppool, *pconv, *patt;
    __device__ __forceinline__ void operator()(const f32x4 (&acc)[2][2][4][2], const GUnit& u, int wr, int wc, int fr, int fq) const {
        asm volatile("" : "+v"(fr), "+v"(fq));
        bf16_t* base; int ld, ct;
        if (u.pn < 7) { base = prw; ld = 1792; ct = u.pn; } else if (u.pn < 9) { base = ppool; ld = 512; ct = u.pn - 7; }
        else if (u.pn < 15) { base = pconv; ld = 1536; ct = u.pn - 9; } else { base = patt; ld = 768; ct = u.pn - 15; }
        EPI_LOOP({ *(u32x4*)(base + (size_t)row * ld + ct * 256 + tcol) = pack8(v); })
    }
};
struct EpiLora {
    bf16_t* out; const float* w0; const float* a0;
    __device__ __forceinline__ void operator()(const f32x4 (&acc)[2][2][4][2], const GUnit& u, int wr, int wc, int fr, int fq) const {
        asm volatile("" : "+v"(fr), "+v"(fq));
        const float* bias = u.pn < 2 ? w0 + u.pn * 256 : a0 + (u.pn - 2) * 256;
        const bool sg = u.pn < 4;
        float bv0[8], bv1[8];
        if (sg) { ld8f(bias + wc * 32 + 8 * fq, bv0); ld8f(bias + 128 + wc * 32 + 8 * fq, bv1); }
        EPI_LOOP({ if (sg) { _Pragma("unroll") for (int j = 0; j < 8; ++j) v[j] = sigmoidf_(v[j] + (bj ? bv1[j] : bv0[j])); }
                   *(u32x4*)(out + (size_t)row * 1536 + u.pn * 256 + tcol) = pack8(v); })
    }
};
struct EpiBR {
    u32x4* scr; bf16_t* mixed;
    __device__ __forceinline__ void operator()(const f32x4 (&acc)[2][2][4][2], const GUnit& u, int wr, int wc, int fr, int fq) const {
        asm volatile("" : "+v"(fr), "+v"(fq));
        const bool gate = (u.aux & 1) == 0; const bool first = (u.aux >> 1) == 0;
        const int tix = (wr * 4 + wc) * 64 + fq * 16 + fr;
        if (gate) {
            EPI_LOOP({ _Pragma("unroll") for (int j = 0; j < 8; ++j) v[j] = sigmoidf_(v[j]); scr[((ai * 4 + m) * 2 + bj) * 512 + tix] = pack8(v); })
        } else {
#pragma unroll
            for (int aq = 0; aq < 4; ++aq) {
                const int ai = aq >> 1, m0 = (aq & 1) * 2;
                u32x4 gq[4][2], oq[4][2];
#pragma unroll
                for (int m = m0; m < m0 + 2; ++m)
#pragma unroll
                    for (int bj = 0; bj < 2; ++bj) {
                        gq[m][bj] = scr[((ai * 4 + m) * 2 + bj) * 512 + tix];
                        const int row = u.pm * 256 + ai * 128 + wr * 64 + m * 16 + fr; const int tcol = bj * 128 + wc * 32 + 8 * fq;
                        if (!first) oq[m][bj] = *(const u32x4*)(mixed + (size_t)row * 1024 + u.pn * 256 + tcol);
                    }
#pragma unroll
                for (int m = m0; m < m0 + 2; ++m)
#pragma unroll
                    for (int bj = 0; bj < 2; ++bj) {
                        const int row = u.pm * 256 + ai * 128 + wr * 64 + m * 16 + fr; const int tcol = bj * 128 + wc * 32 + 8 * fq;
                        const f32x4 v0 = acc[ai][bj][m][0], v1 = acc[ai][bj][m][1]; float v[8] = {v0[0], v0[1], v0[2], v0[3], v1[0], v1[1], v1[2], v1[3]};
                        float g[8]; unpack8(gq[m][bj], g);
#pragma unroll
                        for (int j = 0; j < 8; ++j) v[j] *= g[j];
                        if (!first) { float o[8]; unpack8(oq[m][bj], o); _Pragma("unroll") for (int j = 0; j < 8; ++j) v[j] += o[j]; }
                        *(u32x4*)(mixed + (size_t)row * 1024 + u.pn * 256 + tcol) = pack8(v);
                    }
            }
        }
    }
};
struct EpiRes {
    const float* base; float* out;
    __device__ __forceinline__ void operator()(const f32x4 (&acc)[2][2][4][2], const GUnit& u, int wr, int wc, int fr, int fq) const {
        asm volatile("" : "+v"(fr), "+v"(fq));
#pragma unroll
        for (int aq = 0; aq < 4; ++aq) {
            const int ai = aq >> 1, m0 = (aq & 1) * 2;
            f32x4 b0[4][2], b1[4][2];
#pragma unroll
            for (int m = m0; m < m0 + 2; ++m)
#pragma unroll
                for (int bj = 0; bj < 2; ++bj) {
                    const size_t off = (size_t)(u.pm * 256 + ai * 128 + wr * 64 + m * 16 + fr) * 1024 + u.pn * 256 + bj * 128 + wc * 32 + 8 * fq;
                    b0[m][bj] = *(const f32x4*)(base + off); b1[m][bj] = *(const f32x4*)(base + off + 4);
                }
#pragma unroll
            for (int m = m0; m < m0 + 2; ++m)
#pragma unroll
                for (int bj = 0; bj < 2; ++bj) {
                    const size_t off = (size_t)(u.pm * 256 + ai * 128 + wr * 64 + m * 16 + fr) * 1024 + u.pn * 256 + bj * 128 + wc * 32 + 8 * fq;
                    *(f32x4*)(out + off) = b0[m][bj] + acc[ai][bj][m][0]; *(f32x4*)(out + off + 4) = b1[m][bj] + acc[ai][bj][m][1];
                }
        }
    }
};
struct EpiGU {
    bf16_t* act;
    __device__ __forceinline__ void operator()(const f32x4 (&acc)[2][2][4][2], const GUnit& u, int wr, int wc, int fr, int fq) const {
        asm volatile("" : "+v"(fr), "+v"(fq));
#pragma unroll
        for (int ai = 0; ai < 2; ++ai)
#pragma unroll
            for (int m = 0; m < 4; ++m) {
                const int row = u.pm * 256 + ai * 128 + wr * 64 + m * 16 + fr; const int col = u.pn * 128 + wc * 32 + 8 * fq;
                const f32x4 g0 = acc[ai][0][m][0], g1 = acc[ai][0][m][1], u0 = acc[ai][1][m][0], u1 = acc[ai][1][m][1];
                float v[8];
#pragma unroll
                for (int j = 0; j < 4; ++j) { v[j] = g0[j] * sigmoidf_(g0[j]) * u0[j]; v[4 + j] = g1[j] * sigmoidf_(g1[j]) * u1[j]; }
                *(u32x4*)(act + (size_t)row * DFF + col) = pack8(v);
            }
    }
};
}

__device__ __forceinline__ float wave_sum(float v) {
#pragma unroll
    for (int o = 1; o < 64; o <<= 1) v += __shfl_xor(v, o);
    return v;
}
__device__ __forceinline__ void transpose_item(const float* W, int ldw, int k0, int n0, bf16_t* WT, int drow0, int ldd, int dk0, LAS float* scr, int lane) {
#pragma unroll 8
    for (int i = 0; i < 32; ++i) { const int kk = 2 * i + (lane >> 5); scr[kk * 33 + (lane & 31)] = W[(size_t)(k0 + kk) * ldw + n0 + (lane & 31)]; }
    asm volatile("s_waitcnt lgkmcnt(0)" ::: "memory");
    const int c = lane & 7;
#pragma unroll
    for (int j = 0; j < 4; ++j) { const int n = (lane >> 3) + 8 * j; const LAS float* s = scr + (8 * c) * 33 + n;
        u32x4 o; o.x = cvt_pk_bf16(s[0 * 33], s[1 * 33]); o.y = cvt_pk_bf16(s[2 * 33], s[3 * 33]); o.z = cvt_pk_bf16(s[4 * 33], s[5 * 33]); o.w = cvt_pk_bf16(s[6 * 33], s[7 * 33]);
        *(u32x4*)(WT + (size_t)(drow0 + n) * ldd + dk0 + k0 + 8 * c) = o; }
    asm volatile("s_waitcnt lgkmcnt(0)" ::: "memory");
}

__device__ __forceinline__ void prologue_phase(const Params& p, LAS unsigned char* lds, const int wv) {
    const int tid = tid_(wv), lane = tid & 63, wave = __builtin_amdgcn_readfirstlane(tid >> 6);
    const int G = gridDim.x; const int gw = bid_() * 8 + wave, NGW = G * 8;
    LAS float* scr = (LAS float*)(lds + wave * 8448);
    bf16_t* Wb = (bf16_t*)(KWS + WS_W);
    constexpr int PER_LAYER = 4352 + 16 + 16 + 32 + 256 * 3 + 512 + 1408 * 3;
    for (int it = gw; it < NL * PER_LAYER; it += NGW) {
        const int l = it / PER_LAYER; int r = it % PER_LAYER;
        bf16_t* wl = Wb + (size_t)l * LW_ELEMS;
        const float* src; int K, N, ldd, dk0 = 0, mode = 0; bf16_t* dst; int rowoff = 0;
        if (r < 4352) { src = (const float*)karg(3) + (size_t)l * 1024 * INC; K = 1024; N = INC; dst = wl + OW_IN; ldd = 1024; }
        else if ((r -= 4352) < 16) { src = (const float*)karg(5) + (size_t)l * 64 * 512; K = 64; N = 512; dst = wl + OW_LORA; ldd = 256; }
        else if ((r -= 16) < 16) { src = (const float*)karg(7) + (size_t)l * 64 * 512; K = 64; N = 512; dst = wl + OW_LORA; ldd = 256; rowoff = 512; dk0 = 64; }
        else if ((r -= 16) < 32) { src = (const float*)karg(9) + (size_t)l * 128 * 512; K = 128; N = 512; dst = wl + OW_LORA; ldd = 256; rowoff = 1024; dk0 = 128; }
        else if ((r -= 32) < 256) { src = (const float*)karg(15) + (size_t)l * 512 * 1024; K = 512; N = 1024; dst = wl + OW_BR; ldd = 512; }
        else if ((r -= 256) < 256) { src = (const float*)karg(20) + (size_t)l * 512 * 1024; K = 512; N = 1024; dst = wl + OW_BR + 2 * 524288; ldd = 512; }
        else if ((r -= 256) < 256) { src = (const float*)karg(24) + (size_t)l * 512 * 1024; K = 512; N = 1024; dst = wl + OW_BR + 3 * 524288; ldd = 512; }
        else if ((r -= 256) < 512) { src = (const float*)karg(25) + (size_t)l * 1024 * 1024; K = 1024; N = 1024; dst = wl + OW_O; ldd = 1024; }
        else if ((r -= 512) < 1408) { src = (const float*)karg(27) + (size_t)l * 1024 * DFF; K = 1024; N = DFF; dst = wl + OW_GU; ldd = 1024; mode = 1; }
        else if ((r -= 1408) < 1408) { src = (const float*)karg(28) + (size_t)l * 1024 * DFF; K = 1024; N = DFF; dst = wl + OW_GU; ldd = 1024; mode = 2; }
        else { r -= 1408; src = (const float*)karg(29) + (size_t)l * DFF * 1024; K = DFF; N = 1024; dst = wl + OW_D; ldd = DFF; }
        const int nblk = N / 32, kb = r / nblk, nb = r % nblk, n0 = nb * 32;
        int drow0 = rowoff + n0;
        if (mode) drow0 = (n0 >> 7) * 256 + (n0 & 127) + (mode == 2 ? 128 : 0);
        transpose_item(src, N, kb * 64, n0, dst, drow0, ldd, dk0, scr, lane);
    }
    const int gt = bid_() * NTHR + tid, NGT = G * NTHR;
    for (int idx = gt; idx < NL * 1536 * 32; idx += NGT) {
        const int l = idx / (1536 * 32), r = idx % (1536 * 32), row = r >> 5, kc = (r & 31) * 8;
        const bool diag = row < 512 ? (kc < 64) : row < 1024 ? (kc >= 64 && kc < 128) : (kc >= 128);
        if (!diag) *(u32x4*)(Wb + (size_t)l * LW_ELEMS + OW_LORA + (size_t)row * 256 + kc) = (u32x4){0u, 0u, 0u, 0u};
    }
    for (int idx = gt; idx < NL * 1024 * 64; idx += NGT) {
        const int l = idx >> 16, r = idx & 65535, n = r & 1023, k0 = (r >> 10) * 8, g = k0 >> 7;
        const float* pw = (const float*)karg(16) + (size_t)l * 65536 + (size_t)g * 16384 + (size_t)(k0 & 127) * 128;
        const float* sc = (const float*)karg(17) + l * 512 + g * 128;
        const float* wo = (const float*)karg(18) + (size_t)l * 512 * 1024 + (size_t)g * 128 * 1024 + n;
        float a[8] = {0.f, 0.f, 0.f, 0.f, 0.f, 0.f, 0.f, 0.f};
        for (int j = 0; j < 128; ++j) { const float w = sc[j] * wo[(size_t)j * 1024];
#pragma unroll
            for (int i = 0; i < 8; ++i) a[i] += pw[i * 128 + j] * w; }
        *(u32x4*)(Wb + (size_t)l * LW_ELEMS + OW_BR + 524288 + (size_t)n * 512 + k0) = pack8(a);
    }
    _Float16* rope = (_Float16*)(KWS + WS_ROPE);
    const int* pos = (const int*)karg(1);
    for (int idx = gt; idx < MTOK * 32; idx += NGT) {
        const int m = idx >> 5, i = idx & 31;
        const float inv = powf(10000.0f, -(float)i * 2.0f / 64.0f);
        const float ang = (float)pos[m] * inv;
        rope[(size_t)m * 64 + i] = (_Float16)cosf(ang); rope[(size_t)m * 64 + 32 + i] = (_Float16)sinf(ang);
    }
}

__device__ __forceinline__ void norm_phase(const float* x, const float* g, bf16_t* out, const int wv) {
    const int tid = tid_(wv), lane = tid & 63, wave = tid >> 6;
    f32x4 gv[4];
#pragma unroll
    for (int j = 0; j < 4; ++j) gv[j] = *((const f32x4*)g + lane + 64 * j);
    for (int m = bid_() * 8 + wave; m < MTOK; m += gridDim.x * 8) {
        const f32x4* xr = (const f32x4*)(x + (size_t)m * DM) + lane;
        f32x4 v[4]; float s = 0.f;
#pragma unroll
        for (int j = 0; j < 4; ++j) { v[j] = xr[64 * j]; s += (v[j].x * v[j].x + v[j].y * v[j].y) + (v[j].z * v[j].z + v[j].w * v[j].w); }
        const float rstd = 1.0f / sqrtf(wave_sum(s) * (1.0f / DM) + 1e-6f);
        u32x2* o = (u32x2*)(out + (size_t)m * DM) + lane;
#pragma unroll
        for (int j = 0; j < 4; ++j) { u32x2 w; w.x = cvt_pk_bf16(v[j].x * rstd * gv[j].x, v[j].y * rstd * gv[j].y); w.y = cvt_pk_bf16(v[j].z * rstd * gv[j].z, v[j].w * rstd * gv[j].w); o[64 * j] = w; }
    }
}

__device__ __forceinline__ u32x4 qk_prep(const u32x4 raw, const float* g, const _Float16* rp, int c, float scale) {
    float x[8]; unpack8(raw, x);
    float ss = 0.f;
#pragma unroll
    for (int j = 0; j < 8; ++j) ss += x[j] * x[j];
    ss = dpp_sum8(ss);
    const float rstd = 1.0f / sqrtf(ss * (1.0f / 64.0f) + 1e-6f);
    float gg[8]; ld8f(g + c * 8, gg);
    const int ci = (c & 3) * 8;
    float o[8];
#pragma unroll
    for (int j = 0; j < 8; ++j) {
        const float y = x[j] * rstd * gg[j];
        const float pr = __shfl_xor(y, 4);
        const float cs = (float)rp[ci + j], sn = (float)rp[32 + ci + j];
        o[j] = (c < 4 ? y * cs - pr * sn : y * cs + pr * sn) * scale;
    }
    return pack8(o);
}

__device__ __forceinline__ void attn_item(const Params& p, int l, int item, LAS unsigned char* lds, const int wv) {
    const int tid = tid_(wv), lane = tid & 63, wave = __builtin_amdgcn_readfirstlane(tid >> 6), fr = lane & 15, fq = lane >> 4;
    const int b = item >> 6, kvh = (item >> 5) & 1, nbk = item & 31;
    const int tok0 = b * SEQ + nbk * 128;
    const bf16_t* PATT = (const bf16_t*)(KWS + WS_PATT);
    bf16_t* M3 = (bf16_t*)(KWS + WS_M3);
    const _Float16* rope = (const _Float16*)(KWS + WS_ROPE);
    const float* qg = (const float*)karg(21) + l * 64; const float* kg = (const float*)karg(22) + l * 64;
    LAS bf16_t* Ks = (LAS bf16_t*)lds;
    LAS bf16_t* Vt = (LAS bf16_t*)(lds + 36864);
    LAS bf16_t* Qs = (LAS bf16_t*)(lds + 70656);
    const int c = tid & 7;
#pragma unroll 1
    for (int pass = 0; pass < 4; ++pass) {
        const int row = pass * 64 + (tid >> 3); const int tokk = tok0 - 128 + row; const bool valid = (nbk > 0) || (row >= 128);
        u32x4 kraw = (u32x4){0u, 0u, 0u, 0u}, vraw = kraw;
        const int tk = valid ? tokk : tok0;
        if (valid) { kraw = ld16(PATT + (size_t)tokk * 768 + 512 + kvh * 64 + c * 8); vraw = ld16(PATT + (size_t)tokk * 768 + 640 + kvh * 64 + c * 8); }
        const u32x4 kp = qk_prep(kraw, kg, rope + (size_t)tk * 64, c, 1.0f);
        *(LAS u32x4*)(Ks + row * 72 + c * 8) = kp;
        LAS bf16_t* vp = Vt + (c * 8) * 264 + row;
        vp[0 * 264] = (bf16_t)(vraw.x & 0xffffu); vp[1 * 264] = (bf16_t)(vraw.x >> 16); vp[2 * 264] = (bf16_t)(vraw.y & 0xffffu); vp[3 * 264] = (bf16_t)(vraw.y >> 16);
        vp[4 * 264] = (bf16_t)(vraw.z & 0xffffu); vp[5 * 264] = (bf16_t)(vraw.z >> 16); vp[6 * 264] = (bf16_t)(vraw.w & 0xffffu); vp[7 * 264] = (bf16_t)(vraw.w >> 16);
    }
#pragma unroll 1
    for (int pass = 0; pass < 8; ++pass) {
        const int row = pass * 64 + (tid >> 3); const int g = row >> 7, ql = row & 127; const int tokq = tok0 + ql; const int hq = kvh * 4 + g;
        const u32x4 qraw = ld16(PATT + (size_t)tokq * 768 + hq * 64 + c * 8);
        *(LAS u32x4*)(Qs + row * 72 + c * 8) = qk_prep(qraw, qg, rope + (size_t)tokq * 64, c, 0.125f);
    }
    __syncthreads();
    const int g = wave >> 1; const int hq = kvh * 4 + g;
    const float sink = ((const float*)karg(23))[l * 8 + hq];
#pragma unroll 1
    for (int pp = 0; pp < 2; ++pp) {
        const int ql0 = (wave & 1) * 64 + pp * 32;
        f32x4 sacc[10][2];
#pragma unroll
        for (int n = 0; n < 10; ++n) { sacc[n][0] = (f32x4){0.f, 0.f, 0.f, 0.f}; sacc[n][1] = sacc[n][0]; }
#pragma unroll
        for (int kk2 = 0; kk2 < 2; ++kk2) {
            const bf16x8 q0 = *(const LAS bf16x8*)(Qs + (g * 128 + ql0 + fr) * 72 + 32 * kk2 + 8 * fq);
            const bf16x8 q1 = *(const LAS bf16x8*)(Qs + (g * 128 + ql0 + 16 + fr) * 72 + 32 * kk2 + 8 * fq);
#pragma unroll
            for (int n = 0; n < 10; ++n) {
                const bf16x8 kf = *(const LAS bf16x8*)(Ks + (ql0 + 16 * n + fr) * 72 + 32 * kk2 + 8 * fq);
                sacc[n][0] = __builtin_amdgcn_mfma_f32_16x16x32_bf16(kf, q0, sacc[n][0], 0, 0, 0);
                sacc[n][1] = __builtin_amdgcn_mfma_f32_16x16x32_bf16(kf, q1, sacc[n][1], 0, 0, 0);
            }
        }
        u32x2 pb[10][2];
#pragma unroll
        for (int mq = 0; mq < 2; ++mq) {
            const int qi = 128 + ql0 + 16 * mq + fr;
            float mx = -__builtin_inff();
#pragma unroll
            for (int n = 0; n < 10; ++n)
#pragma unroll
                for (int j = 0; j < 4; ++j) {
                    const int kj = ql0 + 16 * n + 4 * fq + j; const int dist = qi - kj;
                    const bool ok = (dist >= 0) && (dist < 128) && ((nbk > 0) || (kj >= 128));
                    const float s = ok ? sacc[n][mq][j] : -__builtin_inff();
                    sacc[n][mq][j] = s; mx = fmaxf(mx, s);
                }
            mx = fmaxf(mx, __shfl_xor(mx, 16)); mx = fmaxf(mx, __shfl_xor(mx, 32));
            const float mf = fmaxf(mx, sink);
            float sum = 0.f;
#pragma unroll
            for (int n = 0; n < 10; ++n)
#pragma unroll
                for (int j = 0; j < 4; ++j) { const float e = __expf(sacc[n][mq][j] - mf); sacc[n][mq][j] = e; sum += e; }
            sum += __shfl_xor(sum, 16); sum += __shfl_xor(sum, 32);
            const float inv = 1.0f / (sum + __expf(sink - mf));
#pragma unroll
            for (int n = 0; n < 10; ++n) { pb[n][mq].x = cvt_pk_bf16(sacc[n][mq][0] * inv, sacc[n][mq][1] * inv); pb[n][mq].y = cvt_pk_bf16(sacc[n][mq][2] * inv, sacc[n][mq][3] * inv); }
        }
        f32x4 oacc[4][2];
#pragma unroll
        for (int dt = 0; dt < 4; ++dt) { oacc[dt][0] = (f32x4){0.f, 0.f, 0.f, 0.f}; oacc[dt][1] = oacc[dt][0]; }
#pragma unroll
        for (int kc = 0; kc < 5; ++kc) {
            const u32x4 p0 = (u32x4){pb[2 * kc][0].x, pb[2 * kc][0].y, pb[2 * kc + 1][0].x, pb[2 * kc + 1][0].y};
            const u32x4 p1 = (u32x4){pb[2 * kc][1].x, pb[2 * kc][1].y, pb[2 * kc + 1][1].x, pb[2 * kc + 1][1].y};
#pragma unroll
            for (int dt = 0; dt < 4; ++dt) {
                const LAS bf16_t* vrow = Vt + (16 * dt + fr) * 264 + ql0 + 32 * kc + 4 * fq;
                const u32x2 va = *(const LAS u32x2*)vrow, vb = *(const LAS u32x2*)(vrow + 16);
                const u32x4 vv = (u32x4){va.x, va.y, vb.x, vb.y};
                oacc[dt][0] = __builtin_amdgcn_mfma_f32_16x16x32_bf16(__builtin_bit_cast(bf16x8, vv), __builtin_bit_cast(bf16x8, p0), oacc[dt][0], 0, 0, 0);
                oacc[dt][1] = __builtin_amdgcn_mfma_f32_16x16x32_bf16(__builtin_bit_cast(bf16x8, vv), __builtin_bit_cast(bf16x8, p1), oacc[dt][1], 0, 0, 0);
            }
        }
#pragma unroll
        for (int mq = 0; mq < 2; ++mq)
#pragma unroll
            for (int dt = 0; dt < 4; ++dt) {
                const int ql = ql0 + 16 * mq + fr;
                u32x2 w; w.x = cvt_pk_bf16(oacc[dt][mq][0], oacc[dt][mq][1]); w.y = cvt_pk_bf16(oacc[dt][mq][2], oacc[dt][mq][3]);
                *(u32x2*)(M3 + (size_t)(tok0 + ql) * 1536 + 1024 + hq * 64 + 16 * dt + 4 * fq) = w;
            }
    }
    __syncthreads();
}

__device__ __forceinline__ void mix1_phase(const Params& p, int l, LAS unsigned char* lds, const int wv) {
    const int tid = tid_(wv), G = gridDim.x;
    for (int item = bid_(); item < 1024; item += G) attn_item(p, l, item, lds, wv);
    const int gt = bid_() * NTHR + tid, NGT = G * NTHR;
    const bf16_t* PRW = (const bf16_t*)(KWS + WS_PRW); const bf16_t* PPOOL = (const bf16_t*)(KWS + WS_PPOOL); const bf16_t* PCONV = (const bf16_t*)(KWS + WS_PCONV);
    bf16_t* M3 = (bf16_t*)(KWS + WS_M3); bf16_t* AL = (bf16_t*)(KWS + WS_ALORA);
    const float* mu = (const float*)karg(4) + l * RWC;
    for (int idx = gt; idx < MTOK * 32; idx += NGT) {
        const int m = idx >> 5, c8 = (idx & 31) * 8, t = m & (SEQ - 1);
        float cur[8], prv[8], mm[8], o[8];
        unpack8(ld16(PRW + (size_t)m * RWC + 1536 + c8), cur);
        if (t > 0) unpack8(ld16(PRW + (size_t)(m - 1) * RWC + 1536 + c8), prv); else { _Pragma("unroll") for (int j = 0; j < 8; ++j) prv[j] = 0.f; }
        ld8f(mu + 1536 + c8, mm);
#pragma unroll
        for (int j = 0; j < 8; ++j) { const float s = cur[j] + (prv[j] - cur[j]) * mm[j];
            o[j] = c8 < 64 ? (1.0f - 2.0f / (__expf(2.0f * s) + 1.0f)) : (c8 < 128 ? s : sigmoidf_(s)); }
        *(u32x4*)(AL + (size_t)m * 256 + c8) = pack8(o);
    }
    const float* cw = (const float*)karg(19) + l * 3 * 512;
    for (int idx = gt; idx < MTOK * 64; idx += NGT) {
        const int m = idx >> 6, c8 = (idx & 63) * 8, t = m & (SEQ - 1);
        float bg[8], a[8] = {0.f, 0.f, 0.f, 0.f, 0.f, 0.f, 0.f, 0.f};
        unpack8(ld16(PCONV + (size_t)m * 1536 + c8), bg);
#pragma unroll
        for (int k = 0; k < 3; ++k) {
            if (t - 2 + k >= 0) { float cc[8], uu[8], ww[8];
                unpack8(ld16(PCONV + (size_t)(m - 2 + k) * 1536 + 512 + c8), cc); unpack8(ld16(PCONV + (size_t)(m - 2 + k) * 1536 + 1024 + c8), uu); ld8f(cw + k * 512 + c8, ww);
#pragma unroll
                for (int j = 0; j < 8; ++j) a[j] += ww[j] * (cc[j] * uu[j]); }
        }
#pragma unroll
        for (int j = 0; j < 8; ++j) a[j] *= bg[j];
        *(u32x4*)(M3 + (size_t)m * 1536 + 512 + c8) = pack8(a);
    }
    for (int idx = gt; idx < MTOK * 64; idx += NGT) {
        const int m = idx >> 6, c8 = (idx & 63) * 8, t = m & (SEQ - 1);
        const int win = 2 << (c8 >> 7);
        float u0[8], s[8];
        unpack8(ld16(PPOOL + (size_t)m * 512 + c8), u0);
#pragma unroll
        for (int j = 0; j < 8; ++j) s[j] = u0[j];
        for (int d = 1; d < win; ++d) { if (t - d >= 0) { float uu[8]; unpack8(ld16(PPOOL + (size_t)(m - d) * 512 + c8), uu);
#pragma unroll
                for (int j = 0; j < 8; ++j) s[j] += uu[j]; } }
        const float ic = 1.0f / (float)(t + 1 < win ? t + 1 : win);
#pragma unroll
        for (int j = 0; j < 8; ++j) s[j] = s[j] * ic - u0[j];
        *(u32x4*)(M3 + (size_t)m * 1536 + c8) = pack8(s);
    }
}

constexpr int TC = 32, NCH = SEQ / TC, SROW = 352;
__device__ __forceinline__ float dpp_sum16(float v) {
    v += __builtin_bit_cast(float, __builtin_amdgcn_mov_dpp(__builtin_bit_cast(int, v), 0xB1, 0xF, 0xF, true));
    v += __builtin_bit_cast(float, __builtin_amdgcn_mov_dpp(__builtin_bit_cast(int, v), 0x4E, 0xF, 0xF, true));
    v += __builtin_bit_cast(float, __builtin_amdgcn_mov_dpp(__builtin_bit_cast(int, v), 0x141, 0xF, 0xF, true));
    v += __builtin_bit_cast(float, __builtin_amdgcn_mov_dpp(__builtin_bit_cast(int, v), 0x140, 0xF, 0xF, true));
    return v;
}
__device__ __forceinline__ void scan_phase(const Params& p, int l, LAS unsigned char* lds, const int wv) {
    const int tid = tid_(wv), lane = tid & 63, wave = __builtin_amdgcn_readfirstlane(tid >> 6);
    const bf16_t* PRW = (const bf16_t*)(KWS + WS_PRW); const bf16_t* LORA = (const bf16_t*)(KWS + WS_LORA);
    bf16_t* YRAW = (bf16_t*)(KWS + WS_YRAW); float* BONUS = (float*)(KWS + WS_BONUS);
    LAS float* inb = (LAS float*)lds;
    LAS float* yb = inb + 2 * TC * SROW;
    for (int item = bid_(); item < 256; item += gridDim.x) {
        const int chain = item >> 1, half = item & 1, b = chain >> 3, head = chain & 7;
        const int pt = tid - 256, t_l = (pt >> 3) & 31, cgi = pt & 7, c0 = cgi * 8, ch = head * 64 + c0;
        const float* mu = (const float*)karg(4) + l * RWC + ch; const float* ckk = (const float*)karg(10) + l * 512 + ch; const float* cka = (const float*)karg(11) + l * 512 + ch; const float* crk = (const float*)karg(12) + l * 512 + ch;
        u32x4 raw[8], rawb[8];
        const bf16_t* prw0 = PRW + ((size_t)b * SEQ + t_l) * RWC + ch; const bf16_t* lor0 = LORA + ((size_t)b * SEQ + t_l) * 1536 + ch;
#define SCAN_LOAD(dst, n_) do { const bf16_t* q_ = prw0 + (size_t)(n_) * TC * RWC; const bf16_t* lq_ = lor0 + (size_t)(n_) * TC * 1536; \
            dst[0] = ld16(q_); dst[1] = ld16(q_ + 512); dst[2] = ld16(q_ + 1024); \
            if ((n_) * TC + t_l > 0) { dst[3] = ld16(q_ - RWC); dst[4] = ld16(q_ - RWC + 512); dst[5] = ld16(q_ - RWC + 1024); } \
            else { dst[3] = (u32x4){0u, 0u, 0u, 0u}; dst[4] = dst[3]; dst[5] = dst[3]; } \
            dst[6] = ld16(lq_); dst[7] = ld16(lq_ + 512); } while (0)
        if (wave >= 4) {
            SCAN_LOAD(raw, 0);
        }
        const int seg = lane & 15, rg = lane >> 4, rr0 = (wave & 3) * 8 + rg * 2;
        f32x2 Sa0 = (f32x2){0.f, 0.f}, Sa1 = Sa0, Sb0 = Sa0, Sb1 = Sa0;
#pragma unroll 1
        for (int n2 = 0; n2 <= NCH + 1; n2 += 2) {
        { const int n = n2;
            if (wave >= 4) {
                if (n >= 2) {
                    const LAS float* ys = yb + (n & 1) * TC * 32 + t_l * 32 + cgi * 4;
                    const f32x4 yv = *(const LAS f32x4*)ys;
                    u32x2 w; w.x = cvt_pk_bf16(yv[0], yv[1]); w.y = cvt_pk_bf16(yv[2], yv[3]);
                    *(u32x2*)(YRAW + (size_t)(b * SEQ + (n - 2) * TC + t_l) * 512 + head * 64 + half * 32 + cgi * 4) = w;
                }
                if (n < NCH) {
                    if (n + 1 < NCH) SCAN_LOAD(rawb, n + 1);
                    const size_t m = (size_t)b * SEQ + n * TC + t_l;
                    float mur[8], muk[8], muv[8], kkc[8], kac[8], rkc[8];
                    ld8f(mu, mur); ld8f(mu + 512, muk); ld8f(mu + 1024, muv); ld8f(ckk, kkc); ld8f(cka, kac); ld8f(crk, rkc);
                    float r[8], k[8], v[8], rp[8], kp[8], vp[8], sl[8], al[8];
                    unpack8(raw[0], r); unpack8(raw[1], k); unpack8(raw[2], v); unpack8(raw[3], rp); unpack8(raw[4], kp); unpack8(raw[5], vp); unpack8(raw[6], sl); unpack8(raw[7], al);
                    float kkr[8], ss = 0.f, bon = 0.f, dec[8], kpr[8];
#pragma unroll
                    for (int j = 0; j < 8; ++j) {
                        r[j] = r[j] + (rp[j] - r[j]) * mur[j]; k[j] = k[j] + (kp[j] - k[j]) * muk[j]; v[j] = v[j] + (vp[j] - v[j]) * muv[j];
                        dec[j] = __expf(-0.6065306597126334f * sl[j]);
                        kkr[j] = k[j] * kkc[j]; ss += kkr[j] * kkr[j];
                        kpr[j] = k[j] * (1.0f + (al[j] - 1.0f) * kac[j]);
                        bon += r[j] * kpr[j] * rkc[j];
                    }
                    ss = dpp_sum8(ss); bon = dpp_sum8(bon);
                    const float inrm = 1.0f / fmaxf(sqrtf(ss), 1e-12f);
                    LAS float* dst = inb + (n & 1) * TC * SROW + t_l * SROW + c0;
                    f32x4 w0, w1;
                    w0 = (f32x4){kkr[0] * inrm, kkr[1] * inrm, kkr[2] * inrm, kkr[3] * inrm}; w1 = (f32x4){kkr[4] * inrm, kkr[5] * inrm, kkr[6] * inrm, kkr[7] * inrm};
                    *(LAS f32x4*)(dst) = w0; *(LAS f32x4*)(dst + 4) = w1;
                    *(LAS f32x4*)(dst + 192) = (f32x4){w0[0] * al[0], w0[1] * al[1], w0[2] * al[2], w0[3] * al[3]}; *(LAS f32x4*)(dst + 196) = (f32x4){w1[0] * al[4], w1[1] * al[5], w1[2] * al[6], w1[3] * al[7]};
                    *(LAS f32x4*)(dst + 64) = (f32x4){dec[0], dec[1], dec[2], dec[3]}; *(LAS f32x4*)(dst + 68) = (f32x4){dec[4], dec[5], dec[6], dec[7]};
                    *(LAS f32x4*)(dst + 128) = (f32x4){kpr[0], kpr[1], kpr[2], kpr[3]}; *(LAS f32x4*)(dst + 132) = (f32x4){kpr[4], kpr[5], kpr[6], kpr[7]};
                    *(LAS f32x4*)(dst + 256) = (f32x4){r[0], r[1], r[2], r[3]}; *(LAS f32x4*)(dst + 260) = (f32x4){r[4], r[5], r[6], r[7]};
                    if ((cgi >> 2) == half) { LAS float* vd = inb + (n & 1) * TC * SROW + t_l * SROW + 320 + (c0 - 32 * half);
                        *(LAS f32x4*)(vd) = (f32x4){v[0], v[1], v[2], v[3]}; *(LAS f32x4*)(vd + 4) = (f32x4){v[4], v[5], v[6], v[7]}; }
                    if (half == 0 && cgi == 0) BONUS[m * 8 + head] = bon;
                }
            } else if (n >= 1 && n <= NCH) {
                const LAS float* src = inb + ((n - 1) & 1) * TC * SROW + seg * 4;
                const LAS float* vsrc = inb + ((n - 1) & 1) * TC * SROW + 320 + rr0;
                LAS float* yd = yb + ((n - 1) & 1) * TC * 32 + rr0;
#define SCAN_RD2(q_, tl_) do { const LAS float* s_ = src + (tl_) * SROW; kkq[q_] = *(const LAS f32x4*)(s_); dcq[q_] = *(const LAS f32x4*)(s_ + 64); kpq[q_] = *(const LAS f32x4*)(s_ + 128); \
                    bvq[q_] = *(const LAS f32x4*)(s_ + 192); rvq[q_] = *(const LAS f32x4*)(s_ + 256); vvq[q_] = *(const LAS f32x2*)(vsrc + (tl_) * SROW); } while (0)
                f32x4 kkq[4], dcq[4], kpq[4], bvq[4], rvq[4]; f32x2 vvq[4];
                SCAN_RD2(0, 0); SCAN_RD2(1, 1);
#pragma unroll 1
                for (int tl4 = 0; tl4 < TC; tl4 += 4) {
                    float yA[4], yB[4];
#pragma unroll
                    for (int u = 0; u < 4; ++u) {
                        { const int tn = tl4 + u + 2 < TC ? tl4 + u + 2 : TC - 1; SCAN_RD2((u + 2) & 3, tn); }
                        const f32x4 kk = kkq[u], dc = dcq[u], kp = kpq[u], bv = bvq[u], rv = rvq[u]; const f32x2 vv = vvq[u];
                        const f32x2 kk0 = (f32x2){kk[0], kk[1]}, kk1 = (f32x2){kk[2], kk[3]};
                        const f32x2 kp0 = (f32x2){kp[0], kp[1]}, kp1 = (f32x2){kp[2], kp[3]}, bv0 = (f32x2){bv[0], bv[1]}, bv1 = (f32x2){bv[2], bv[3]};
                        const f32x2 dc0 = (f32x2){dc[0], dc[1]}, dc1 = (f32x2){dc[2], dc[3]};
                        const f32x2 r0 = (f32x2){rv[0], rv[1]}, r1 = (f32x2){rv[2], rv[3]};
                        const f32x2 va = (f32x2){vv.x, vv.x}, vb = (f32x2){vv.y, vv.y};
                        f32x2 da = Sa0 * kk0; da += Sa1 * kk1; f32x2 db = Sb0 * kk0; db += Sb1 * kk1;
                        const float saa = dpp_sum16(da.x + da.y), sab = dpp_sum16(db.x + db.y);
                        const f32x2 na = (f32x2){-saa, -saa}, nb = (f32x2){-sab, -sab};
                        Sa0 = Sa0 * dc0 + (va * kp0 + na * bv0); Sa1 = Sa1 * dc1 + (va * kp1 + na * bv1);
                        Sb0 = Sb0 * dc0 + (vb * kp0 + nb * bv0); Sb1 = Sb1 * dc1 + (vb * kp1 + nb * bv1);
                        f32x2 ya = Sa0 * r0; ya += Sa1 * r1; f32x2 yb2 = Sb0 * r0; yb2 += Sb1 * r1;
                        yA[u] = dpp_sum16(ya.x + ya.y); yB[u] = dpp_sum16(yb2.x + yb2.y);
                    }
                    const float y0 = seg == 0 ? yA[0] : seg == 1 ? yA[1] : seg == 2 ? yA[2] : yA[3];
                    const float y1 = seg == 0 ? yB[0] : seg == 1 ? yB[1] : seg == 2 ? yB[2] : yB[3];
                    if (seg < 4) *(LAS f32x2*)(yd + (tl4 + seg) * 32) = (f32x2){y0, y1};
                }
#undef SCAN_RD2
            }
            __syncthreads();
        }
        { const int n = n2 + 1;
            if (wave >= 4) {
                if (n >= 2) {
                    const LAS float* ys = yb + (n & 1) * TC * 32 + t_l * 32 + cgi * 4;
                    const f32x4 yv = *(const LAS f32x4*)ys;
                    u32x2 w; w.x = cvt_pk_bf16(yv[0], yv[1]); w.y = cvt_pk_bf16(yv[2], yv[3]);
                    *(u32x2*)(YRAW + (size_t)(b * SEQ + (n - 2) * TC + t_l) * 512 + head * 64 + half * 32 + cgi * 4) = w;
                }
                if (n < NCH) {
                    if (n + 1 < NCH) SCAN_LOAD(raw, n + 1);
                    const size_t m = (size_t)b * SEQ + n * TC + t_l;
                    float mur[8], muk[8], muv[8], kkc[8], kac[8], rkc[8];
                    ld8f(mu, mur); ld8f(mu + 512, muk); ld8f(mu + 1024, muv); ld8f(ckk, kkc); ld8f(cka, kac); ld8f(crk, rkc);
                    float r[8], k[8], v[8], rp[8], kp[8], vp[8], sl[8], al[8];
                    unpack8(rawb[0], r); unpack8(rawb[1], k); unpack8(rawb[2], v); unpack8(rawb[3], rp); unpack8(rawb[4], kp); unpack8(rawb[5], vp); unpack8(rawb[6], sl); unpack8(rawb[7], al);
                    float kkr[8], ss = 0.f, bon = 0.f, dec[8], kpr[8];
#pragma unroll
                    for (int j = 0; j < 8; ++j) {
                        r[j] = r[j] + (rp[j] - r[j]) * mur[j]; k[j] = k[j] + (kp[j] - k[j]) * muk[j]; v[j] = v[j] + (vp[j] - v[j]) * muv[j];
                        dec[j] = __expf(-0.6065306597126334f * sl[j]);
                        kkr[j] = k[j] * kkc[j]; ss += kkr[j] * kkr[j];
                        kpr[j] = k[j] * (1.0f + (al[j] - 1.0f) * kac[j]);
                        bon += r[j] * kpr[j] * rkc[j];
                    }
                    ss = dpp_sum8(ss); bon = dpp_sum8(bon);
                    const float inrm = 1.0f / fmaxf(sqrtf(ss), 1e-12f);
                    LAS float* dst = inb + (n & 1) * TC * SROW + t_l * SROW + c0;
                    f32x4 w0, w1;
                    w0 = (f32x4){kkr[0] * inrm, kkr[1] * inrm, kkr[2] * inrm, kkr[3] * inrm}; w1 = (f32x4){kkr[4] * inrm, kkr[5] * inrm, kkr[6] * inrm, kkr[7] * inrm};
                    *(LAS f32x4*)(dst) = w0; *(LAS f32x4*)(dst + 4) = w1;
                    *(LAS f32x4*)(dst + 192) = (f32x4){w0[0] * al[0], w0[1] * al[1], w0[2] * al[2], w0[3] * al[3]}; *(LAS f32x4*)(dst + 196) = (f32x4){w1[0] * al[4], w1[1] * al[5], w1[2] * al[6], w1[3] * al[7]};
                    *(LAS f32x4*)(dst + 64) = (f32x4){dec[0], dec[1], dec[2], dec[3]}; *(LAS f32x4*)(dst + 68) = (f32x4){dec[4], dec[5], dec[6], dec[7]};
                    *(LAS f32x4*)(dst + 128) = (f32x4){kpr[0], kpr[1], kpr[2], kpr[3]}; *(LAS f32x4*)(dst + 132) = (f32x4){kpr[4], kpr[5], kpr[6], kpr[7]};
                    *(LAS f32x4*)(dst + 256) = (f32x4){r[0], r[1], r[2], r[3]}; *(LAS f32x4*)(dst + 260) = (f32x4){r[4], r[5], r[6], r[7]};
                    if ((cgi >> 2) == half) { LAS float* vd = inb + (n & 1) * TC * SROW + t_l * SROW + 320 + (c0 - 32 * half);
                        *(LAS f32x4*)(vd) = (f32x4){v[0], v[1], v[2], v[3]}; *(LAS f32x4*)(vd + 4) = (f32x4){v[4], v[5], v[6], v[7]}; }
                    if (half == 0 && cgi == 0) BONUS[m * 8 + head] = bon;
                }
            } else if (n >= 1 && n <= NCH) {
                const LAS float* src = inb + ((n - 1) & 1) * TC * SROW + seg * 4;
                const LAS float* vsrc = inb + ((n - 1) & 1) * TC * SROW + 320 + rr0;
                LAS float* yd = yb + ((n - 1) & 1) * TC * 32 + rr0;
#define SCAN_RD2(q_, tl_) do { const LAS float* s_ = src + (tl_) * SROW; kkq[q_] = *(const LAS f32x4*)(s_); dcq[q_] = *(const LAS f32x4*)(s_ + 64); kpq[q_] = *(const LAS f32x4*)(s_ + 128); \
                    bvq[q_] = *(const LAS f32x4*)(s_ + 192); rvq[q_] = *(const LAS f32x4*)(s_ + 256); vvq[q_] = *(const LAS f32x2*)(vsrc + (tl_) * SROW); } while (0)
                f32x4 kkq[4], dcq[4], kpq[4], bvq[4], rvq[4]; f32x2 vvq[4];
                SCAN_RD2(0, 0); SCAN_RD2(1, 1);
#pragma unroll 1
                for (int tl4 = 0; tl4 < TC; tl4 += 4) {
                    float yA[4], yB[4];
#pragma unroll
                    for (int u = 0; u < 4; ++u) {
                        { const int tn = tl4 + u + 2 < TC ? tl4 + u + 2 : TC - 1; SCAN_RD2((u + 2) & 3, tn); }
                        const f32x4 kk = kkq[u], dc = dcq[u], kp = kpq[u], bv = bvq[u], rv = rvq[u]; const f32x2 vv = vvq[u];
                        const f32x2 kk0 = (f32x2){kk[0], kk[1]}, kk1 = (f32x2){kk[2], kk[3]};
                        const f32x2 kp0 = (f32x2){kp[0], kp[1]}, kp1 = (f32x2){kp[2], kp[3]}, bv0 = (f32x2){bv[0], bv[1]}, bv1 = (f32x2){bv[2], bv[3]};
                        const f32x2 dc0 = (f32x2){dc[0], dc[1]}, dc1 = (f32x2){dc[2], dc[3]};
                        const f32x2 r0 = (f32x2){rv[0], rv[1]}, r1 = (f32x2){rv[2], rv[3]};
                        const f32x2 va = (f32x2){vv.x, vv.x}, vb = (f32x2){vv.y, vv.y};
                        f32x2 da = Sa0 * kk0; da += Sa1 * kk1; f32x2 db = Sb0 * kk0; db += Sb1 * kk1;
                        const float saa = dpp_sum16(da.x + da.y), sab = dpp_sum16(db.x + db.y);
                        const f32x2 na = (f32x2){-saa, -saa}, nb = (f32x2){-sab, -sab};
                        Sa0 = Sa0 * dc0 + (va * kp0 + na * bv0); Sa1 = Sa1 * dc1 + (va * kp1 + na * bv1);
                        Sb0 = Sb0 * dc0 + (vb * kp0 + nb * bv0); Sb1 = Sb1 * dc1 + (vb * kp1 + nb * bv1);
                        f32x2 ya = Sa0 * r0; ya += Sa1 * r1; f32x2 yb2 = Sb0 * r0; yb2 += Sb1 * r1;
                        yA[u] = dpp_sum16(ya.x + ya.y); yB[u] = dpp_sum16(yb2.x + yb2.y);
                    }
                    const float y0 = seg == 0 ? yA[0] : seg == 1 ? yA[1] : seg == 2 ? yA[2] : yA[3];
                    const float y1 = seg == 0 ? yB[0] : seg == 1 ? yB[1] : seg == 2 ? yB[2] : yB[3];
                    if (seg < 4) *(LAS f32x2*)(yd + (tl4 + seg) * 32) = (f32x2){y0, y1};
                }
#undef SCAN_RD2
            }
            __syncthreads();
        }
        }
#undef SCAN_LOAD
    }
}

__device__ __forceinline__ void post_phase(const Params& p, int l, const int wv) {
    const int gt = bid_() * NTHR + tid_(wv), NGT = gridDim.x * NTHR;
    const bf16_t* PRW = (const bf16_t*)(KWS + WS_PRW); const bf16_t* LORA = (const bf16_t*)(KWS + WS_LORA); const bf16_t* YRAW = (const bf16_t*)(KWS + WS_YRAW);
    const float* BONUS = (const float*)(KWS + WS_BONUS); bf16_t* MA = (bf16_t*)(KWS + WS_MA);
    const float* muv = (const float*)karg(4) + l * RWC + 1024; const float* lg = (const float*)karg(13) + l * 512; const float* lb = (const float*)karg(14) + l * 512;
    for (int idx = gt; idx < MTOK * 64; idx += NGT) {
        const int m = idx >> 6, c = (idx & 63) * 8, head = c >> 6, t = m & (SEQ - 1);
        float y[8], cur[8], prv[8], mm[8], g[8], gg[8], bb[8], o[8];
        unpack8(ld16(YRAW + (size_t)m * 512 + c), y);
        float s = 0.f;
#pragma unroll
        for (int j = 0; j < 8; ++j) s += y[j];
        const float mean = dpp_sum8(s) * (1.0f / 64.0f);
        float q = 0.f;
#pragma unroll
        for (int j = 0; j < 8; ++j) { y[j] -= mean; q += y[j] * y[j]; }
        const float rstd = 1.0f / sqrtf(dpp_sum8(q) * (1.0f / 64.0f) + 64e-5f);
        unpack8(ld16(PRW + (size_t)m * RWC + 1024 + c), cur);
        if (t > 0) unpack8(ld16(PRW + (size_t)(m - 1) * RWC + 1024 + c), prv); else { _Pragma("unroll") for (int j = 0; j < 8; ++j) prv[j] = 0.f; }
        ld8f(muv + c, mm); ld8f(lg + c, gg); ld8f(lb + c, bb);
        unpack8(ld16(LORA + (size_t)m * 1536 + 1024 + c), g);
        const float bon = BONUS[(size_t)m * 8 + head];
#pragma unroll
        for (int j = 0; j < 8; ++j) { const float vs = cur[j] + (prv[j] - cur[j]) * mm[j]; o[j] = (y[j] * rstd * gg[j] + bb[j] + bon * vs) * g[j]; }
        *(u32x4*)(MA + (size_t)m * 512 + c) = pack8(o);
    }
}

__global__ void __launch_bounds__(NTHR, 2) hybrid_fwd(Params p) {
    extern __shared__ __attribute__((aligned(16))) unsigned char lds_raw[];
    LAS unsigned char* lds = (LAS unsigned char*)lds_raw;
    cg::grid_group grid = cg::this_grid();
    const int wv = __builtin_amdgcn_readfirstlane((int)threadIdx.x >> 6);
    const int G = gridDim.x;
    const int lo = p.ph_lo, hi = p.ph_hi;
#define RUN(k) (lo <= (k) && (k) < hi)
#ifndef REPEAT_MASK
#define REPEAT_MASK 0
#endif
#define REP(k) _Pragma("unroll 1") for (int rep_ = 0; rep_ < 1 + ((REPEAT_MASK >> (k)) & 1); ++rep_)
#define SYNC(k) do { if (RUN(k) && RUN((k) + 1)) grid.sync(); } while (0)
    if (RUN(0)) {
        prologue_phase(p, lds, wv);
        norm_phase((const float*)karg(0), (const float*)karg(2), (bf16_t*)(KWS + WS_H), wv);
    }
    SYNC(0);
#pragma unroll 1
    for (int l = 0; l < NL; ++l) {
        const int pb = 1 + 11 * l;
        const char* wl = (const char*)(KWS + WS_W) + (size_t)l * LW_ELEMS * 2;
        if (RUN(pb + 0)) REP(0) {
            pg::DenseSched S{(const char*)(KWS + WS_H), wl + OW_IN * 2, 2048u, 2048u, 16, 256, 18, G, bid_()};
            pg::EpiIn E{(bf16_t*)(KWS + WS_PRW), (bf16_t*)(KWS + WS_PPOOL), (bf16_t*)(KWS + WS_PCONV), (bf16_t*)(KWS + WS_PATT)};
            pg::gemm_phase(lds, S, E, wv);
        }
        SYNC(pb + 0);
        if (RUN(pb + 1)) REP(1) mix1_phase(p, l, lds, wv);
        SYNC(pb + 1);
        if (RUN(pb + 2)) REP(2) {
            pg::DenseSched S{(const char*)(KWS + WS_ALORA), wl + OW_LORA * 2, 512u, 512u, 4, 256, 6, G, bid_()};
            pg::EpiLora E{(bf16_t*)(KWS + WS_LORA), (const float*)karg(6) + l * 512, (const float*)karg(8) + l * 512};
            pg::gemm_phase(lds, S, E, wv);
        }
        SYNC(pb + 2);
        if (RUN(pb + 3)) REP(3) scan_phase(p, l, lds, wv);
        SYNC(pb + 3);
        if (RUN(pb + 4)) REP(4) post_phase(p, l, wv);
        SYNC(pb + 4);
        if (RUN(pb + 5)) REP(5) {
            const int c = bid_();
            pg::BRSched S{(const char*)(KWS + WS_H), wl + OW_IN * 2, (const char*)(KWS + WS_MA), (const char*)(KWS + WS_M3), wl + OW_BR * 2, G, c};
            pg::EpiBR E{(u32x4*)(KWS + WS_GSCR + (size_t)c * 131072), (bf16_t*)(KWS + WS_MIXED)};
            pg::gemm_phase(lds, S, E, wv);
        }
        SYNC(pb + 5);
        if (RUN(pb + 6)) {
            pg::DenseSched S{(const char*)(KWS + WS_MIXED), wl + OW_O * 2, 2048u, 2048u, 16, 256, 4, G, bid_()};
            pg::EpiRes E{l == 0 ? (const float*)karg(0) : (const float*)KOUT, KOUT};
            pg::gemm_phase(lds, S, E, wv);
        }
        SYNC(pb + 6);
        if (RUN(pb + 7)) REP(7) norm_phase(KOUT, (const float*)karg(26) + l * DM, (bf16_t*)(KWS + WS_H), wv);
        SYNC(pb + 7);
        if (RUN(pb + 8)) REP(8) {
            pg::DenseSched S{(const char*)(KWS + WS_H), wl + OW_GU * 2, 2048u, 2048u, 16, 256, 22, G, bid_()};
            pg::EpiGU E{(bf16_t*)(KWS + WS_ACT)};
            pg::gemm_phase(lds, S, E, wv);
        }
        SYNC(pb + 8);
        if (RUN(pb + 9)) {
            pg::DenseSched S{(const char*)(KWS + WS_ACT), wl + OW_D * 2, (unsigned)(DFF * 2), (unsigned)(DFF * 2), 44, 256, 4, G, bid_()};
            pg::EpiRes E{(const float*)KOUT, KOUT};
            pg::gemm_phase(lds, S, E, wv);
        }
        SYNC(pb + 9);
        if (RUN(pb + 10) && l + 1 < NL) norm_phase(KOUT, (const float*)karg(2) + (l + 1) * DM, (bf16_t*)(KWS + WS_H), wv);
        SYNC(pb + 10);
    }
#undef RUN
#undef SYNC
}

constexpr int N_PHASES = 1 + 11 * NL - 1;

extern "C" void kernel_launch(void* const* d_in, const int* in_sizes, int n_in, void* d_out, int out_size, void* d_ws, size_t ws_size, hipStream_t stream) {
    static int grid = 0;
    if (grid == 0) {
        if (n_in != 30 || out_size != MTOK * DM || ws_size < WS_END) { fprintf(stderr, "kernel_launch: unexpected shapes (n_in %d out %d ws %zu)\n", n_in, out_size, ws_size); grid = -1; return; }
        int dev = 0, cus = 0, per_cu = 0;
        (void)hipGetDevice(&dev); (void)hipDeviceGetAttribute(&cus, hipDeviceAttributeMultiprocessorCount, dev);
        (void)hipFuncSetAttribute((const void*)hybrid_fwd, hipFuncAttributeMaxDynamicSharedMemorySize, LDS_BYTES);
        (void)hipOccupancyMaxActiveBlocksPerMultiprocessor(&per_cu, (const void*)hybrid_fwd, NTHR, LDS_BYTES);
        if (per_cu < 1) { fprintf(stderr, "kernel_launch: occupancy query says %d blocks/CU\n", per_cu); per_cu = 1; }
        (void)hipGetLastError();
        grid = cus;
    }
    if (grid < 0) return;
    Params p{};
    for (int i = 0; i < 30; ++i) p.in[i] = d_in[i];
    p.out = (float*)d_out; p.ws = (unsigned char*)d_ws;
#ifdef MULTI_LAUNCH
    for (int ph = 0; ph < N_PHASES; ++ph) { p.ph_lo = ph; p.ph_hi = ph + 1; hipLaunchKernelGGL(hybrid_fwd, dim3(grid), dim3(NTHR), LDS_BYTES, stream, p); }
#else
    p.ph_lo = 0; p.ph_hi = N_PHASES;
    void* args[] = {&p};
    hipError_t e = hipLaunchCooperativeKernel((const void*)hybrid_fwd, dim3(grid), dim3(NTHR), args, LDS_BYTES, stream);
    if (e != hipSuccess) fprintf(stderr, "cooperative launch failed: %s (grid %d)\n", hipGetErrorString(e), grid);
#endif
}
```

```cpp
#include <hip/hip_runtime.h>
#include <hip/hip_cooperative_groups.h>
#include <cstdio>
#include <cstdint>
namespace cg = cooperative_groups;

#define LAS __attribute__((address_space(3)))
typedef unsigned short bf16_t;
typedef short bf16x8 __attribute__((ext_vector_type(8)));
typedef float f32x4 __attribute__((ext_vector_type(4)));
typedef float f32x2 __attribute__((ext_vector_type(2)));
typedef unsigned u32x4 __attribute__((ext_vector_type(4)));
typedef unsigned u32x2 __attribute__((ext_vector_type(2)));

constexpr int MTOK = 65536, SEQ = 4096, DM = 1024, NL = 2;
constexpr int RWC = 1792, INC = 8704, DFF = 2816;
constexpr int NTHR = 512;
constexpr size_t MiB = 1u << 20;
constexpr size_t OW_IN = 0, OW_LORA = 8912896, OW_BR = OW_LORA + 393216, OW_O = OW_BR + 2097152, OW_GU = OW_O + 1048576, OW_D = OW_GU + 5767168, LW_ELEMS = OW_D + 2883584;
constexpr size_t WS_W = 0, WS_BONUS = 82 * MiB, WS_ROPE = 84 * MiB, WS_H = 92 * MiB, WS_M3 = 220 * MiB, WS_PRW = 412 * MiB, WS_PPOOL = 636 * MiB,
                 WS_PCONV = 700 * MiB, WS_PATT = 892 * MiB, WS_ALORA = 988 * MiB, WS_END = 1020 * MiB;
constexpr size_t WS_CTL = 81 * MiB;
constexpr size_t WS_LORA = 636 * MiB, WS_YRAW = 828 * MiB, WS_MA = 892 * MiB, WS_GSCR = 956 * MiB, WS_MIXED = 412 * MiB, WS_ACT = 220 * MiB;
static_assert(2 * LW_ELEMS * 2 <= 81 * MiB, "weights fit below the control words");
constexpr int LDS_BYTES = 147456;

struct Params { const void* in[30]; float* out; unsigned char* ws; int ph_lo, ph_hi; };

__device__ __forceinline__ unsigned cvt_pk_bf16(float lo, float hi) { unsigned r; asm volatile("v_cvt_pk_bf16_f32 %0, %1, %2" : "=v"(r) : "v"(lo), "v"(hi)); return r; }
__device__ __forceinline__ void unpack8(const u32x4 w, float (&f)[8]) {
    f[0] = __uint_as_float(w.x << 16); f[1] = __uint_as_float(w.x & 0xffff0000u); f[2] = __uint_as_float(w.y << 16); f[3] = __uint_as_float(w.y & 0xffff0000u);
    f[4] = __uint_as_float(w.z << 16); f[5] = __uint_as_float(w.z & 0xffff0000u); f[6] = __uint_as_float(w.w << 16); f[7] = __uint_as_float(w.w & 0xffff0000u);
}
__device__ __forceinline__ u32x4 pack8(const float (&f)[8]) { u32x4 w; w.x = cvt_pk_bf16(f[0], f[1]); w.y = cvt_pk_bf16(f[2], f[3]); w.z = cvt_pk_bf16(f[4], f[5]); w.w = cvt_pk_bf16(f[6], f[7]); return w; }
__device__ __forceinline__ u32x4 ld16(const bf16_t* p) { return *(const u32x4*)p; }
__device__ __forceinline__ void ld8f(const float* p, float (&f)[8]) { const f32x4 a = *(const f32x4*)p, b = *(const f32x4*)(p + 4); f[0] = a.x; f[1] = a.y; f[2] = a.z; f[3] = a.w; f[4] = b.x; f[5] = b.y; f[6] = b.z; f[7] = b.w; }
__device__ __forceinline__ float sigmoidf_(float x) { return 1.0f / (1.0f + __expf(-x)); }
__device__ __forceinline__ const void* karg(int idx) {
    const __attribute__((address_space(4))) unsigned long long* kp = (const __attribute__((address_space(4))) unsigned long long*)__builtin_amdgcn_kernarg_segment_ptr();
    asm volatile("" : "+s"(kp));
    return (const void*)kp[idx];
}
#define KWS ((unsigned char*)karg(31))
#define KOUT ((float*)karg(30))
__device__ __forceinline__ int tid_(int wv) { int t; asm volatile("v_mbcnt_lo_u32_b32 %0, -1, 0\n\tv_mbcnt_hi_u32_b32 %0, -1, %0" : "=v"(t)); return (wv << 6) | t; }
__device__ __forceinline__ int bid_() { int b = blockIdx.x; asm volatile("" : "+s"(b)); return b; }
__device__ __forceinline__ float dpp_sum8(float v) {
    v += __builtin_bit_cast(float, __builtin_amdgcn_mov_dpp(__builtin_bit_cast(int, v), 0xB1, 0xF, 0xF, true));
    v += __builtin_bit_cast(float, __builtin_amdgcn_mov_dpp(__builtin_bit_cast(int, v), 0x4E, 0xF, 0xF, true));
    v += __builtin_bit_cast(float, __builtin_amdgcn_mov_dpp(__builtin_bit_cast(int, v), 0x141, 0xF, 0xF, true));
    return v;
}

namespace pg {
constexpr int BM = 256, BK = 64, HALF = 128, HTB = HALF * BK * 2, NXCD = 8, WGM = 8;
__device__ __forceinline__ int lds_byte(int r, int c) { const int st = (r >> 4) * 2 + (c >> 5), rr = r & 15, cc = c & 31, ob = rr * 64 + cc * 2; return st * 1024 + (ob ^ (((ob >> 9) & 1) << 5)); }
__device__ __forceinline__ void stage_rc(int b, int& R, int& C) { const int st = b / 1024, sb = b % 1024, swz = sb ^ (((sb >> 9) & 1) << 5); R = (st >> 1) * 16 + swz / 64; C = (st & 1) * 32 + (swz % 64) / 2; }
__device__ __forceinline__ int perm32(int rho) { const int n = rho >> 4, i = rho & 15; return 8 * (i >> 2) + 4 * n + (i & 3); }

struct GUnit { const char* A; const char* B; unsigned lda2, ldb2; int nt, pm, pn, aux; };

__device__ __forceinline__ bool tile_order(int i, int G, int c, int nM, int nN, int& pm, int& pn) {
    const int nwg = nM * nN; const long L = (long)i * G + c; if (L >= nwg) return false;
    int wgid = (int)L; { const int q = nwg / NXCD, r = nwg % NXCD, xcd = wgid % NXCD, off = wgid / NXCD; wgid = (xcd < r ? xcd * (q + 1) : r * (q + 1) + (xcd - r) * q) + off; }
    const int nig = WGM * nN, gid = wgid / nig, fm = gid * WGM, gsz = (nM - fm) < WGM ? (nM - fm) : WGM;
    pm = fm + ((wgid % nig) % gsz); pn = (wgid % nig) / gsz; return true;
}
struct DenseSched {
    const char* A; const char* B; unsigned lda2, ldb2; int nt, nM, nN, G, c;
    __device__ __forceinline__ bool next(int i, GUnit& u) const {
        int pm, pn; if (!tile_order(i, G, c, nM, nN, pm, pn)) return false;
        u.A = A + (size_t)pm * 256 * lda2; u.B = B + (size_t)pn * 256 * ldb2; u.lda2 = lda2; u.ldb2 = ldb2; u.nt = nt; u.pm = pm; u.pn = pn; u.aux = 0; return true;
    }
};
struct BRSched {
    const char* H; const char* WIN; const char* MA; const char* M3; const char* WBR; int G, c;
    __device__ __forceinline__ bool next(int i, GUnit& u) const {
        int pm, pn; if (!tile_order(i >> 3, G, c, 256, 4, pm, pn)) return false;
        const int sub = i & 7, b = sub >> 1;
        if ((sub & 1) == 0) { u.A = H + (size_t)pm * 256 * 2048; u.lda2 = 2048; u.B = WIN + (size_t)(4608 + b * 1024 + pn * 256) * 2048; u.ldb2 = 2048; u.nt = 16; }
        else { if (b == 0) { u.A = MA + (size_t)pm * 256 * 1024; u.lda2 = 1024; } else { u.A = M3 + (size_t)(b - 1) * 1024 + (size_t)pm * 256 * 3072; u.lda2 = 3072; }
               u.B = WBR + (size_t)b * (1024 * 512 * 2) + (size_t)pn * 256 * 1024; u.ldb2 = 1024; u.nt = 8; }
        u.pm = pm; u.pn = pn; u.aux = sub; return true;
    }
};

template <class Epi, class Sched>
__device__ __forceinline__ void gemm_phase(LAS unsigned char* lds, const Sched& S, const Epi& E, const int wv) {
    const int tid = tid_(wv), wid = __builtin_amdgcn_readfirstlane(tid >> 6), lane = tid & 63, wr = wid >> 2, wc = wid & 3, fr = lane & 15, fq = lane >> 4;
    const size_t kstep = (size_t)(BK * 2);
    const unsigned ldsw = (unsigned)wid * 1024u;
    const int aoff = lds_byte(wr * 64 + fr, fq * 8), boff = lds_byte(wc * 32 + fr, fq * 8);
#define PG_SA(b, h) (((b) * 2 + (h)) * HTB)
#define PG_SB(b, h) ((4 + (b) * 2 + (h)) * HTB)
#define PG_STAGE(bufoff, gbase, voff, ld2) do { \
        __builtin_amdgcn_global_load_lds((const unsigned*)((const char*)(gbase) + (voff)), (LAS unsigned*)(lds + (bufoff) + ldsw), 16, 0, 0); \
        __builtin_amdgcn_global_load_lds((const unsigned*)((const char*)(gbase) + (size_t)64 * (ld2) + (voff)), (LAS unsigned*)(lds + (bufoff) + ldsw + 8192), 16, 0, 0); } while (0)
#define PG_LDA(dst, b, h) do { _Pragma("unroll") for (int m = 0; m < 4; ++m) _Pragma("unroll") for (int k = 0; k < 2; ++k) dst[m][k] = *(const LAS bf16x8*)(lds + PG_SA(b, h) + aoff + m * 2048 + k * 1024); } while (0)
#define PG_LDB(dst, b, h) do { _Pragma("unroll") for (int n = 0; n < 2; ++n) _Pragma("unroll") for (int k = 0; k < 2; ++k) dst[n][k] = *(const LAS bf16x8*)(lds + PG_SB(b, h) + boff + n * 2048 + k * 1024); } while (0)
#define PG_MMA(ai, bj, At, Bt) do { __builtin_amdgcn_s_setprio(1); _Pragma("unroll") for (int m = 0; m < 4; ++m) _Pragma("unroll") for (int n = 0; n < 2; ++n) _Pragma("unroll") for (int k = 0; k < 2; ++k) \
        acc[ai][bj][m][n] = __builtin_amdgcn_mfma_f32_16x16x32_bf16(Bt[n][k], At[m][k], acc[ai][bj][m][n], 0, 0, 0); __builtin_amdgcn_s_setprio(0); } while (0)
#define PG_WAIT_V(n) asm volatile("s_waitcnt vmcnt(" #n ")" ::: "memory")
#define PG_WAIT_L(n) asm volatile("s_waitcnt lgkmcnt(" #n ")" ::: "memory")
#define PG_BAR __builtin_amdgcn_s_barrier()
#define PG_SCHED __builtin_amdgcn_sched_barrier(0)
#define PG_BODY(a1, vA1, la1, a2, b2, vA2, vB2, la2, lb2) do { \
            const size_t hA1 = (size_t)128 * (la1), hA2 = (size_t)128 * (la2), hB2 = (size_t)128 * (lb2); \
            const char* a3 = (a2) + kstep; const char* b3 = (b2) + kstep; \
            PG_LDB(B0, 0, 0); PG_LDB(B1, 0, 1); PG_SCHED; PG_LDA(At, 0, 0); PG_STAGE(PG_SA(1, 1), (a1) + hA1, vA1, la1); \
            PG_WAIT_V(8); PG_WAIT_L(0); PG_BAR; PG_MMA(0, 0, At, B0); PG_MMA(0, 1, At, B1); PG_BAR; PG_SCHED; \
            PG_LDA(At, 0, 1); PG_STAGE(PG_SB(0, 0), (b2), vB2, lb2); PG_STAGE(PG_SB(0, 1), (b2) + hB2, vB2, lb2); PG_STAGE(PG_SA(0, 0), (a2), vA2, la2); \
            PG_WAIT_V(8); PG_WAIT_L(0); PG_BAR; PG_MMA(1, 0, At, B0); PG_MMA(1, 1, At, B1); PG_BAR; PG_SCHED; \
            PG_LDB(B0, 1, 0); PG_LDB(B1, 1, 1); PG_SCHED; PG_LDA(At, 1, 0); PG_STAGE(PG_SA(0, 1), (a2) + hA2, vA2, la2); \
            PG_WAIT_V(8); PG_WAIT_L(0); PG_BAR; PG_MMA(0, 0, At, B0); PG_MMA(0, 1, At, B1); PG_BAR; PG_SCHED; \
            PG_LDA(At, 1, 1); PG_STAGE(PG_SB(1, 0), b3, vB2, lb2); PG_STAGE(PG_SB(1, 1), b3 + hB2, vB2, lb2); PG_STAGE(PG_SA(1, 0), a3, vA2, la2); \
            PG_WAIT_V(8); PG_WAIT_L(0); PG_BAR; PG_MMA(1, 0, At, B0); PG_MMA(1, 1, At, B1); PG_BAR; PG_SCHED; } while (0)
    GUnit cur, nxt; int ui = 0;
    if (!S.next(0, cur)) return;
    f32x4 acc[2][2][4][2];
#pragma unroll
    for (int a = 0; a < 2; ++a)
#pragma unroll
        for (int b = 0; b < 2; ++b)
#pragma unroll
            for (int m = 0; m < 4; ++m)
#pragma unroll
                for (int n = 0; n < 2; ++n) acc[a][b][m][n] = (f32x4){0.f, 0.f, 0.f, 0.f};
    bf16x8 At[4][2], B0[2][2], B1[2][2];
    unsigned vAc, vBc;
    { int R0, C0; stage_rc(tid * 16, R0, C0); const int Rb0 = (R0 & ~31) + perm32(R0 & 31); vAc = (unsigned)R0 * cur.lda2 + (unsigned)C0 * 2u; vBc = (unsigned)Rb0 * cur.ldb2 + (unsigned)C0 * 2u; }
    {
        const char* cA = cur.A; const char* cB = cur.B; const size_t hA = (size_t)128 * cur.lda2, hB = (size_t)128 * cur.ldb2;
        PG_STAGE(PG_SB(0, 0), cB, vBc, cur.ldb2); PG_STAGE(PG_SB(0, 1), cB + hB, vBc, cur.ldb2); PG_STAGE(PG_SA(0, 0), cA, vAc, cur.lda2); PG_STAGE(PG_SA(0, 1), cA + hA, vAc, cur.lda2);
        if (wr == 1) PG_BAR;
        PG_WAIT_V(2); PG_BAR;
        PG_STAGE(PG_SB(1, 0), cB + kstep, vBc, cur.ldb2); PG_STAGE(PG_SA(1, 0), cA + kstep, vAc, cur.lda2); PG_STAGE(PG_SB(1, 1), cB + hB + kstep, vBc, cur.ldb2);
        PG_WAIT_V(6); PG_BAR;
    }
    for (;;) {
        const bool has_next = S.next(ui + 1, nxt);
        if (!has_next) nxt = cur;
        const int nt = cur.nt;
        const char* cA = cur.A; const char* cB = cur.B;
        for (int t = 0; t < nt - 2; t += 2)
            PG_BODY(cA + (size_t)(t + 1) * kstep, vAc, cur.lda2, cA + (size_t)(t + 2) * kstep, cB + (size_t)(t + 2) * kstep, vAc, vBc, cur.lda2, cur.ldb2);
        unsigned vAn, vBn;
        { int t2 = tid; asm volatile("" : "+v"(t2)); int R0, C0; stage_rc(t2 * 16, R0, C0); const int Rb0 = (R0 & ~31) + perm32(R0 & 31);
          vAn = (unsigned)R0 * nxt.lda2 + (unsigned)C0 * 2u; vBn = (unsigned)Rb0 * nxt.ldb2 + (unsigned)C0 * 2u; }
        PG_BODY(cA + (size_t)(nt - 1) * kstep, vAc, cur.lda2, nxt.A, nxt.B, vAn, vBn, nxt.lda2, nxt.ldb2);
        if (wr == 0) PG_BAR;
        E(acc, cur, wr, wc, fr, fq);
        if (!has_next) break;
#pragma unroll
        for (int a = 0; a < 2; ++a)
#pragma unroll
            for (int b = 0; b < 2; ++b)
#pragma unroll
                for (int m = 0; m < 4; ++m)
#pragma unroll
                    for (int n = 0; n < 2; ++n) acc[a][b][m][n] = (f32x4){0.f, 0.f, 0.f, 0.f};
        cur = nxt; vAc = vAn; vBc = vBn; ++ui;
        if (wr == 1) PG_BAR;
    }
    PG_WAIT_V(0);
    PG_BAR;
#undef PG_SA
#undef PG_SB
#undef PG_STAGE
#undef PG_LDA
#undef PG_LDB
#undef PG_MMA
#undef PG_WAIT_V
#undef PG_WAIT_L
#undef PG_BAR
#undef PG_SCHED
#undef PG_BODY
}

#define EPI_LOOP(...) \
    _Pragma("unroll") for (int ai = 0; ai < 2; ++ai) _Pragma("unroll") for (int m = 0; m < 4; ++m) _Pragma("unroll") for (int bj = 0; bj < 2; ++bj) { \
        const int row = u.pm * 256 + ai * 128 + wr * 64 + m * 16 + fr; const int tcol = bj * 128 + wc * 32 + 8 * fq; \
        const f32x4 v0 = acc[ai][bj][m][0], v1 = acc[ai][bj][m][1]; float v[8] = {v0[0], v0[1], v0[2], v0[3], v1[0], v1[1], v1[2], v1[3]}; __VA_ARGS__ }

struct EpiIn {
    bf16_t *prw, *ppool, *pconv, *patt;
    __device__ __forceinline__ void operator()(const f32x4 (&acc)[2][2][4][2], const GUnit& u, int wr, int wc, int fr, int fq) const {
        asm volatile("" : "+v"(fr), "+v"(fq));
        bf16_t* base; int ld, ct;
        if (u.pn < 7) { base = prw; ld = 1792; ct = u.pn; } else if (u.pn < 9) { base = ppool; ld = 512; ct = u.pn - 7; }
        else if (u.pn < 15) { base = pconv; ld = 1536; ct = u.pn - 9; } else { base = patt; ld = 768; ct = u.pn - 15; }
        EPI_LOOP({ *(u32x4*)(base + (size_t)row * ld + ct * 256 + tcol) = pack8(v); })
    }
};
struct EpiLora {
    bf16_t* out; const float* w0; const float* a0;
    __device__ __forceinline__ void operator()(const f32x4 (&acc)[2][2][4][2], const GUnit& u, int wr, int wc, int fr, int fq) const {
        asm volatile("" : "+v"(fr), "+v"(fq));
        const float* bias = u.pn < 2 ? w0 + u.pn * 256 : a0 + (u.pn - 2) * 256;
        const bool sg = u.pn < 4;
        float bv0[8], bv1[8];
        if (sg) { ld8f(bias + wc * 32 + 8 * fq, bv0); ld8f(bias + 128 + wc * 32 + 8 * fq, bv1); }
        EPI_LOOP({ if (sg) { _Pragma("unroll") for (int j = 0; j < 8; ++j) v[j] = sigmoidf_(v[j] + (bj ? bv1[j] : bv0[j])); }
                   *(u32x4*)(out + (size_t)row * 1536 + u.pn * 256 + tcol) = pack8(v); })
    }
};
struct EpiBR {
    u32x4* scr; bf16_t* mixed;
    __device__ __forceinline__ void operator()(const f32x4 (&acc)[2][2][4][2], const GUnit& u, int wr, int wc, int fr, int fq) const {
        asm volatile("" : "+v"(fr), "+v"(fq));
        const bool gate = (u.aux & 1) == 0; const bool first = (u.aux >> 1) == 0;
        const int tix = (wr * 4 + wc) * 64 + fq * 16 + fr;
        if (gate) {
            EPI_LOOP({ _Pragma("unroll") for (int j = 0; j < 8; ++j) v[j] = sigmoidf_(v[j]); scr[((ai * 4 + m) * 2 + bj) * 512 + tix] = pack8(v); })
        } else {
#pragma unroll
            for (int aq = 0; aq < 4; ++aq) {
                const int ai = aq >> 1, m0 = (aq & 1) * 2;
                u32x4 gq[4][2], oq[4][2];
#pragma unroll
                for (int m = m0; m < m0 + 2; ++m)
#pragma unroll
                    for (int bj = 0; bj < 2; ++bj) {
                        gq[m][bj] = scr[((ai * 4 + m) * 2 + bj) * 512 + tix];
                        const int row = u.pm * 256 + ai * 128 + wr * 64 + m * 16 + fr; const int tcol = bj * 128 + wc * 32 + 8 * fq;
                        if (!first) oq[m][bj] = *(const u32x4*)(mixed + (size_t)row * 1024 + u.pn * 256 + tcol);
                    }
#pragma unroll
                for (int m = m0; m < m0 + 2; ++m)
#pragma unroll
                    for (int bj = 0; bj < 2; ++bj) {
                        const int row = u.pm * 256 + ai * 128 + wr * 64 + m * 16 + fr; const int tcol = bj * 128 + wc * 32 + 8 * fq;
                        const f32x4 v0 = acc[ai][bj][m][0], v1 = acc[ai][bj][m][1]; float v[8] = {v0[0], v0[1], v0[2], v0[3], v1[0], v1[1], v1[2], v1[3]};
                        float g[8]; unpack8(gq[m][bj], g);
#pragma unroll
                        for (int j = 0; j < 8; ++j) v[j] *= g[j];
                        if (!first) { float o[8]; unpack8(oq[m][bj], o); _Pragma("unroll") for (int j = 0; j < 8; ++j) v[j] += o[j]; }
                        *(u32x4*)(mixed + (size_t)row * 1024 + u.pn * 256 + tcol) = pack8(v);
                    }
            }
        }
    }
};
struct EpiRes {
    const float* base; float* out;
    __device__ __forceinline__ void operator()(const f32x4 (&acc)[2][2][4][2], const GUnit& u, int wr, int wc, int fr, int fq) const {
        asm volatile("" : "+v"(fr), "+v"(fq));
#pragma unroll
        for (int aq = 0; aq < 4; ++aq) {
            const int ai = aq >> 1, m0 = (aq & 1) * 2;
            f32x4 b0[4][2], b1[4][2];
#pragma unroll
            for (int m = m0; m < m0 + 2; ++m)
#pragma unroll
                for (int bj = 0; bj < 2; ++bj) {
                    const size_t off = (size_t)(u.pm * 256 + ai * 128 + wr * 64 + m * 16 + fr) * 1024 + u.pn * 256 + bj * 128 + wc * 32 + 8 * fq;
                    b0[m][bj] = *(const f32x4*)(base + off); b1[m][bj] = *(const f32x4*)(base + off + 4);
                }
#pragma unroll
            for (int m = m0; m < m0 + 2; ++m)
#pragma unroll
                for (int bj = 0; bj < 2; ++bj) {
                    const size_t off = (size_t)(u.pm * 256 + ai * 128 + wr * 64 + m * 16 + fr) * 1024 + u.pn * 256 + bj * 128 + wc * 32 + 8 * fq;
                    *(f32x4*)(out + off) = b0[m][bj] + acc[ai][bj][m][0]; *(f32x4*)(out + off + 4) = b1[m][bj] + acc[ai][bj][m][1];
                }
        }
    }
};
struct EpiGU {
    bf16_t* act;
    __device__ __forceinline__ void operator()(const f32x4 (&acc)[2][2][4][2], const GUnit& u, int wr, int wc, int fr, int fq) const {
        asm volatile("" : "+v"(fr), "+v"(fq));
#pragma unroll
        for (int ai = 0; ai < 2; ++ai)
#pragma unroll
            for (int m = 0; m < 4; ++m) {
                const int row = u.pm * 256 + ai * 128 + wr * 64 + m * 16 + fr; const int col = u.pn * 128 + wc * 32 + 8 * fq;
                const f32x4 g0 = acc[ai][0][m][0], g1 = acc[ai][0][m][1], u0 = acc[ai][1][m][0], u1 = acc[ai][1][m][1];
                float v[8];
#pragma unroll
                for (int j = 0; j < 4; ++j) { v[j] = g0[j] * sigmoidf_(g0[j]) * u0[j]; v[4 + j] = g1[j] * sigmoidf_(g1[j]) * u1[j]; }
                *(u32x4*)(act + (size_t)row * DFF + col) = pack8(v);
            }
    }
};
}

__device__ __forceinline__ float wave_sum(float v) {
#pragma unroll
    for (int o = 1; o < 64; o <<= 1) v += __shfl_xor(v, o);
    return v;
}
__device__ __forceinline__ void transpose_item(const float* W, int ldw, int k0, int n0, bf16_t* WT, int drow0, int ldd, int dk0, LAS float* scr, int lane) {
#pragma unroll 8
    for (int i = 0; i < 32; ++i) { const int kk = 2 * i + (lane >> 5); scr[kk * 33 + (lane & 31)] = W[(size_t)(k0 + kk) * ldw + n0 + (lane & 31)]; }
    asm volatile("s_waitcnt lgkmcnt(0)" ::: "memory");
    const int c = lane & 7;
#pragma unroll
    for (int j = 0; j < 4; ++j) { const int n = (lane >> 3) + 8 * j; const LAS float* s = scr + (8 * c) * 33 + n;
        u32x4 o; o.x = cvt_pk_bf16(s[0 * 33], s[1 * 33]); o.y = cvt_pk_bf16(s[2 * 33], s[3 * 33]); o.z = cvt_pk_bf16(s[4 * 33], s[5 * 33]); o.w = cvt_pk_bf16(s[6 * 33], s[7 * 33]);
        *(u32x4*)(WT + (size_t)(drow0 + n) * ldd + dk0 + k0 + 8 * c) = o; }
    asm volatile("s_waitcnt lgkmcnt(0)" ::: "memory");
}

__device__ __forceinline__ void prologue_phase(const Params& p, LAS unsigned char* lds, const int wv) {
    const int tid = tid_(wv), lane = tid & 63, wave = __builtin_amdgcn_readfirstlane(tid >> 6);
    const int G = gridDim.x; const int gw = bid_() * 8 + wave, NGW = G * 8;
    LAS float* scr = (LAS float*)(lds + wave * 8448);
    bf16_t* Wb = (bf16_t*)(KWS + WS_W);
    constexpr int PER_LAYER = 4352 + 16 + 16 + 32 + 256 * 3 + 512 + 1408 * 3;
    for (int it = gw; it < NL * PER_LAYER; it += NGW) {
        const int l = it / PER_LAYER; int r = it % PER_LAYER;
        bf16_t* wl = Wb + (size_t)l * LW_ELEMS;
        const float* src; int K, N, ldd, dk0 = 0, mode = 0; bf16_t* dst; int rowoff = 0;
        if (r < 4352) { src = (const float*)karg(3) + (size_t)l * 1024 * INC; K = 1024; N = INC; dst = wl + OW_IN; ldd = 1024; }
        else if ((r -= 4352) < 16) { src = (const float*)karg(5) + (size_t)l * 64 * 512; K = 64; N = 512; dst = wl + OW_LORA; ldd = 256; }
        else if ((r -= 16) < 16) { src = (const float*)karg(7) + (size_t)l * 64 * 512; K = 64; N = 512; dst = wl + OW_LORA; ldd = 256; rowoff = 512; dk0 = 64; }
        else if ((r -= 16) < 32) { src = (const float*)karg(9) + (size_t)l * 128 * 512; K = 128; N = 512; dst = wl + OW_LORA; ldd = 256; rowoff = 1024; dk0 = 128; }
        else if ((r -= 32) < 256) { src = (const float*)karg(15) + (size_t)l * 512 * 1024; K = 512; N = 1024; dst = wl + OW_BR; ldd = 512; }
        else if ((r -= 256) < 256) { src = (const float*)karg(20) + (size_t)l * 512 * 1024; K = 512; N = 1024; dst = wl + OW_BR + 2 * 524288; ldd = 512; }
        else if ((r -= 256) < 256) { src = (const float*)karg(24) + (size_t)l * 512 * 1024; K = 512; N = 1024; dst = wl + OW_BR + 3 * 524288; ldd = 512; }
        else if ((r -= 256) < 512) { src = (const float*)karg(25) + (size_t)l * 1024 * 1024; K = 1024; N = 1024; dst = wl + OW_O; ldd = 1024; }
        else if ((r -= 512) < 1408) { src = (const float*)karg(27) + (size_t)l * 1024 * DFF; K = 1024; N = DFF; dst = wl + OW_GU; ldd = 1024; mode = 1; }
        else if ((r -= 1408) < 1408) { src = (const float*)karg(28) + (size_t)l * 1024 * DFF; K = 1024; N = DFF; dst = wl + OW_GU; ldd = 1024; mode = 2; }
        else { r -= 1408; src = (const float*)karg(29) + (size_t)l * DFF * 1024; K = DFF; N = 1024; dst = wl + OW_D; ldd = DFF; }
        const int nblk = N / 32, kb = r / nblk, nb = r % nblk, n0 = nb * 32;
        int drow0 = rowoff + n0;
        if (mode) drow0 = (n0 >> 7) * 256 + (n0 & 127) + (mode == 2 ? 128 : 0);
        transpose_item(src, N, kb * 64, n0, dst, drow0, ldd, dk0, scr, lane);
    }
    const int gt = bid_() * NTHR + tid, NGT = G * NTHR;
    for (int idx = gt; idx < NL * 1536 * 32; idx += NGT) {
        const int l = idx / (1536 * 32), r = idx % (1536 * 32), row = r >> 5, kc = (r & 31) * 8;
        const bool diag = row < 512 ? (kc < 64) : row < 1024 ? (kc >= 64 && kc < 128) : (kc >= 128);
        if (!diag) *(u32x4*)(Wb + (size_t)l * LW_ELEMS + OW_LORA + (size_t)row * 256 + kc) = (u32x4){0u, 0u, 0u, 0u};
    }
    for (int idx = gt; idx < NL * 1024 * 64; idx += NGT) {
        const int l = idx >> 16, r = idx & 65535, n = r & 1023, k0 = (r >> 10) * 8, g = k0 >> 7;
        const float* pw = (const float*)karg(16) + (size_t)l * 65536 + (size_t)g * 16384 + (size_t)(k0 & 127) * 128;
        const float* sc = (const float*)karg(17) + l * 512 + g * 128;
        const float* wo = (const float*)karg(18) + (size_t)l * 512 * 1024 + (size_t)g * 128 * 1024 + n;
        float a[8] = {0.f, 0.f, 0.f, 0.f, 0.f, 0.f, 0.f, 0.f};
        for (int j = 0; j < 128; ++j) { const float w = sc[j] * wo[(size_t)j * 1024];
#pragma unroll
            for (int i = 0; i < 8; ++i) a[i] += pw[i * 128 + j] * w; }
        *(u32x4*)(Wb + (size_t)l * LW_ELEMS + OW_BR + 524288 + (size_t)n * 512 + k0) = pack8(a);
    }
    _Float16* rope = (_Float16*)(KWS + WS_ROPE);
    const int* pos = (const int*)karg(1);
    for (int idx = gt; idx < MTOK * 32; idx += NGT) {
        const int m = idx >> 5, i = idx & 31;
        const float inv = powf(10000.0f, -(float)i * 2.0f / 64.0f);
        const float ang = (float)pos[m] * inv;
        rope[(size_t)m * 64 + i] = (_Float16)cosf(ang); rope[(size_t)m * 64 + 32 + i] = (_Float16)sinf(ang);
    }
}

__device__ __forceinline__ void norm_phase(const float* x, const float* g, bf16_t* out, const int wv) {
    const int tid = tid_(wv), lane = tid & 63, wave = tid >> 6;
    f32x4 gv[4];
#pragma unroll
    for (int j = 0; j < 4; ++j) gv[j] = *((const f32x4*)g + lane + 64 * j);
    for (int m = bid_() * 8 + wave; m < MTOK; m += gridDim.x * 8) {
        const f32x4* xr = (const f32x4*)(x + (size_t)m * DM) + lane;
        f32x4 v[4]; float s = 0.f;
#pragma unroll
        for (int j = 0; j < 4; ++j) { v[j] = xr[64 * j]; s += (v[j].x * v[j].x + v[j].y * v[j].y) + (v[j].z * v[j].z + v[j].w * v[j].w); }
        const float rstd = 1.0f / sqrtf(wave_sum(s) * (1.0f / DM) + 1e-6f);
        u32x2* o = (u32x2*)(out + (size_t)m * DM) + lane;
#pragma unroll
        for (int j = 0; j < 4; ++j) { u32x2 w; w.x = cvt_pk_bf16(v[j].x * rstd * gv[j].x, v[j].y * rstd * gv[j].y); w.y = cvt_pk_bf16(v[j].z * rstd * gv[j].z, v[j].w * rstd * gv[j].w); o[64 * j] = w; }
    }
}

__device__ __forceinline__ u32x4 qk_prep(const u32x4 raw, const float* g, const _Float16* rp, int c, float scale) {
    float x[8]; unpack8(raw, x);
    float ss = 0.f;
#pragma unroll
    for (int j = 0; j < 8; ++j) ss += x[j] * x[j];
    ss = dpp_sum8(ss);
    const float rstd = 1.0f / sqrtf(ss * (1.0f / 64.0f) + 1e-6f);
    float gg[8]; ld8f(g + c * 8, gg);
    const int ci = (c & 3) * 8;
    float o[8];
#pragma unroll
    for (int j = 0; j < 8; ++j) {
        const float y = x[j] * rstd * gg[j];
        const float pr = __shfl_xor(y, 4);
        const float cs = (float)rp[ci + j], sn = (float)rp[32 + ci + j];
        o[j] = (c < 4 ? y * cs - pr * sn : y * cs + pr * sn) * scale;
    }
    return pack8(o);
}

__device__ __forceinline__ void attn_item(const Params& p, int l, int item, LAS unsigned char* lds, const int wv) {
    const int tid = tid_(wv), lane = tid & 63, wave = __builtin_amdgcn_readfirstlane(tid >> 6), fr = lane & 15, fq = lane >> 4;
    const int b = item >> 6, kvh = (item >> 5) & 1, nbk = item & 31;
    const int tok0 = b * SEQ + nbk * 128;
    const bf16_t* PATT = (const bf16_t*)(KWS + WS_PATT);
    bf16_t* M3 = (bf16_t*)(KWS + WS_M3);
    const _Float16* rope = (const _Float16*)(KWS + WS_ROPE);
    const float* qg = (const float*)karg(21) + l * 64; const float* kg = (const float*)karg(22) + l * 64;
    LAS bf16_t* Ks = (LAS bf16_t*)lds;
    LAS bf16_t* Vt = (LAS bf16_t*)(lds + 36864);
    LAS bf16_t* Qs = (LAS bf16_t*)(lds + 70656);
    const int c = tid & 7;
#pragma unroll 1
    for (int pass = 0; pass < 4; ++pass) {
        const int row = pass * 64 + (tid >> 3); const int tokk = tok0 - 128 + row; const bool valid = (nbk > 0) || (row >= 128);
        u32x4 kraw = (u32x4){0u, 0u, 0u, 0u}, vraw = kraw;
        const int tk = valid ? tokk : tok0;
        if (valid) { kraw = ld16(PATT + (size_t)tokk * 768 + 512 + kvh * 64 + c * 8); vraw = ld16(PATT + (size_t)tokk * 768 + 640 + kvh * 64 + c * 8); }
        const u32x4 kp = qk_prep(kraw, kg, rope + (size_t)tk * 64, c, 1.0f);
        *(LAS u32x4*)(Ks + row * 72 + c * 8) = kp;
        LAS bf16_t* vp = Vt + (c * 8) * 264 + row;
        vp[0 * 264] = (bf16_t)(vraw.x & 0xffffu); vp[1 * 264] = (bf16_t)(vraw.x >> 16); vp[2 * 264] = (bf16_t)(vraw.y & 0xffffu); vp[3 * 264] = (bf16_t)(vraw.y >> 16);
        vp[4 * 264] = (bf16_t)(vraw.z & 0xffffu); vp[5 * 264] = (bf16_t)(vraw.z >> 16); vp[6 * 264] = (bf16_t)(vraw.w & 0xffffu); vp[7 * 264] = (bf16_t)(vraw.w >> 16);
    }
#pragma unroll 1
    for (int pass = 0; pass < 8; ++pass) {
        const int row = pass * 64 + (tid >> 3); const int g = row >> 7, ql = row & 127; const int tokq = tok0 + ql; const int hq = kvh * 4 + g;
        const u32x4 qraw = ld16(PATT + (size_t)tokq * 768 + hq * 64 + c * 8);
        *(LAS u32x4*)(Qs + row * 72 + c * 8) = qk_prep(qraw, qg, rope + (size_t)tokq * 64, c, 0.125f);
    }
    __syncthreads();
    const int g = wave >> 1; const int hq = kvh * 4 + g;
    const float sink = ((const float*)karg(23))[l * 8 + hq];
#pragma unroll 1
    for (int pp = 0; pp < 2; ++pp) {
        const int ql0 = (wave & 1) * 64 + pp * 32;
        f32x4 sacc[10][2];
#pragma unroll
        for (int n = 0; n < 10; ++n) { sacc[n][0] = (f32x4){0.f, 0.f, 0.f, 0.f}; sacc[n][1] = sacc[n][0]; }
#pragma unroll
        for (int kk2 = 0; kk2 < 2; ++kk2) {
            const bf16x8 q0 = *(const LAS bf16x8*)(Qs + (g * 128 + ql0 + fr) * 72 + 32 * kk2 + 8 * fq);
            const bf16x8 q1 = *(const LAS bf16x8*)(Qs + (g * 128 + ql0 + 16 + fr) * 72 + 32 * kk2 + 8 * fq);
#pragma unroll
            for (int n = 0; n < 10; ++n) {
                const bf16x8 kf = *(const LAS bf16x8*)(Ks + (ql0 + 16 * n + fr) * 72 + 32 * kk2 + 8 * fq);
                sacc[n][0] = __builtin_amdgcn_mfma_f32_16x16x32_bf16(kf, q0, sacc[n][0], 0, 0, 0);
                sacc[n][1] = __builtin_amdgcn_mfma_f32_16x16x32_bf16(kf, q1, sacc[n][1], 0, 0, 0);
            }
        }
        u32x2 pb[10][2];
#pragma unroll
        for (int mq = 0; mq < 2; ++mq) {
            const int qi = 128 + ql0 + 16 * mq + fr;
            float mx = -__builtin_inff();
#pragma unroll
            for (int n = 0; n < 10; ++n)
#pragma unroll
                for (int j = 0; j < 4; ++j) {
                    const int kj = ql0 + 16 * n + 4 * fq + j; const int dist = qi - kj;
                    const bool ok = (dist >= 0) && (dist < 128) && ((nbk > 0) || (kj >= 128));
                    const float s = ok ? sacc[n][mq][j] : -__builtin_inff();
                    sacc[n][mq][j] = s; mx = fmaxf(mx, s);
                }
            mx = fmaxf(mx, __shfl_xor(mx, 16)); mx = fmaxf(mx, __shfl_xor(mx, 32));
            const float mf = fmaxf(mx, sink);
            float sum = 0.f;
#pragma unroll
            for (int n = 0; n < 10; ++n)
#pragma unroll
                for (int j = 0; j < 4; ++j) { const float e = __expf(sacc[n][mq][j] - mf); sacc[n][mq][j] = e; sum += e; }
            sum += __shfl_xor(sum, 16); sum += __shfl_xor(sum, 32);
            const float inv = 1.0f / (sum + __expf(sink - mf));
#pragma unroll
            for (int n = 0; n < 10; ++n) { pb[n][mq].x = cvt_pk_bf16(sacc[n][mq][0] * inv, sacc[n][mq][1] * inv); pb[n][mq].y = cvt_pk_bf16(sacc[n][mq][2] * inv, sacc[n][mq][3] * inv); }
        }
        f32x4 oacc[4][2];
#pragma unroll
        for (int dt = 0; dt < 4; ++dt) { oacc[dt][0] = (f32x4){0.f, 0.f, 0.f, 0.f}; oacc[dt][1] = oacc[dt][0]; }
#pragma unroll
        for (int kc = 0; kc < 5; ++kc) {
            const u32x4 p0 = (u32x4){pb[2 * kc][0].x, pb[2 * kc][0].y, pb[2 * kc + 1][0].x, pb[2 * kc + 1][0].y};
            const u32x4 p1 = (u32x4){pb[2 * kc][1].x, pb[2 * kc][1].y, pb[2 * kc + 1][1].x, pb[2 * kc + 1][1].y};
#pragma unroll
            for (int dt = 0; dt < 4; ++dt) {
                const LAS bf16_t* vrow = Vt + (16 * dt + fr) * 264 + ql0 + 32 * kc + 4 * fq;
                const u32x2 va = *(const LAS u32x2*)vrow, vb = *(const LAS u32x2*)(vrow + 16);
                const u32x4 vv = (u32x4){va.x, va.y, vb.x, vb.y};
                oacc[dt][0] = __builtin_amdgcn_mfma_f32_16x16x32_bf16(__builtin_bit_cast(bf16x8, vv), __builtin_bit_cast(bf16x8, p0), oacc[dt][0], 0, 0, 0);
                oacc[dt][1] = __builtin_amdgcn_mfma_f32_16x16x32_bf16(__builtin_bit_cast(bf16x8, vv), __builtin_bit_cast(bf16x8, p1), oacc[dt][1], 0, 0, 0);
            }
        }
#pragma unroll
        for (int mq = 0; mq < 2; ++mq)
#pragma unroll
            for (int dt = 0; dt < 4; ++dt) {
                const int ql = ql0 + 16 * mq + fr;
                u32x2 w; w.x = cvt_pk_bf16(oacc[dt][mq][0], oacc[dt][mq][1]); w.y = cvt_pk_bf16(oacc[dt][mq][2], oacc[dt][mq][3]);
                *(u32x2*)(M3 + (size_t)(tok0 + ql) * 1536 + 1024 + hq * 64 + 16 * dt + 4 * fq) = w;
            }
    }
    __syncthreads();
}

__device__ __forceinline__ void mix1_phase(const Params& p, int l, LAS unsigned char* lds, const int wv) {
    const int tid = tid_(wv), G = gridDim.x;
    for (int item = bid_(); item < 1024; item += G) attn_item(p, l, item, lds, wv);
    const int gt = bid_() * NTHR + tid, NGT = G * NTHR;
    const bf16_t* PRW = (const bf16_t*)(KWS + WS_PRW); const bf16_t* PPOOL = (const bf16_t*)(KWS + WS_PPOOL); const bf16_t* PCONV = (const bf16_t*)(KWS + WS_PCONV);
    bf16_t* M3 = (bf16_t*)(KWS + WS_M3); bf16_t* AL = (bf16_t*)(KWS + WS_ALORA);
    const float* mu = (const float*)karg(4) + l * RWC;
    for (int idx = gt; idx < MTOK * 32; idx += NGT) {
        const int m = idx >> 5, c8 = (idx & 31) * 8, t = m & (SEQ - 1);
        float cur[8], prv[8], mm[8], o[8];
        unpack8(ld16(PRW + (size_t)m * RWC + 1536 + c8), cur);
        if (t > 0) unpack8(ld16(PRW + (size_t)(m - 1) * RWC + 1536 + c8), prv); else { _Pragma("unroll") for (int j = 0; j < 8; ++j) prv[j] = 0.f; }
        ld8f(mu + 1536 + c8, mm);
#pragma unroll
        for (int j = 0; j < 8; ++j) { const float s = cur[j] + (prv[j] - cur[j]) * mm[j];
            o[j] = c8 < 64 ? (1.0f - 2.0f / (__expf(2.0f * s) + 1.0f)) : (c8 < 128 ? s : sigmoidf_(s)); }
        *(u32x4*)(AL + (size_t)m * 256 + c8) = pack8(o);
    }
    const float* cw = (const float*)karg(19) + l * 3 * 512;
    for (int idx = gt; idx < MTOK * 64; idx += NGT) {
        const int m = idx >> 6, c8 = (idx & 63) * 8, t = m & (SEQ - 1);
        float bg[8], a[8] = {0.f, 0.f, 0.f, 0.f, 0.f, 0.f, 0.f, 0.f};
        unpack8(ld16(PCONV + (size_t)m * 1536 + c8), bg);
#pragma unroll
        for (int k = 0; k < 3; ++k) {
            if (t - 2 + k >= 0) { float cc[8], uu[8], ww[8];
                unpack8(ld16(PCONV + (size_t)(m - 2 + k) * 1536 + 512 + c8), cc); unpack8(ld16(PCONV + (size_t)(m - 2 + k) * 1536 + 1024 + c8), uu); ld8f(cw + k * 512 + c8, ww);
#pragma unroll
                for (int j = 0; j < 8; ++j) a[j] += ww[j] * (cc[j] * uu[j]); }
        }
#pragma unroll
        for (int j = 0; j < 8; ++j) a[j] *= bg[j];
        *(u32x4*)(M3 + (size_t)m * 1536 + 512 + c8) = pack8(a);
    }
    for (int idx = gt; idx < MTOK * 64; idx += NGT) {
        const int m = idx >> 6, c8 = (idx & 63) * 8, t = m & (SEQ - 1);
        const int win = 2 << (c8 >> 7);
        float u0[8], s[8];
        unpack8(ld16(PPOOL + (size_t)m * 512 + c8), u0);
#pragma unroll
        for (int j = 0; j < 8; ++j) s[j] = u0[j];
        for (int d = 1; d < win; ++d) { if (t - d >= 0) { float uu[8]; unpack8(ld16(PPOOL + (size_t)(m - d) * 512 + c8), uu);
#pragma unroll
                for (int j = 0; j < 8; ++j) s[j] += uu[j]; } }
        const float ic = 1.0f / (float)(t + 1 < win ? t + 1 : win);
#pragma unroll
        for (int j = 0; j < 8; ++j) s[j] = s[j] * ic - u0[j];
        *(u32x4*)(M3 + (size_t)m * 1536 + c8) = pack8(s);
    }
}

constexpr int TC = 32, NCH = SEQ / TC, SROW = 352;
__device__ __forceinline__ float dpp_sum16(float v) {
    v += __builtin_bit_cast(float, __builtin_amdgcn_mov_dpp(__builtin_bit_cast(int, v), 0xB1, 0xF, 0xF, true));
    v += __builtin_bit_cast(float, __builtin_amdgcn_mov_dpp(__builtin_bit_cast(int, v), 0x4E, 0xF, 0xF, true));
    v += __builtin_bit_cast(float, __builtin_amdgcn_mov_dpp(__builtin_bit_cast(int, v), 0x141, 0xF, 0xF, true));
    v += __builtin_bit_cast(float, __builtin_amdgcn_mov_dpp(__builtin_bit_cast(int, v), 0x140, 0xF, 0xF, true));
    return v;
}
__device__ __forceinline__ void scan_phase(const Params& p, int l, LAS unsigned char* lds, const int wv) {
    const int tid = tid_(wv), lane = tid & 63, wave = __builtin_amdgcn_readfirstlane(tid >> 6);
    const bf16_t* PRW = (const bf16_t*)(KWS + WS_PRW); const bf16_t* LORA = (const bf16_t*)(KWS + WS_LORA);
    bf16_t* YRAW = (bf16_t*)(KWS + WS_YRAW); float* BONUS = (float*)(KWS + WS_BONUS);
    LAS float* inb = (LAS float*)lds;
    LAS float* yb = inb + 2 * TC * SROW;
    for (int item = bid_(); item < 256; item += gridDim.x) {
        const int chain = item >> 1, half = item & 1, b = chain >> 3, head = chain & 7;
        const int pt = tid - 256, t_l = (pt >> 3) & 31, cgi = pt & 7, c0 = cgi * 8, ch = head * 64 + c0;
        const float* mu = (const float*)karg(4) + l * RWC + ch; const float* ckk = (const float*)karg(10) + l * 512 + ch; const float* cka = (const float*)karg(11) + l * 512 + ch; const float* crk = (const float*)karg(12) + l * 512 + ch;
        u32x4 raw[8], rawb[8];
        const bf16_t* prw0 = PRW + ((size_t)b * SEQ + t_l) * RWC + ch; const bf16_t* lor0 = LORA + ((size_t)b * SEQ + t_l) * 1536 + ch;
#define SCAN_LOAD(dst, n_) do { const bf16_t* q_ = prw0 + (size_t)(n_) * TC * RWC; const bf16_t* lq_ = lor0 + (size_t)(n_) * TC * 1536; \
            dst[0] = ld16(q_); dst[1] = ld16(q_ + 512); dst[2] = ld16(q_ + 1024); \
            if ((n_) * TC + t_l > 0) { dst[3] = ld16(q_ - RWC); dst[4] = ld16(q_ - RWC + 512); dst[5] = ld16(q_ - RWC + 1024); } \
            else { dst[3] = (u32x4){0u, 0u, 0u, 0u}; dst[4] = dst[3]; dst[5] = dst[3]; } \
            dst[6] = ld16(lq_); dst[7] = ld16(lq_ + 512); } while (0)
        if (wave >= 4) {
            SCAN_LOAD(raw, 0);
        }
        const int seg = lane & 15, rg = lane >> 4, rr0 = (wave & 3) * 8 + rg * 2;
        f32x2 Sa0 = (f32x2){0.f, 0.f}, Sa1 = Sa0, Sb0 = Sa0, Sb1 = Sa0;
#pragma unroll 1
        for (int n2 = 0; n2 <= NCH + 1; n2 += 2) {
        { const int n = n2;
            if (wave >= 4) {
                if (n >= 2) {
                    const LAS float* ys = yb + (n & 1) * TC * 32 + t_l * 32 + cgi * 4;
                    const f32x4 yv = *(const LAS f32x4*)ys;
                    u32x2 w; w.x = cvt_pk_bf16(yv[0], yv[1]); w.y = cvt_pk_bf16(yv[2], yv[3]);
                    *(u32x2*)(YRAW + (size_t)(b * SEQ + (n - 2) * TC + t_l) * 512 + head * 64 + half * 32 + cgi * 4) = w;
                }
                if (n < NCH) {
                    if (n + 1 < NCH) SCAN_LOAD(rawb, n + 1);
                    const size_t m = (size_t)b * SEQ + n * TC + t_l;
                    float mur[8], muk[8], muv[8], kkc[8], kac[8], rkc[8];
                    ld8f(mu, mur); ld8f(mu + 512, muk); ld8f(mu + 1024, muv); ld8f(ckk, kkc); ld8f(cka, kac); ld8f(crk, rkc);
                    float r[8], k[8], v[8], rp[8], kp[8], vp[8], sl[8], al[8];
                    unpack8(raw[0], r); unpack8(raw[1], k); unpack8(raw[2], v); unpack8(raw[3], rp); unpack8(raw[4], kp); unpack8(raw[5], vp); unpack8(raw[6], sl); unpack8(raw[7], al);
                    float kkr[8], ss = 0.f, bon = 0.f, dec[8], kpr[8];
#pragma unroll
                    for (int j = 0; j < 8; ++j) {
                        r[j] = r[j] + (rp[j] - r[j]) * mur[j]; k[j] = k[j] + (kp[j] - k[j]) * muk[j]; v[j] = v[j] + (vp[j] - v[j]) * muv[j];
                        dec[j] = __expf(-0.6065306597126334f * sl[j]);
                        kkr[j] = k[j] * kkc[j]; ss += kkr[j] * kkr[j];
                        kpr[j] = k[j] * (1.0f + (al[j] - 1.0f) * kac[j]);
                        bon += r[j] * kpr[j] * rkc[j];
                    }
                    ss = dpp_sum8(ss); bon = dpp_sum8(bon);
                    const float inrm = 1.0f / fmaxf(sqrtf(ss), 1e-12f);
                    LAS float* dst = inb + (n & 1) * TC * SROW + t_l * SROW + c0;
                    f32x4 w0, w1;
                    w0 = (f32x4){kkr[0] * inrm, kkr[1] * inrm, kkr[2] * inrm, kkr[3] * inrm}; w1 = (f32x4){kkr[4] * inrm, kkr[5] * inrm, kkr[6] * inrm, kkr[7] * inrm};
                    *(LAS f32x4*)(dst) = w0; *(LAS f32x4*)(dst + 4) = w1;
                    *(LAS f32x4*)(dst + 192) = (f32x4){w0[0] * al[0], w0[1] * al[1], w0[2] * al[2], w0[3] * al[3]}; *(LAS f32x4*)(dst + 196) = (f32x4){w1[0] * al[4], w1[1] * al[5], w1[2] * al[6], w1[3] * al[7]};
                    *(LAS f32x4*)(dst + 64) = (f32x4){dec[0], dec[1], dec[2], dec[3]}; *(LAS f32x4*)(dst + 68) = (f32x4){dec[4], dec[5], dec[6], dec[7]};
                    *(LAS f32x4*)(dst + 128) = (f32x4){kpr[0], kpr[1], kpr[2], kpr[3]}; *(LAS f32x4*)(dst + 132) = (f32x4){kpr[4], kpr[5], kpr[6], kpr[7]};
                    *(LAS f32x4*)(dst + 256) = (f32x4){r[0], r[1], r[2], r[3]}; *(LAS f32x4*)(dst + 260) = (f32x4){r[4], r[5], r[6], r[7]};
                    if ((cgi >> 2) == half) { LAS float* vd = inb + (n & 1) * TC * SROW + t_l * SROW + 320 + (c0 - 32 * half);
                        *(LAS f32x4*)(vd) = (f32x4){v[0], v[1], v[2], v[3]}; *(LAS f32x4*)(vd + 4) = (f32x4){v[4], v[5], v[6], v[7]}; }
                    if (half == 0 && cgi == 0) BONUS[m * 8 + head] = bon;
                }
            } else if (n >= 1 && n <= NCH) {
                const LAS float* src = inb + ((n - 1) & 1) * TC * SROW + seg * 4;
                const LAS float* vsrc = inb + ((n - 1) & 1) * TC * SROW + 320 + rr0;
                LAS float* yd = yb + ((n - 1) & 1) * TC * 32 + rr0;
#define SCAN_RD2(q_, tl_) do { const LAS float* s_ = src + (tl_) * SROW; kkq[q_] = *(const LAS f32x4*)(s_); dcq[q_] = *(const LAS f32x4*)(s_ + 64); kpq[q_] = *(const LAS f32x4*)(s_ + 128); \
                    bvq[q_] = *(const LAS f32x4*)(s_ + 192); rvq[q_] = *(const LAS f32x4*)(s_ + 256); vvq[q_] = *(const LAS f32x2*)(vsrc + (tl_) * SROW); } while (0)
                f32x4 kkq[4], dcq[4], kpq[4], bvq[4], rvq[4]; f32x2 vvq[4];
                SCAN_RD2(0, 0); SCAN_RD2(1, 1);
#pragma unroll 1
                for (int tl4 = 0; tl4 < TC; tl4 += 4) {
                    float yA[4], yB[4];
#pragma unroll
                    for (int u = 0; u < 4; ++u) {
                        { const int tn = tl4 + u + 2 < TC ? tl4 + u + 2 : TC - 1; SCAN_RD2((u + 2) & 3, tn); }
                        const f32x4 kk = kkq[u], dc = dcq[u], kp = kpq[u], bv = bvq[u], rv = rvq[u]; const f32x2 vv = vvq[u];
                        const f32x2 kk0 = (f32x2){kk[0], kk[1]}, kk1 = (f32x2){kk[2], kk[3]};
                        const f32x2 kp0 = (f32x2){kp[0], kp[1]}, kp1 = (f32x2){kp[2], kp[3]}, bv0 = (f32x2){bv[0], bv[1]}, bv1 = (f32x2){bv[2], bv[3]};
                        const f32x2 dc0 = (f32x2){dc[0], dc[1]}, dc1 = (f32x2){dc[2], dc[3]};
                        const f32x2 r0 = (f32x2){rv[0], rv[1]}, r1 = (f32x2){rv[2], rv[3]};
                        const f32x2 va = (f32x2){vv.x, vv.x}, vb = (f32x2){vv.y, vv.y};
                        f32x2 da = Sa0 * kk0; da += Sa1 * kk1; f32x2 db = Sb0 * kk0; db += Sb1 * kk1;
                        const float saa = dpp_sum16(da.x + da.y), sab = dpp_sum16(db.x + db.y);
                        const f32x2 na = (f32x2){-saa, -saa}, nb = (f32x2){-sab, -sab};
                        Sa0 = Sa0 * dc0 + (va * kp0 + na * bv0); Sa1 = Sa1 * dc1 + (va * kp1 + na * bv1);
                        Sb0 = Sb0 * dc0 + (vb * kp0 + nb * bv0); Sb1 = Sb1 * dc1 + (vb * kp1 + nb * bv1);
                        f32x2 ya = Sa0 * r0; ya += Sa1 * r1; f32x2 yb2 = Sb0 * r0; yb2 += Sb1 * r1;
                        yA[u] = dpp_sum16(ya.x + ya.y); yB[u] = dpp_sum16(yb2.x + yb2.y);
                    }
                    const float y0 = seg == 0 ? yA[0] : seg == 1 ? yA[1] : seg == 2 ? yA[2] : yA[3];
                    const float y1 = seg == 0 ? yB[0] : seg == 1 ? yB[1] : seg == 2 ? yB[2] : yB[3];
                    if (seg < 4) *(LAS f32x2*)(yd + (tl4 + seg) * 32) = (f32x2){y0, y1};
                }
#undef SCAN_RD2
            }
            __syncthreads();
        }
        { const int n = n2 + 1;
            if (wave >= 4) {
                if (n >= 2) {
                    const LAS float* ys = yb + (n & 1) * TC * 32 + t_l * 32 + cgi * 4;
                    const f32x4 yv = *(const LAS f32x4*)ys;
                    u32x2 w; w.x = cvt_pk_bf16(yv[0], yv[1]); w.y = cvt_pk_bf16(yv[2], yv[3]);
                    *(u32x2*)(YRAW + (size_t)(b * SEQ + (n - 2) * TC + t_l) * 512 + head * 64 + half * 32 + cgi * 4) = w;
                }
                if (n < NCH) {
                    if (n + 1 < NCH) SCAN_LOAD(raw, n + 1);
                    const size_t m = (size_t)b * SEQ + n * TC + t_l;
                    float mur[8], muk[8], muv[8], kkc[8], kac[8], rkc[8];
                    ld8f(mu, mur); ld8f(mu + 512, muk); ld8f(mu + 1024, muv); ld8f(ckk, kkc); ld8f(cka, kac); ld8f(crk, rkc);
                    float r[8], k[8], v[8], rp[8], kp[8], vp[8], sl[8], al[8];
                    unpack8(rawb[0], r); unpack8(rawb[1], k); unpack8(rawb[2], v); unpack8(rawb[3], rp); unpack8(rawb[4], kp); unpack8(rawb[5], vp); unpack8(rawb[6], sl); unpack8(rawb[7], al);
                    float kkr[8], ss = 0.f, bon = 0.f, dec[8], kpr[8];
#pragma unroll
                    for (int j = 0; j < 8; ++j) {
                        r[j] = r[j] + (rp[j] - r[j]) * mur[j]; k[j] = k[j] + (kp[j] - k[j]) * muk[j]; v[j] = v[j] + (vp[j] - v[j]) * muv[j];
                        dec[j] = __expf(-0.6065306597126334f * sl[j]);
                        kkr[j] = k[j] * kkc[j]; ss += kkr[j] * kkr[j];
                        kpr[j] = k[j] * (1.0f + (al[j] - 1.0f) * kac[j]);
                        bon += r[j] * kpr[j] * rkc[j];
                    }
                    ss = dpp_sum8(ss); bon = dpp_sum8(bon);
                    const float inrm = 1.0f / fmaxf(sqrtf(ss), 1e-12f);
                    LAS float* dst = inb + (n & 1) * TC * SROW + t_l * SROW + c0;
                    f32x4 w0, w1;
                    w0 = (f32x4){kkr[0] * inrm, kkr[1] * inrm, kkr[2] * inrm, kkr[3] * inrm}; w1 = (f32x4){kkr[4] * inrm, kkr[5] * inrm, kkr[6] * inrm, kkr[7] * inrm};
                    *(LAS f32x4*)(dst) = w0; *(LAS f32x4*)(dst + 4) = w1;
                    *(LAS f32x4*)(dst + 192) = (f32x4){w0[0] * al[0], w0[1] * al[1], w0[2] * al[2], w0[3] * al[3]}; *(LAS f32x4*)(dst + 196) = (f32x4){w1[0] * al[4], w1[1] * al[5], w1[2] * al[6], w1[3] * al[7]};
                    *(LAS f32x4*)(dst + 64) = (f32x4){dec[0], dec[1], dec[2], dec[3]}; *(LAS f32x4*)(dst + 68) = (f32x4){dec[4], dec[5], dec[6], dec[7]};
                    *(LAS f32x4*)(dst + 128) = (f32x4){kpr[0], kpr[1], kpr[2], kpr[3]}; *(LAS f32x4*)(dst + 132) = (f32x4){kpr[4], kpr[5], kpr[6], kpr[7]};
                    *(LAS f32x4*)(dst + 256) = (f32x4){r[0], r[1], r[2], r[3]}; *(LAS f32x4*)(dst + 260) = (f32x4){r[4], r[5], r[6], r[7]};
                    if ((cgi >> 2) == half) { LAS float* vd = inb + (n & 1) * TC * SROW + t_l * SROW + 320 + (c0 - 32 * half);
                        *(LAS f32x4*)(vd) = (f32x4){v[0], v[1], v[2], v[3]}; *(LAS f32x4*)(vd + 4) = (f32x4){v[4], v[5], v[6], v[7]}; }
                    if (half == 0 && cgi == 0) BONUS[m * 8 + head] = bon;
                }
            } else if (n >= 1 && n <= NCH) {
                const LAS float* src = inb + ((n - 1) & 1) * TC * SROW + seg * 4;
                const LAS float* vsrc = inb + ((n - 1) & 1) * TC * SROW + 320 + rr0;
                LAS float* yd = yb + ((n - 1) & 1) * TC * 32 + rr0;
#define SCAN_RD2(q_, tl_) do { const LAS float* s_ = src + (tl_) * SROW; kkq[q_] = *(const LAS f32x4*)(s_); dcq[q_] = *(const LAS f32x4*)(s_ + 64); kpq[q_] = *(const LAS f32x4*)(s_ + 128); \
                    bvq[q_] = *(const LAS f32x4*)(s_ + 192); rvq[q_] = *(const LAS f32x4*)(s_ + 256); vvq[q_] = *(const LAS f32x2*)(vsrc + (tl_) * SROW); } while (0)
                f32x4 kkq[4], dcq[4], kpq[4], bvq[4], rvq[4]; f32x2 vvq[4];
                SCAN_RD2(0, 0); SCAN_RD2(1, 1);
#pragma unroll 1
                for (int tl4 = 0; tl4 < TC; tl4 += 4) {
                    float yA[4], yB[4];
#pragma unroll
                    for (int u = 0; u < 4; ++u) {
                        { const int tn = tl4 + u + 2 < TC ? tl4 + u + 2 : TC - 1; SCAN_RD2((u + 2) & 3, tn); }
                        const f32x4 kk = kkq[u], dc = dcq[u], kp = kpq[u], bv = bvq[u], rv = rvq[u]; const f32x2 vv = vvq[u];
                        const f32x2 kk0 = (f32x2){kk[0], kk[1]}, kk1 = (f32x2){kk[2], kk[3]};
                        const f32x2 kp0 = (f32x2){kp[0], kp[1]}, kp1 = (f32x2){kp[2], kp[3]}, bv0 = (f32x2){bv[0], bv[1]}, bv1 = (f32x2){bv[2], bv[3]};
                        const f32x2 dc0 = (f32x2){dc[0], dc[1]}, dc1 = (f32x2){dc[2], dc[3]};
                        const f32x2 r0 = (f32x2){rv[0], rv[1]}, r1 = (f32x2){rv[2], rv[3]};
                        const f32x2 va = (f32x2){vv.x, vv.x}, vb = (f32x2){vv.y, vv.y};
                        f32x2 da = Sa0 * kk0; da += Sa1 * kk1; f32x2 db = Sb0 * kk0; db += Sb1 * kk1;
                        const float saa = dpp_sum16(da.x + da.y), sab = dpp_sum16(db.x + db.y);
                        const f32x2 na = (f32x2){-saa, -saa}, nb = (f32x2){-sab, -sab};
                        Sa0 = Sa0 * dc0 + (va * kp0 + na * bv0); Sa1 = Sa1 * dc1 + (va * kp1 + na * bv1);
                        Sb0 = Sb0 * dc0 + (vb * kp0 + nb * bv0); Sb1 = Sb1 * dc1 + (vb * kp1 + nb * bv1);
                        f32x2 ya = Sa0 * r0; ya += Sa1 * r1; f32x2 yb2 = Sb0 * r0; yb2 += Sb1 * r1;
                        yA[u] = dpp_sum16(ya.x + ya.y); yB[u] = dpp_sum16(yb2.x + yb2.y);
                    }
                    const float y0 = seg == 0 ? yA[0] : seg == 1 ? yA[1] : seg == 2 ? yA[2] : yA[3];
                    const float y1 = seg == 0 ? yB[0] : seg == 1 ? yB[1] : seg == 2 ? yB[2] : yB[3];
                    if (seg < 4) *(LAS f32x2*)(yd + (tl4 + seg) * 32) = (f32x2){y0, y1};
                }
#undef SCAN_RD2
            }
            __syncthreads();
        }
        }
#undef SCAN_LOAD
    }
}

__device__ __forceinline__ void post_phase(const Params& p, int l, const int wv) {
    const int gt = bid_() * NTHR + tid_(wv), NGT = gridDim.x * NTHR;
    const bf16_t* PRW = (const bf16_t*)(KWS + WS_PRW); const bf16_t* LORA = (const bf16_t*)(KWS + WS_LORA); const bf16_t* YRAW = (const bf16_t*)(KWS + WS_YRAW);
    const float* BONUS = (const float*)(KWS + WS_BONUS); bf16_t* MA = (bf16_t*)(KWS + WS_MA);
    const float* muv = (const float*)karg(4) + l * RWC + 1024; const float* lg = (const float*)karg(13) + l * 512; const float* lb = (const float*)karg(14) + l * 512;
    for (int idx = gt; idx < MTOK * 64; idx += NGT) {
        const int m = idx >> 6, c = (idx & 63) * 8, head = c >> 6, t = m & (SEQ - 1);
        float y[8], cur[8], prv[8], mm[8], g[8], gg[8], bb[8], o[8];
        unpack8(ld16(YRAW + (size_t)m * 512 + c), y);
        float s = 0.f;
#pragma unroll
        for (int j = 0; j < 8; ++j) s += y[j];
        const float mean = dpp_sum8(s) * (1.0f / 64.0f);
        float q = 0.f;
#pragma unroll
        for (int j = 0; j < 8; ++j) { y[j] -= mean; q += y[j] * y[j]; }
        const float rstd = 1.0f / sqrtf(dpp_sum8(q) * (1.0f / 64.0f) + 64e-5f);
        unpack8(ld16(PRW + (size_t)m * RWC + 1024 + c), cur);
        if (t > 0) unpack8(ld16(PRW + (size_t)(m - 1) * RWC + 1024 + c), prv); else { _Pragma("unroll") for (int j = 0; j < 8; ++j) prv[j] = 0.f; }
        ld8f(muv + c, mm); ld8f(lg + c, gg); ld8f(lb + c, bb);
        unpack8(ld16(LORA + (size_t)m * 1536 + 1024 + c), g);
        const float bon = BONUS[(size_t)m * 8 + head];
#pragma unroll
        for (int j = 0; j < 8; ++j) { const float vs = cur[j] + (prv[j] - cur[j]) * mm[j]; o[j] = (y[j] * rstd * gg[j] + bb[j] + bon * vs) * g[j]; }
        *(u32x4*)(MA + (size_t)m * 512 + c) = pack8(o);
    }
}


#define XB_TMO      128
#define XB_XCNT(j)  (256  + 64 * (j))
#define XB_XSUB(j)  (1280 + 64 * (j))
#define XB_XGEN(j)  (2304 + 64 * (j))
#define XB_TOP      3328
#define XB_TOPGEN   3392
#define XCD_BAR_WORDS 3456
#define XB_SPIN_CAP (1u << 18)
__device__ __forceinline__ unsigned xb_ld(unsigned* p)              { return __hip_atomic_load(p, __ATOMIC_RELAXED, __HIP_MEMORY_SCOPE_AGENT); }
__device__ __forceinline__ unsigned xb_add(unsigned* p, unsigned v) { return __hip_atomic_fetch_add(p, v, __ATOMIC_RELAXED, __HIP_MEMORY_SCOPE_AGENT); }
__device__ __forceinline__ unsigned xb_xcc_id() { return (unsigned)__builtin_amdgcn_s_getreg((3 << 11) | 20) & 0xFu; }
#define XB_SPIN(cond, bar) do { unsigned _sp = 0; while (cond) { __builtin_amdgcn_s_sleep(1); \
    if ((++_sp & 255u) == 0u) { if (xb_ld(&(bar)[XB_TMO])) break; if (_sp > XB_SPIN_CAP) { atomicAdd(&(bar)[XB_TMO], 1u); break; } } } } while (0)
struct XcdBarrier { unsigned* bar; unsigned x; volatile LAS unsigned* st; };
__device__ __forceinline__ void xcd_barrier_complete(unsigned* bar, unsigned x, unsigned& nloc, unsigned& nx) {
    const unsigned G = gridDim.x * gridDim.y * gridDim.z;
    unsigned sum, cnt, mine, sp = 0u;
    for (;;) {
        sum = 0u; cnt = 0u; mine = 0u;
#pragma unroll
        for (unsigned j = 0; j < 16; ++j) { const unsigned c = xb_ld(&bar[XB_XCNT(j)]); sum += c; cnt += (c > 0u) ? 1u : 0u; mine = (j == x) ? c : mine; }
        if (sum == G) break;
        __builtin_amdgcn_s_sleep(1);
        if ((++sp & 255u) == 0u) { if (xb_ld(&bar[XB_TMO])) break; if (sp > XB_SPIN_CAP) { atomicAdd(&bar[XB_TMO], 1u); break; } }
    }
    nloc = mine > 0u ? mine : 1u; nx = cnt > 0u ? cnt : 1u;
}
__device__ __forceinline__ void xcd_barrier(const XcdBarrier& b, const int wv) {
    asm volatile("s_waitcnt vmcnt(0)" ::: "memory");
    __syncthreads();
    if (tid_(wv) == 0) {
        unsigned* bar = b.bar;
        __builtin_amdgcn_s_waitcnt(0);
        unsigned nloc = b.st[0], nx = b.st[1];
        if (nloc == 0u) { xcd_barrier_complete(bar, b.x, nloc, nx); b.st[0] = nloc; b.st[1] = nx; }
        const unsigned old = xb_add(&bar[XB_XSUB(b.x)], 1u);
        const unsigned gen = old / nloc;
        if (old + 1u == (gen + 1u) * nloc) {
            __builtin_amdgcn_fence(__ATOMIC_RELEASE, "agent");
            asm volatile("s_waitcnt vmcnt(0)" ::: "memory");
            const unsigned og = xb_add(&bar[XB_TOP], 1u);
            const unsigned tg = og / nx;
            if (og + 1u == (tg + 1u) * nx) xb_add(&bar[XB_TOPGEN], 1u);
            else XB_SPIN(xb_ld(&bar[XB_TOPGEN]) == tg, bar);
            __builtin_amdgcn_fence(__ATOMIC_ACQUIRE, "agent");
            xb_add(&bar[XB_XGEN(b.x)], 1u);
            asm volatile("s_waitcnt vmcnt(0)" ::: "memory");
        } else {
            XB_SPIN(xb_ld(&bar[XB_XGEN(b.x)]) == gen, bar);
            __builtin_amdgcn_fence(__ATOMIC_ACQUIRE, "agent");
            asm volatile("s_waitcnt vmcnt(0)" ::: "memory");
        }
    }
    __syncthreads();
}

__global__ void __launch_bounds__(NTHR, 2) hybrid_fwd(Params p) {
    extern __shared__ __attribute__((aligned(16))) unsigned char lds_raw[];
    LAS unsigned char* lds = (LAS unsigned char*)lds_raw;
    cg::grid_group grid = cg::this_grid();
    const int wv = __builtin_amdgcn_readfirstlane((int)threadIdx.x >> 6);
    const int G = gridDim.x;
    const int lo = p.ph_lo, hi = p.ph_hi;
#define RUN(k) (lo <= (k) && (k) < hi)
#ifndef REPEAT_MASK
#define REPEAT_MASK 0
#endif
#define REP(k) _Pragma("unroll 1") for (int rep_ = 0; rep_ < 1 + ((REPEAT_MASK >> (k)) & 1); ++rep_)
#define SYNC(k) do { if (RUN(k) && RUN((k) + 1)) xcd_barrier(xbar, wv); } while (0)
    XcdBarrier xbar; xbar.bar = (unsigned*)(KWS + WS_CTL); xbar.x = xb_xcc_id(); xbar.st = (volatile LAS unsigned*)(lds + LDS_BYTES - 16);
    { const int t0 = tid_(wv); if (t0 < 2) xbar.st[t0] = 0u;
      if (bid_() == 0) for (int i = t0; i < XCD_BAR_WORDS; i += NTHR) xbar.bar[i] = 0u; }
    if (RUN(0)) {
        prologue_phase(p, lds, wv);
        norm_phase((const float*)karg(0), (const float*)karg(2), (bf16_t*)(KWS + WS_H), wv);
    }
    if (RUN(0) && RUN(1)) { grid.sync(); if (tid_(wv) == 0) (void)xb_add(&xbar.bar[XB_XCNT(xbar.x)], 1u); }
#pragma unroll 1
    for (int l = 0; l < NL; ++l) {
        const int pb = 1 + 11 * l;
        const char* wl = (const char*)(KWS + WS_W) + (size_t)l * LW_ELEMS * 2;
        if (RUN(pb + 0)) REP(0) {
            pg::DenseSched S{(const char*)(KWS + WS_H), wl + OW_IN * 2, 2048u, 2048u, 16, 256, 18, G, bid_()};
            pg::EpiIn E{(bf16_t*)(KWS + WS_PRW), (bf16_t*)(KWS + WS_PPOOL), (bf16_t*)(KWS + WS_PCONV), (bf16_t*)(KWS + WS_PATT)};
            pg::gemm_phase(lds, S, E, wv);
        }
        SYNC(pb + 0);
        if (RUN(pb + 1)) REP(1) mix1_phase(p, l, lds, wv);
        SYNC(pb + 1);
        if (RUN(pb + 2)) REP(2) {
            pg::DenseSched S{(const char*)(KWS + WS_ALORA), wl + OW_LORA * 2, 512u, 512u, 4, 256, 6, G, bid_()};
            pg::EpiLora E{(bf16_t*)(KWS + WS_LORA), (const float*)karg(6) + l * 512, (const float*)karg(8) + l * 512};
            pg::gemm_phase(lds, S, E, wv);
        }
        SYNC(pb + 2);
        if (RUN(pb + 3)) REP(3) scan_phase(p, l, lds, wv);
        SYNC(pb + 3);
        if (RUN(pb + 4)) REP(4) post_phase(p, l, wv);
        SYNC(pb + 4);
        if (RUN(pb + 5)) REP(5) {
            const int c = bid_();
            pg::BRSched S{(const char*)(KWS + WS_H), wl + OW_IN * 2, (const char*)(KWS + WS_MA), (const char*)(KWS + WS_M3), wl + OW_BR * 2, G, c};
            pg::EpiBR E{(u32x4*)(KWS + WS_GSCR + (size_t)c * 131072), (bf16_t*)(KWS + WS_MIXED)};
            pg::gemm_phase(lds, S, E, wv);
        }
        SYNC(pb + 5);
        if (RUN(pb + 6)) {
            pg::DenseSched S{(const char*)(KWS + WS_MIXED), wl + OW_O * 2, 2048u, 2048u, 16, 256, 4, G, bid_()};
            pg::EpiRes E{l == 0 ? (const float*)karg(0) : (const float*)KOUT, KOUT};
            pg::gemm_phase(lds, S, E, wv);
        }
        SYNC(pb + 6);
        if (RUN(pb + 7)) REP(7) norm_phase(KOUT, (const float*)karg(26) + l * DM, (bf16_t*)(KWS + WS_H), wv);
        SYNC(pb + 7);
        if (RUN(pb + 8)) REP(8) {
            pg::DenseSched S{(const char*)(KWS + WS_H), wl + OW_GU * 2, 2048u, 2048u, 16, 256, 22, G, bid_()};
            pg::EpiGU E{(bf16_t*)(KWS + WS_ACT)};
            pg::gemm_phase(lds, S, E, wv);
        }
        SYNC(pb + 8);
        if (RUN(pb + 9)) {
            pg::DenseSched S{(const char*)(KWS + WS_ACT), wl + OW_D * 2, (unsigned)(DFF * 2), (unsigned)(DFF * 2), 44, 256, 4, G, bid_()};
            pg::EpiRes E{(const float*)KOUT, KOUT};
            pg::gemm_phase(lds, S, E, wv);
        }
        SYNC(pb + 9);
        if (RUN(pb + 10) && l + 1 < NL) norm_phase(KOUT, (const float*)karg(2) + (l + 1) * DM, (bf16_t*)(KWS + WS_H), wv);
        SYNC(pb + 10);
    }
#undef RUN
#undef SYNC
}

constexpr int N_PHASES = 1 + 11 * NL - 1;

extern "C" void kernel_launch(void* const* d_in, const int* in_sizes, int n_in, void* d_out, int out_size, void* d_ws, size_t ws_size, hipStream_t stream) {
    static int grid = 0;
    if (grid == 0) {
        if (n_in != 30 || out_size != MTOK * DM || ws_size < WS_END) { fprintf(stderr, "kernel_launch: unexpected shapes (n_in %d out %d ws %zu)\n", n_in, out_size, ws_size); grid = -1; return; }
        int dev = 0, cus = 0, per_cu = 0;
        (void)hipGetDevice(&dev); (void)hipDeviceGetAttribute(&cus, hipDeviceAttributeMultiprocessorCount, dev);
        (void)hipFuncSetAttribute((const void*)hybrid_fwd, hipFuncAttributeMaxDynamicSharedMemorySize, LDS_BYTES);
        (void)hipOccupancyMaxActiveBlocksPerMultiprocessor(&per_cu, (const void*)hybrid_fwd, NTHR, LDS_BYTES);
        if (per_cu < 1) { fprintf(stderr, "kernel_launch: occupancy query says %d blocks/CU\n", per_cu); per_cu = 1; }
        (void)hipGetLastError();
        grid = cus;
    }
    if (grid < 0) return;
    Params p{};
    for (int i = 0; i < 30; ++i) p.in[i] = d_in[i];
    p.out = (float*)d_out; p.ws = (unsigned char*)d_ws;
#ifdef MULTI_LAUNCH
    for (int ph = 0; ph < N_PHASES; ++ph) { p.ph_lo = ph; p.ph_hi = ph + 1; hipLaunchKernelGGL(hybrid_fwd, dim3(grid), dim3(NTHR), LDS_BYTES, stream, p); }
#else
    p.ph_lo = 0; p.ph_hi = N_PHASES;
    void* args[] = {&p};
    hipError_t e = hipLaunchCooperativeKernel((const void*)hybrid_fwd, dim3(grid), dim3(NTHR), args, LDS_BYTES, stream);
    if (e != hipSuccess) fprintf(stderr, "cooperative launch failed: %s (grid %d)\n", hipGetErrorString(e), grid);
#endif
}
```

```cpp
#include <hip/hip_runtime.h>
#include <hip/hip_cooperative_groups.h>
#include <cstdio>
#include <cstdint>
namespace cg = cooperative_groups;

#define LAS __attribute__((address_space(3)))
typedef unsigned short bf16_t;
typedef short bf16x8 __attribute__((ext_vector_type(8)));
typedef float f32x4 __attribute__((ext_vector_type(4)));
typedef float f32x2 __attribute__((ext_vector_type(2)));
typedef unsigned u32x4 __attribute__((ext_vector_type(4)));
typedef unsigned u32x2 __attribute__((ext_vector_type(2)));

constexpr int MTOK = 65536, SEQ = 4096, DM = 1024, NL = 2;
constexpr int RWC = 1792, INC = 8704, DFF = 2816;
constexpr int NTHR = 512;
constexpr size_t MiB = 1u << 20;
constexpr size_t OW_IN = 0, OW_LORA = 8912896, OW_BR = OW_LORA + 393216, OW_O = OW_BR + 2097152, OW_GU = OW_O + 1048576, OW_D = OW_GU + 5767168, LW_ELEMS = OW_D + 2883584;
constexpr size_t WS_W = 0, WS_BONUS = 82 * MiB, WS_ROPE = 84 * MiB, WS_H = 92 * MiB, WS_M3 = 220 * MiB, WS_PRW = 412 * MiB, WS_PPOOL = 636 * MiB,
                 WS_PCONV = 700 * MiB, WS_PATT = 892 * MiB, WS_ALORA = 988 * MiB, WS_END = 1020 * MiB;
constexpr size_t WS_CTL = 81 * MiB;
constexpr size_t WS_SSQ = 81 * MiB + 65536;
constexpr size_t WS_LORA = 636 * MiB, WS_YRAW = 828 * MiB, WS_MA = 892 * MiB, WS_GSCR = 956 * MiB, WS_MIXED = 412 * MiB, WS_ACT = 220 * MiB;
static_assert(2 * LW_ELEMS * 2 <= 81 * MiB, "weights fit below the control words");
constexpr int LDS_BYTES = 147456;

struct Params { const void* in[30]; float* out; unsigned char* ws; int ph_lo, ph_hi; };

__device__ __forceinline__ unsigned cvt_pk_bf16(float lo, float hi) { unsigned r; asm volatile("v_cvt_pk_bf16_f32 %0, %1, %2" : "=v"(r) : "v"(lo), "v"(hi)); return r; }
__device__ __forceinline__ void unpack8(const u32x4 w, float (&f)[8]) {
    f[0] = __uint_as_float(w.x << 16); f[1] = __uint_as_float(w.x & 0xffff0000u); f[2] = __uint_as_float(w.y << 16); f[3] = __uint_as_float(w.y & 0xffff0000u);
    f[4] = __uint_as_float(w.z << 16); f[5] = __uint_as_float(w.z & 0xffff0000u); f[6] = __uint_as_float(w.w << 16); f[7] = __uint_as_float(w.w & 0xffff0000u);
}
__device__ __forceinline__ u32x4 pack8(const float (&f)[8]) { u32x4 w; w.x = cvt_pk_bf16(f[0], f[1]); w.y = cvt_pk_bf16(f[2], f[3]); w.z = cvt_pk_bf16(f[4], f[5]); w.w = cvt_pk_bf16(f[6], f[7]); return w; }
__device__ __forceinline__ u32x4 ld16(const bf16_t* p) { return *(const u32x4*)p; }
__device__ __forceinline__ void ld8f(const float* p, float (&f)[8]) { const f32x4 a = *(const f32x4*)p, b = *(const f32x4*)(p + 4); f[0] = a.x; f[1] = a.y; f[2] = a.z; f[3] = a.w; f[4] = b.x; f[5] = b.y; f[6] = b.z; f[7] = b.w; }
__device__ __forceinline__ float sigmoidf_(float x) { return 1.0f / (1.0f + __expf(-x)); }
__device__ __forceinline__ const void* karg(int idx) {
    const __attribute__((address_space(4))) unsigned long long* kp = (const __attribute__((address_space(4))) unsigned long long*)__builtin_amdgcn_kernarg_segment_ptr();
    asm volatile("" : "+s"(kp));
    return (const void*)kp[idx];
}
#define KWS ((unsigned char*)karg(31))
#define KOUT ((float*)karg(30))
__device__ __forceinline__ int tid_(int wv) { int t; asm volatile("v_mbcnt_lo_u32_b32 %0, -1, 0\n\tv_mbcnt_hi_u32_b32 %0, -1, %0" : "=v"(t)); return (wv << 6) | t; }
__device__ __forceinline__ int bid_() { int b = blockIdx.x; asm volatile("" : "+s"(b)); return b; }
__device__ __forceinline__ float dpp_sum8(float v) {
    v += __builtin_bit_cast(float, __builtin_amdgcn_mov_dpp(__builtin_bit_cast(int, v), 0xB1, 0xF, 0xF, true));
    v += __builtin_bit_cast(float, __builtin_amdgcn_mov_dpp(__builtin_bit_cast(int, v), 0x4E, 0xF, 0xF, true));
    v += __builtin_bit_cast(float, __builtin_amdgcn_mov_dpp(__builtin_bit_cast(int, v), 0x141, 0xF, 0xF, true));
    return v;
}

namespace pg {
constexpr int BM = 256, BK = 64, HALF = 128, HTB = HALF * BK * 2, NXCD = 8, WGM = 8;
__device__ __forceinline__ int lds_byte(int r, int c) { const int st = (r >> 4) * 2 + (c >> 5), rr = r & 15, cc = c & 31, ob = rr * 64 + cc * 2; return st * 1024 + (ob ^ (((ob >> 9) & 1) << 5)); }
__device__ __forceinline__ void stage_rc(int b, int& R, int& C) { const int st = b / 1024, sb = b % 1024, swz = sb ^ (((sb >> 9) & 1) << 5); R = (st >> 1) * 16 + swz / 64; C = (st & 1) * 32 + (swz % 64) / 2; }
__device__ __forceinline__ int perm32(int rho) { const int n = rho >> 4, i = rho & 15; return 8 * (i >> 2) + 4 * n + (i & 3); }

struct GUnit { const char* A; const char* B; unsigned lda2, ldb2; int nt, pm, pn, aux; };

__device__ __forceinline__ bool tile_order(int i, int G, int c, int nM, int nN, int& pm, int& pn) {
    const int nwg = nM * nN; const long L = (long)i * G + c; if (L >= nwg) return false;
    int wgid = (int)L; { const int q = nwg / NXCD, r = nwg % NXCD, xcd = wgid % NXCD, off = wgid / NXCD; wgid = (xcd < r ? xcd * (q + 1) : r * (q + 1) + (xcd - r) * q) + off; }
    const int nig = WGM * nN, gid = wgid / nig, fm = gid * WGM, gsz = (nM - fm) < WGM ? (nM - fm) : WGM;
    pm = fm + ((wgid % nig) % gsz); pn = (wgid % nig) / gsz; return true;
}
struct DenseSched {
    const char* A; const char* B; unsigned lda2, ldb2; int nt, nM, nN, G, c;
    __device__ __forceinline__ bool next(int i, GUnit& u) const {
        int pm, pn; if (!tile_order(i, G, c, nM, nN, pm, pn)) return false;
        u.A = A + (size_t)pm * 256 * lda2; u.B = B + (size_t)pn * 256 * ldb2; u.lda2 = lda2; u.ldb2 = ldb2; u.nt = nt; u.pm = pm; u.pn = pn; u.aux = 0; return true;
    }
};
struct BRSched {
    const char* H; const char* WIN; const char* MA; const char* M3; const char* WBR; int G, c;
    __device__ __forceinline__ bool next(int i, GUnit& u) const {
        int pm, pn; if (!tile_order(i >> 3, G, c, 256, 4, pm, pn)) return false;
        const int sub = i & 7, b = sub >> 1;
        if ((sub & 1) == 0) { u.A = H + (size_t)pm * 256 * 2048; u.lda2 = 2048; u.B = WIN + (size_t)(4608 + b * 1024 + pn * 256) * 2048; u.ldb2 = 2048; u.nt = 16; }
        else { if (b == 0) { u.A = MA + (size_t)pm * 256 * 1024; u.lda2 = 1024; } else { u.A = M3 + (size_t)(b - 1) * 1024 + (size_t)pm * 256 * 3072; u.lda2 = 3072; }
               u.B = WBR + (size_t)b * (1024 * 512 * 2) + (size_t)pn * 256 * 1024; u.ldb2 = 1024; u.nt = 8; }
        u.pm = pm; u.pn = pn; u.aux = sub; return true;
    }
};

template <class Epi, class Sched>
__device__ __forceinline__ void gemm_phase(LAS unsigned char* lds, const Sched& S, const Epi& E, const int wv) {
    const int tid = tid_(wv), wid = __builtin_amdgcn_readfirstlane(tid >> 6), lane = tid & 63, wr = wid >> 2, wc = wid & 3, fr = lane & 15, fq = lane >> 4;
    const size_t kstep = (size_t)(BK * 2);
    const unsigned ldsw = (unsigned)wid * 1024u;
    const int aoff = lds_byte(wr * 64 + fr, fq * 8), boff = lds_byte(wc * 32 + fr, fq * 8);
#define PG_SA(b, h) (((b) * 2 + (h)) * HTB)
#define PG_SB(b, h) ((4 + (b) * 2 + (h)) * HTB)
#define PG_STAGE(bufoff, gbase, voff, ld2) do { \
        __builtin_amdgcn_global_load_lds((const unsigned*)((const char*)(gbase) + (voff)), (LAS unsigned*)(lds + (bufoff) + ldsw), 16, 0, 0); \
        __builtin_amdgcn_global_load_lds((const unsigned*)((const char*)(gbase) + (size_t)64 * (ld2) + (voff)), (LAS unsigned*)(lds + (bufoff) + ldsw + 8192), 16, 0, 0); } while (0)
#define PG_LDA(dst, b, h) do { _Pragma("unroll") for (int m = 0; m < 4; ++m) _Pragma("unroll") for (int k = 0; k < 2; ++k) dst[m][k] = *(const LAS bf16x8*)(lds + PG_SA(b, h) + aoff + m * 2048 + k * 1024); } while (0)
#define PG_LDB(dst, b, h) do { _Pragma("unroll") for (int n = 0; n < 2; ++n) _Pragma("unroll") for (int k = 0; k < 2; ++k) dst[n][k] = *(const LAS bf16x8*)(lds + PG_SB(b, h) + boff + n * 2048 + k * 1024); } while (0)
#define PG_MMA(ai, bj, At, Bt) do { __builtin_amdgcn_s_setprio(1); _Pragma("unroll") for (int m = 0; m < 4; ++m) _Pragma("unroll") for (int n = 0; n < 2; ++n) _Pragma("unroll") for (int k = 0; k < 2; ++k) \
        acc[ai][bj][m][n] = __builtin_amdgcn_mfma_f32_16x16x32_bf16(Bt[n][k], At[m][k], acc[ai][bj][m][n], 0, 0, 0); __builtin_amdgcn_s_setprio(0); } while (0)
#define PG_WAIT_V(n) asm volatile("s_waitcnt vmcnt(" #n ")" ::: "memory")
#define PG_WAIT_L(n) asm volatile("s_waitcnt lgkmcnt(" #n ")" ::: "memory")
#define PG_BAR __builtin_amdgcn_s_barrier()
#define PG_SCHED __builtin_amdgcn_sched_barrier(0)
#define PG_BODY(a1, vA1, la1, a2, b2, vA2, vB2, la2, lb2) do { \
            const size_t hA1 = (size_t)128 * (la1), hA2 = (size_t)128 * (la2), hB2 = (size_t)128 * (lb2); \
            const char* a3 = (a2) + kstep; const char* b3 = (b2) + kstep; \
            PG_LDB(B0, 0, 0); PG_LDB(B1, 0, 1); PG_SCHED; PG_LDA(At, 0, 0); PG_STAGE(PG_SA(1, 1), (a1) + hA1, vA1, la1); \
            PG_WAIT_V(8); PG_WAIT_L(0); PG_BAR; PG_MMA(0, 0, At, B0); PG_MMA(0, 1, At, B1); PG_BAR; PG_SCHED; \
            PG_LDA(At, 0, 1); PG_STAGE(PG_SB(0, 0), (b2), vB2, lb2); PG_STAGE(PG_SB(0, 1), (b2) + hB2, vB2, lb2); PG_STAGE(PG_SA(0, 0), (a2), vA2, la2); \
            PG_WAIT_V(8); PG_WAIT_L(0); PG_BAR; PG_MMA(1, 0, At, B0); PG_MMA(1, 1, At, B1); PG_BAR; PG_SCHED; \
            PG_LDB(B0, 1, 0); PG_LDB(B1, 1, 1); PG_SCHED; PG_LDA(At, 1, 0); PG_STAGE(PG_SA(0, 1), (a2) + hA2, vA2, la2); \
            PG_WAIT_V(8); PG_WAIT_L(0); PG_BAR; PG_MMA(0, 0, At, B0); PG_MMA(0, 1, At, B1); PG_BAR; PG_SCHED; \
            PG_LDA(At, 1, 1); PG_STAGE(PG_SB(1, 0), b3, vB2, lb2); PG_STAGE(PG_SB(1, 1), b3 + hB2, vB2, lb2); PG_STAGE(PG_SA(1, 0), a3, vA2, la2); \
            PG_WAIT_V(8); PG_WAIT_L(0); PG_BAR; PG_MMA(1, 0, At, B0); PG_MMA(1, 1, At, B1); PG_BAR; PG_SCHED; } while (0)
    GUnit cur, nxt; int ui = 0;
    if (!S.next(0, cur)) return;
    f32x4 acc[2][2][4][2];
#pragma unroll
    for (int a = 0; a < 2; ++a)
#pragma unroll
        for (int b = 0; b < 2; ++b)
#pragma unroll
            for (int m = 0; m < 4; ++m)
#pragma unroll
                for (int n = 0; n < 2; ++n) acc[a][b][m][n] = (f32x4){0.f, 0.f, 0.f, 0.f};
    bf16x8 At[4][2], B0[2][2], B1[2][2];
    unsigned vAc, vBc;
    { int R0, C0; stage_rc(tid * 16, R0, C0); const int Rb0 = (R0 & ~31) + perm32(R0 & 31); vAc = (unsigned)R0 * cur.lda2 + (unsigned)C0 * 2u; vBc = (unsigned)Rb0 * cur.ldb2 + (unsigned)C0 * 2u; }
    {
        const char* cA = cur.A; const char* cB = cur.B; const size_t hA = (size_t)128 * cur.lda2, hB = (size_t)128 * cur.ldb2;
        PG_STAGE(PG_SB(0, 0), cB, vBc, cur.ldb2); PG_STAGE(PG_SB(0, 1), cB + hB, vBc, cur.ldb2); PG_STAGE(PG_SA(0, 0), cA, vAc, cur.lda2); PG_STAGE(PG_SA(0, 1), cA + hA, vAc, cur.lda2);
        if (wr == 1) PG_BAR;
        PG_WAIT_V(2); PG_BAR;
        PG_STAGE(PG_SB(1, 0), cB + kstep, vBc, cur.ldb2); PG_STAGE(PG_SA(1, 0), cA + kstep, vAc, cur.lda2); PG_STAGE(PG_SB(1, 1), cB + hB + kstep, vBc, cur.ldb2);
        PG_WAIT_V(6); PG_BAR;
    }
    for (;;) {
        const bool has_next = S.next(ui + 1, nxt);
        if (!has_next) nxt = cur;
        const int nt = cur.nt;
        const char* cA = cur.A; const char* cB = cur.B;
        for (int t = 0; t < nt - 2; t += 2)
            PG_BODY(cA + (size_t)(t + 1) * kstep, vAc, cur.lda2, cA + (size_t)(t + 2) * kstep, cB + (size_t)(t + 2) * kstep, vAc, vBc, cur.lda2, cur.ldb2);
        unsigned vAn, vBn;
        { const int t2 = tid_(wv); int R0, C0; stage_rc(t2 * 16, R0, C0); const int Rb0 = (R0 & ~31) + perm32(R0 & 31);
          vAn = (unsigned)R0 * nxt.lda2 + (unsigned)C0 * 2u; vBn = (unsigned)Rb0 * nxt.ldb2 + (unsigned)C0 * 2u; }
        PG_BODY(cA + (size_t)(nt - 1) * kstep, vAc, cur.lda2, nxt.A, nxt.B, vAn, vBn, nxt.lda2, nxt.ldb2);
        if (wr == 0) PG_BAR;
        { const int te = tid_(wv); E(acc, cur, wr, wc, te & 15, (te >> 4) & 3); }
        if (!has_next) break;
#pragma unroll
        for (int a = 0; a < 2; ++a)
#pragma unroll
            for (int b = 0; b < 2; ++b)
#pragma unroll
                for (int m = 0; m < 4; ++m)
#pragma unroll
                    for (int n = 0; n < 2; ++n) acc[a][b][m][n] = (f32x4){0.f, 0.f, 0.f, 0.f};
        cur = nxt; vAc = vAn; vBc = vBn; ++ui;
        if (wr == 1) PG_BAR;
    }
    PG_WAIT_V(0);
    PG_BAR;
#undef PG_SA
#undef PG_SB
#undef PG_STAGE
#undef PG_LDA
#undef PG_LDB
#undef PG_MMA
#undef PG_WAIT_V
#undef PG_WAIT_L
#undef PG_BAR
#undef PG_SCHED
#undef PG_BODY
}

#define EPI_LOOP(...) \
    _Pragma("unroll") for (int ai = 0; ai < 2; ++ai) _Pragma("unroll") for (int m = 0; m < 4; ++m) _Pragma("unroll") for (int bj = 0; bj < 2; ++bj) { \
        const int row = u.pm * 256 + ai * 128 + wr * 64 + m * 16 + fr; const int tcol = bj * 128 + wc * 32 + 8 * fq; \
        const f32x4 v0 = acc[ai][bj][m][0], v1 = acc[ai][bj][m][1]; float v[8] = {v0[0], v0[1], v0[2], v0[3], v1[0], v1[1], v1[2], v1[3]}; __VA_ARGS__ }

struct EpiIn {
    bf16_t *prw, *ppool, *pconv, *patt; const float* ssq;
    __device__ __forceinline__ void operator()(const f32x4 (&acc)[2][2][4][2], const GUnit& u, int wr, int wc, int fr, int fq) const {
        asm volatile("" : "+v"(fr), "+v"(fq));
        bf16_t* base; int ld, ct;
        if (u.pn < 7) { base = prw; ld = 1792; ct = u.pn; } else if (u.pn < 9) { base = ppool; ld = 512; ct = u.pn - 7; }
        else if (u.pn < 15) { base = pconv; ld = 1536; ct = u.pn - 9; } else { base = patt; ld = 768; ct = u.pn - 15; }
        EPI_LOOP({ if (ssq) { const float rs = 1.0f / sqrtf(ssq[row] * (1.0f / 1024.0f) + 1e-6f); _Pragma("unroll") for (int j = 0; j < 8; ++j) v[j] *= rs; }
                   *(u32x4*)(base + (size_t)row * ld + ct * 256 + tcol) = pack8(v); })
    }
};
struct EpiLora {
    bf16_t* out; const float* w0; const float* a0;
    __device__ __forceinline__ void operator()(const f32x4 (&acc)[2][2][4][2], const GUnit& u, int wr, int wc, int fr, int fq) const {
        asm volatile("" : "+v"(fr), "+v"(fq));
        const float* bias = u.pn < 2 ? w0 + u.pn * 256 : a0 + (u.pn - 2) * 256;
        const bool sg = u.pn < 4;
        float bv0[8], bv1[8];
        if (sg) { ld8f(bias + wc * 32 + 8 * fq, bv0); ld8f(bias + 128 + wc * 32 + 8 * fq, bv1); }
        EPI_LOOP({ if (sg) { _Pragma("unroll") for (int j = 0; j < 8; ++j) v[j] = sigmoidf_(v[j] + (bj ? bv1[j] : bv0[j])); }
                   *(u32x4*)(out + (size_t)row * 1536 + u.pn * 256 + tcol) = pack8(v); })
    }
};
struct EpiBR {
    u32x4* scr; bf16_t* mixed; const float* ssq;
    __device__ __forceinline__ void operator()(const f32x4 (&acc)[2][2][4][2], const GUnit& u, int wr, int wc, int fr, int fq) const {
        asm volatile("" : "+v"(fr), "+v"(fq));
        const bool gate = (u.aux & 1) == 0; const bool first = (u.aux >> 1) == 0;
        const int tix = (wr * 4 + wc) * 64 + fq * 16 + fr;
        if (gate) {
            EPI_LOOP({ const float rs = ssq ? 1.0f / sqrtf(ssq[row] * (1.0f / 1024.0f) + 1e-6f) : 1.0f;
                       _Pragma("unroll") for (int j = 0; j < 8; ++j) v[j] = sigmoidf_(v[j] * rs); scr[((ai * 4 + m) * 2 + bj) * 512 + tix] = pack8(v); })
        } else {
#pragma unroll
            for (int aq = 0; aq < 4; ++aq) {
                const int ai = aq >> 1, m0 = (aq & 1) * 2;
                u32x4 gq[4][2], oq[4][2];
#pragma unroll
                for (int m = m0; m < m0 + 2; ++m)
#pragma unroll
                    for (int bj = 0; bj < 2; ++bj) {
                        gq[m][bj] = scr[((ai * 4 + m) * 2 + bj) * 512 + tix];
                        const int row = u.pm * 256 + ai * 128 + wr * 64 + m * 16 + fr; const int tcol = bj * 128 + wc * 32 + 8 * fq;
                        if (!first) oq[m][bj] = *(const u32x4*)(mixed + (size_t)row * 1024 + u.pn * 256 + tcol);
                    }
#pragma unroll
                for (int m = m0; m < m0 + 2; ++m)
#pragma unroll
                    for (int bj = 0; bj < 2; ++bj) {
                        const int row = u.pm * 256 + ai * 128 + wr * 64 + m * 16 + fr; const int tcol = bj * 128 + wc * 32 + 8 * fq;
                        const f32x4 v0 = acc[ai][bj][m][0], v1 = acc[ai][bj][m][1]; float v[8] = {v0[0], v0[1], v0[2], v0[3], v1[0], v1[1], v1[2], v1[3]};
                        float g[8]; unpack8(gq[m][bj], g);
#pragma unroll
                        for (int j = 0; j < 8; ++j) v[j] *= g[j];
                        if (!first) { float o[8]; unpack8(oq[m][bj], o); _Pragma("unroll") for (int j = 0; j < 8; ++j) v[j] += o[j]; }
                        *(u32x4*)(mixed + (size_t)row * 1024 + u.pn * 256 + tcol) = pack8(v);
                    }
            }
        }
    }
};
struct EpiRes {
    const float* base; float* out; bf16_t* xg; const float* g; float* ssq;
    __device__ __forceinline__ void operator()(const f32x4 (&acc)[2][2][4][2], const GUnit& u, int wr, int wc, int fr, int fq) const {
        asm volatile("" : "+v"(fr), "+v"(fq));
        float gq[2][8], sqv[8];
        if (xg) { ld8f(g + u.pn * 256 + wc * 32 + 8 * fq, gq[0]); ld8f(g + u.pn * 256 + 128 + wc * 32 + 8 * fq, gq[1]); }
#pragma unroll
        for (int aq = 0; aq < 4; ++aq) {
            const int ai = aq >> 1, m0 = (aq & 1) * 2;
            f32x4 b0[4][2], b1[4][2];
#pragma unroll
            for (int m = m0; m < m0 + 2; ++m)
#pragma unroll
                for (int bj = 0; bj < 2; ++bj) {
                    const size_t off = (size_t)(u.pm * 256 + ai * 128 + wr * 64 + m * 16 + fr) * 1024 + u.pn * 256 + bj * 128 + wc * 32 + 8 * fq;
                    b0[m][bj] = *(const f32x4*)(base + off); b1[m][bj] = *(const f32x4*)(base + off + 4);
                }
#pragma unroll
            for (int m = m0; m < m0 + 2; ++m) {
                float sq = 0.f;
#pragma unroll
                for (int bj = 0; bj < 2; ++bj) {
                    const int row = u.pm * 256 + ai * 128 + wr * 64 + m * 16 + fr;
                    const size_t off = (size_t)row * 1024 + u.pn * 256 + bj * 128 + wc * 32 + 8 * fq;
                    const f32x4 o0 = b0[m][bj] + acc[ai][bj][m][0], o1 = b1[m][bj] + acc[ai][bj][m][1];
                    *(f32x4*)(out + off) = o0; *(f32x4*)(out + off + 4) = o1;
                    if (xg) {
                        sq += (o0[0] * o0[0] + o0[1] * o0[1]) + (o0[2] * o0[2] + o0[3] * o0[3]) + (o1[0] * o1[0] + o1[1] * o1[1]) + (o1[2] * o1[2] + o1[3] * o1[3]);
                        float xv[8] = {o0[0] * gq[bj][0], o0[1] * gq[bj][1], o0[2] * gq[bj][2], o0[3] * gq[bj][3], o1[0] * gq[bj][4], o1[1] * gq[bj][5], o1[2] * gq[bj][6], o1[3] * gq[bj][7]};
                        *(u32x4*)(xg + off) = pack8(xv);
                    }
                }
                sqv[ai * 4 + m] = sq;
            }
        }
        if (xg) {
#pragma unroll
            for (int q = 0; q < 8; ++q) { sqv[q] += __shfl_xor(sqv[q], 16); sqv[q] += __shfl_xor(sqv[q], 32); }
            if (fq == 0) {
#pragma unroll
                for (int q = 0; q < 8; ++q) {
                    __attribute__((address_space(1))) float* ap = (__attribute__((address_space(1))) float*)(ssq + (u.pm * 256 + (q >> 2) * 128 + wr * 64 + (q & 3) * 16 + fr));
                    (void)__hip_atomic_fetch_add(ap, sqv[q], __ATOMIC_RELAXED, __HIP_MEMORY_SCOPE_AGENT);
                }
            }
        }
    }
};
struct EpiGU {
    bf16_t* act; const float* ssq;
    __device__ __forceinline__ void operator()(const f32x4 (&acc)[2][2][4][2], const GUnit& u, int wr, int wc, int fr, int fq) const {
        asm volatile("" : "+v"(fr), "+v"(fq));
#pragma unroll
        for (int ai = 0; ai < 2; ++ai)
#pragma unroll
            for (int m = 0; m < 4; ++m) {
                const int row = u.pm * 256 + ai * 128 + wr * 64 + m * 16 + fr; const int col = u.pn * 128 + wc * 32 + 8 * fq;
                const float rs = 1.0f / sqrtf(ssq[row] * (1.0f / 1024.0f) + 1e-6f);
                const f32x4 g0 = acc[ai][0][m][0] * rs, g1 = acc[ai][0][m][1] * rs, u0 = acc[ai][1][m][0] * rs, u1 = acc[ai][1][m][1] * rs;
                float v[8];
#pragma unroll
                for (int j = 0; j < 4; ++j) { v[j] = g0[j] * sigmoidf_(g0[j]) * u0[j]; v[4 + j] = g1[j] * sigmoidf_(g1[j]) * u1[j]; }
                *(u32x4*)(act + (size_t)row * DFF + col) = pack8(v);
            }
    }
};
}

__device__ __forceinline__ float wave_sum(float v) {
#pragma unroll
    for (int o = 1; o < 64; o <<= 1) v += __shfl_xor(v, o);
    return v;
}
__device__ __forceinline__ void transpose_item(const float* W, int ldw, int k0, int n0, bf16_t* WT, int drow0, int ldd, int dk0, LAS float* scr, int lane) {
#pragma unroll 8
    for (int i = 0; i < 32; ++i) { const int kk = 2 * i + (lane >> 5); scr[kk * 33 + (lane & 31)] = W[(size_t)(k0 + kk) * ldw + n0 + (lane & 31)]; }
    asm volatile("s_waitcnt lgkmcnt(0)" ::: "memory");
    const int c = lane & 7;
#pragma unroll
    for (int j = 0; j < 4; ++j) { const int n = (lane >> 3) + 8 * j; const LAS float* s = scr + (8 * c) * 33 + n;
        u32x4 o; o.x = cvt_pk_bf16(s[0 * 33], s[1 * 33]); o.y = cvt_pk_bf16(s[2 * 33], s[3 * 33]); o.z = cvt_pk_bf16(s[4 * 33], s[5 * 33]); o.w = cvt_pk_bf16(s[6 * 33], s[7 * 33]);
        *(u32x4*)(WT + (size_t)(drow0 + n) * ldd + dk0 + k0 + 8 * c) = o; }
    asm volatile("s_waitcnt lgkmcnt(0)" ::: "memory");
}

__device__ __forceinline__ void prologue_phase(const Params& p, LAS unsigned char* lds, const int wv) {
    const int tid = tid_(wv), lane = tid & 63, wave = __builtin_amdgcn_readfirstlane(tid >> 6);
    const int G = gridDim.x; const int gw = bid_() * 8 + wave, NGW = G * 8;
    LAS float* scr = (LAS float*)(lds + wave * 8448);
    bf16_t* Wb = (bf16_t*)(KWS + WS_W);
    constexpr int PER_LAYER = 4352 + 16 + 16 + 32 + 256 * 3 + 512 + 1408 * 3;
    for (int it = gw; it < NL * PER_LAYER; it += NGW) {
        const int l = it / PER_LAYER; int r = it % PER_LAYER;
        bf16_t* wl = Wb + (size_t)l * LW_ELEMS;
        const float* src; int K, N, ldd, dk0 = 0, mode = 0; bf16_t* dst; int rowoff = 0;
        if (r < 4352) { src = (const float*)karg(3) + (size_t)l * 1024 * INC; K = 1024; N = INC; dst = wl + OW_IN; ldd = 1024; }
        else if ((r -= 4352) < 16) { src = (const float*)karg(5) + (size_t)l * 64 * 512; K = 64; N = 512; dst = wl + OW_LORA; ldd = 256; }
        else if ((r -= 16) < 16) { src = (const float*)karg(7) + (size_t)l * 64 * 512; K = 64; N = 512; dst = wl + OW_LORA; ldd = 256; rowoff = 512; dk0 = 64; }
        else if ((r -= 16) < 32) { src = (const float*)karg(9) + (size_t)l * 128 * 512; K = 128; N = 512; dst = wl + OW_LORA; ldd = 256; rowoff = 1024; dk0 = 128; }
        else if ((r -= 32) < 256) { src = (const float*)karg(15) + (size_t)l * 512 * 1024; K = 512; N = 1024; dst = wl + OW_BR; ldd = 512; }
        else if ((r -= 256) < 256) { src = (const float*)karg(20) + (size_t)l * 512 * 1024; K = 512; N = 1024; dst = wl + OW_BR + 2 * 524288; ldd = 512; }
        else if ((r -= 256) < 256) { src = (const float*)karg(24) + (size_t)l * 512 * 1024; K = 512; N = 1024; dst = wl + OW_BR + 3 * 524288; ldd = 512; }
        else if ((r -= 256) < 512) { src = (const float*)karg(25) + (size_t)l * 1024 * 1024; K = 1024; N = 1024; dst = wl + OW_O; ldd = 1024; }
        else if ((r -= 512) < 1408) { src = (const float*)karg(27) + (size_t)l * 1024 * DFF; K = 1024; N = DFF; dst = wl + OW_GU; ldd = 1024; mode = 1; }
        else if ((r -= 1408) < 1408) { src = (const float*)karg(28) + (size_t)l * 1024 * DFF; K = 1024; N = DFF; dst = wl + OW_GU; ldd = 1024; mode = 2; }
        else { r -= 1408; src = (const float*)karg(29) + (size_t)l * DFF * 1024; K = DFF; N = 1024; dst = wl + OW_D; ldd = DFF; }
        const int nblk = N / 32, kb = r / nblk, nb = r % nblk, n0 = nb * 32;
        int drow0 = rowoff + n0;
        if (mode) drow0 = (n0 >> 7) * 256 + (n0 & 127) + (mode == 2 ? 128 : 0);
        transpose_item(src, N, kb * 64, n0, dst, drow0, ldd, dk0, scr, lane);
    }
    const int gt = bid_() * NTHR + tid, NGT = G * NTHR;
    for (int idx = gt; idx < 3 * MTOK; idx += NGT) ((float*)(KWS + WS_SSQ))[idx] = 0.f;
    for (int idx = gt; idx < NL * 1536 * 32; idx += NGT) {
        const int l = idx / (1536 * 32), r = idx % (1536 * 32), row = r >> 5, kc = (r & 31) * 8;
        const bool diag = row < 512 ? (kc < 64) : row < 1024 ? (kc >= 64 && kc < 128) : (kc >= 128);
        if (!diag) *(u32x4*)(Wb + (size_t)l * LW_ELEMS + OW_LORA + (size_t)row * 256 + kc) = (u32x4){0u, 0u, 0u, 0u};
    }
    for (int idx = gt; idx < NL * 1024 * 64; idx += NGT) {
        const int l = idx >> 16, r = idx & 65535, n = r & 1023, k0 = (r >> 10) * 8, g = k0 >> 7;
        const float* pw = (const float*)karg(16) + (size_t)l * 65536 + (size_t)g * 16384 + (size_t)(k0 & 127) * 128;
        const float* sc = (const float*)karg(17) + l * 512 + g * 128;
        const float* wo = (const float*)karg(18) + (size_t)l * 512 * 1024 + (size_t)g * 128 * 1024 + n;
        float a[8] = {0.f, 0.f, 0.f, 0.f, 0.f, 0.f, 0.f, 0.f};
        for (int j = 0; j < 128; ++j) { const float w = sc[j] * wo[(size_t)j * 1024];
#pragma unroll
            for (int i = 0; i < 8; ++i) a[i] += pw[i * 128 + j] * w; }
        *(u32x4*)(Wb + (size_t)l * LW_ELEMS + OW_BR + 524288 + (size_t)n * 512 + k0) = pack8(a);
    }
    _Float16* rope = (_Float16*)(KWS + WS_ROPE);
    const int* pos = (const int*)karg(1);
    for (int idx = gt; idx < MTOK * 32; idx += NGT) {
        const int m = idx >> 5, i = idx & 31;
        const float inv = powf(10000.0f, -(float)i * 2.0f / 64.0f);
        const float ang = (float)pos[m] * inv;
        rope[(size_t)m * 64 + i] = (_Float16)cosf(ang); rope[(size_t)m * 64 + 32 + i] = (_Float16)sinf(ang);
    }
}

__device__ __forceinline__ void norm_phase(const float* x, const float* g, bf16_t* out, const int wv) {
    const int tid = tid_(wv), lane = tid & 63, wave = tid >> 6;
    f32x4 gv[4];
#pragma unroll
    for (int j = 0; j < 4; ++j) gv[j] = *((const f32x4*)g + lane + 64 * j);
    for (int m = bid_() * 8 + wave; m < MTOK; m += gridDim.x * 8) {
        const f32x4* xr = (const f32x4*)(x + (size_t)m * DM) + lane;
        f32x4 v[4]; float s = 0.f;
#pragma unroll
        for (int j = 0; j < 4; ++j) { v[j] = xr[64 * j]; s += (v[j].x * v[j].x + v[j].y * v[j].y) + (v[j].z * v[j].z + v[j].w * v[j].w); }
        const float rstd = 1.0f / sqrtf(wave_sum(s) * (1.0f / DM) + 1e-6f);
        u32x2* o = (u32x2*)(out + (size_t)m * DM) + lane;
#pragma unroll
        for (int j = 0; j < 4; ++j) { u32x2 w; w.x = cvt_pk_bf16(v[j].x * rstd * gv[j].x, v[j].y * rstd * gv[j].y); w.y = cvt_pk_bf16(v[j].z * rstd * gv[j].z, v[j].w * rstd * gv[j].w); o[64 * j] = w; }
    }
}

typedef _Float16 h16x8 __attribute__((ext_vector_type(8)));
__device__ __forceinline__ u32x4 qk_prep(const u32x4 raw, const float* g, const u32x4 cs8, const u32x4 sn8, int c, float scale) {
    float x[8]; unpack8(raw, x);
    float ss = 0.f;
#pragma unroll
    for (int j = 0; j < 8; ++j) ss += x[j] * x[j];
    ss = dpp_sum8(ss);
    const float rstd = 1.0f / sqrtf(ss * (1.0f / 64.0f) + 1e-6f);
    float gg[8]; ld8f(g + c * 8, gg);
    const h16x8 ch = __builtin_bit_cast(h16x8, cs8), sh = __builtin_bit_cast(h16x8, sn8);
    float o[8];
#pragma unroll
    for (int j = 0; j < 8; ++j) {
        const float y = x[j] * rstd * gg[j];
        const float pr = __shfl_xor(y, 4);
        const float cs = (float)ch[j], sn = (float)sh[j];
        o[j] = (c < 4 ? y * cs - pr * sn : y * cs + pr * sn) * scale;
    }
    return pack8(o);
}

__device__ __forceinline__ void attn_item(const Params& p, int l, int item, LAS unsigned char* lds, const int wv) {
    const int tid = tid_(wv), lane = tid & 63, wave = __builtin_amdgcn_readfirstlane(tid >> 6), fr = lane & 15, fq = lane >> 4;
    const int b = item >> 6, kvh = (item >> 5) & 1, nbk = item & 31;
    const int tok0 = b * SEQ + nbk * 128;
    const bf16_t* PATT = (const bf16_t*)(KWS + WS_PATT);
    bf16_t* M3 = (bf16_t*)(KWS + WS_M3);
    const _Float16* rope = (const _Float16*)(KWS + WS_ROPE);
    const float* qg = (const float*)karg(21) + l * 64; const float* kg = (const float*)karg(22) + l * 64;
    LAS bf16_t* Ks = (LAS bf16_t*)lds;
    LAS bf16_t* Vt = (LAS bf16_t*)(lds + 36864);
    LAS bf16_t* Qs = (LAS bf16_t*)(lds + 70656);
    const int c = tid & 7;
    const int ci = (c & 3) * 8;
    {
        u32x4 kraw[4], vraw[4], kcs[4], ksn[4];
#pragma unroll
        for (int pass = 0; pass < 4; ++pass) {
            const int row = pass * 64 + (tid >> 3); const int tokk = tok0 - 128 + row; const bool valid = (nbk > 0) || (row >= 128);
            const int tk = valid ? tokk : tok0;
            kraw[pass] = ld16(PATT + (size_t)tk * 768 + 512 + kvh * 64 + c * 8); vraw[pass] = ld16(PATT + (size_t)tk * 768 + 640 + kvh * 64 + c * 8);
            kcs[pass] = *(const u32x4*)(rope + (size_t)tk * 64 + ci); ksn[pass] = *(const u32x4*)(rope + (size_t)tk * 64 + 32 + ci);
            if (!valid) { kraw[pass] = (u32x4){0u, 0u, 0u, 0u}; vraw[pass] = kraw[pass]; }
        }
#pragma unroll
        for (int pass = 0; pass < 4; ++pass) {
            const int row = pass * 64 + (tid >> 3);
            *(LAS u32x4*)(Ks + row * 72 + c * 8) = qk_prep(kraw[pass], kg, kcs[pass], ksn[pass], c, 1.0f);
            LAS bf16_t* vp = Vt + (c * 8) * 264 + row; const u32x4 vr = vraw[pass];
            vp[0 * 264] = (bf16_t)(vr.x & 0xffffu); vp[1 * 264] = (bf16_t)(vr.x >> 16); vp[2 * 264] = (bf16_t)(vr.y & 0xffffu); vp[3 * 264] = (bf16_t)(vr.y >> 16);
            vp[4 * 264] = (bf16_t)(vr.z & 0xffffu); vp[5 * 264] = (bf16_t)(vr.z >> 16); vp[6 * 264] = (bf16_t)(vr.w & 0xffffu); vp[7 * 264] = (bf16_t)(vr.w >> 16);
        }
    }
#pragma unroll 1
    for (int ph2 = 0; ph2 < 2; ++ph2) {
        u32x4 qraw[4], qcs[4], qsn[4];
#pragma unroll
        for (int i = 0; i < 4; ++i) {
            const int row = (ph2 * 4 + i) * 64 + (tid >> 3); const int g = row >> 7, ql = row & 127; const int tokq = tok0 + ql; const int hq = kvh * 4 + g;
            qraw[i] = ld16(PATT + (size_t)tokq * 768 + hq * 64 + c * 8);
            qcs[i] = *(const u32x4*)(rope + (size_t)tokq * 64 + ci); qsn[i] = *(const u32x4*)(rope + (size_t)tokq * 64 + 32 + ci);
        }
#pragma unroll
        for (int i = 0; i < 4; ++i) {
            const int row = (ph2 * 4 + i) * 64 + (tid >> 3);
            *(LAS u32x4*)(Qs + row * 72 + c * 8) = qk_prep(qraw[i], qg, qcs[i], qsn[i], c, 0.125f);
        }
    }
    __syncthreads();
    const int g = wave >> 1; const int hq = kvh * 4 + g;
    const float sink = ((const float*)karg(23))[l * 8 + hq];
#pragma unroll 1
    for (int pp = 0; pp < 2; ++pp) {
        const int ql0 = (wave & 1) * 64 + pp * 32;
        f32x4 sacc[10][2];
#pragma unroll
        for (int n = 0; n < 10; ++n) { sacc[n][0] = (f32x4){0.f, 0.f, 0.f, 0.f}; sacc[n][1] = sacc[n][0]; }
#pragma unroll
        for (int kk2 = 0; kk2 < 2; ++kk2) {
            const bf16x8 q0 = *(const LAS bf16x8*)(Qs + (g * 128 + ql0 + fr) * 72 + 32 * kk2 + 8 * fq);
            const bf16x8 q1 = *(const LAS bf16x8*)(Qs + (g * 128 + ql0 + 16 + fr) * 72 + 32 * kk2 + 8 * fq);
#pragma unroll
            for (int n = 0; n < 10; ++n) {
                const bf16x8 kf = *(const LAS bf16x8*)(Ks + (ql0 + 16 * n + fr) * 72 + 32 * kk2 + 8 * fq);
                sacc[n][0] = __builtin_amdgcn_mfma_f32_16x16x32_bf16(kf, q0, sacc[n][0], 0, 0, 0);
                sacc[n][1] = __builtin_amdgcn_mfma_f32_16x16x32_bf16(kf, q1, sacc[n][1], 0, 0, 0);
            }
        }
        u32x2 pb[10][2];
#pragma unroll
        for (int mq = 0; mq < 2; ++mq) {
            const int qi = 128 + ql0 + 16 * mq + fr;
            float mx = -__builtin_inff();
#pragma unroll
            for (int n = 0; n < 10; ++n)
#pragma unroll
                for (int j = 0; j < 4; ++j) {
                    const int kj = ql0 + 16 * n + 4 * fq + j; const int dist = qi - kj;
                    const bool ok = (dist >= 0) && (dist < 128) && ((nbk > 0) || (kj >= 128));
                    const float s = ok ? sacc[n][mq][j] : -__builtin_inff();
                    sacc[n][mq][j] = s; mx = fmaxf(mx, s);
                }
            mx = fmaxf(mx, __shfl_xor(mx, 16)); mx = fmaxf(mx, __shfl_xor(mx, 32));
            const float mf = fmaxf(mx, sink);
            float sum = 0.f;
#pragma unroll
            for (int n = 0; n < 10; ++n)
#pragma unroll
                for (int j = 0; j < 4; ++j) { const float e = __expf(sacc[n][mq][j] - mf); sacc[n][mq][j] = e; sum += e; }
            sum += __shfl_xor(sum, 16); sum += __shfl_xor(sum, 32);
            const float inv = 1.0f / (sum + __expf(sink - mf));
#pragma unroll
            for (int n = 0; n < 10; ++n) { pb[n][mq].x = cvt_pk_bf16(sacc[n][mq][0] * inv, sacc[n][mq][1] * inv); pb[n][mq].y = cvt_pk_bf16(sacc[n][mq][2] * inv, sacc[n][mq][3] * inv); }
        }
        f32x4 oacc[4][2];
#pragma unroll
        for (int dt = 0; dt < 4; ++dt) { oacc[dt][0] = (f32x4){0.f, 0.f, 0.f, 0.f}; oacc[dt][1] = oacc[dt][0]; }
#pragma unroll
        for (int kc = 0; kc < 5; ++kc) {
            const u32x4 p0 = (u32x4){pb[2 * kc][0].x, pb[2 * kc][0].y, pb[2 * kc + 1][0].x, pb[2 * kc + 1][0].y};
            const u32x4 p1 = (u32x4){pb[2 * kc][1].x, pb[2 * kc][1].y, pb[2 * kc + 1][1].x, pb[2 * kc + 1][1].y};
#pragma unroll
            for (int dt = 0; dt < 4; ++dt) {
                const LAS bf16_t* vrow = Vt + (16 * dt + fr) * 264 + ql0 + 32 * kc + 4 * fq;
                const u32x2 va = *(const LAS u32x2*)vrow, vb = *(const LAS u32x2*)(vrow + 16);
                const u32x4 vv = (u32x4){va.x, va.y, vb.x, vb.y};
                oacc[dt][0] = __builtin_amdgcn_mfma_f32_16x16x32_bf16(__builtin_bit_cast(bf16x8, vv), __builtin_bit_cast(bf16x8, p0), oacc[dt][0], 0, 0, 0);
                oacc[dt][1] = __builtin_amdgcn_mfma_f32_16x16x32_bf16(__builtin_bit_cast(bf16x8, vv), __builtin_bit_cast(bf16x8, p1), oacc[dt][1], 0, 0, 0);
            }
        }
#pragma unroll
        for (int mq = 0; mq < 2; ++mq)
#pragma unroll
            for (int dt = 0; dt < 4; ++dt) {
                const int ql = ql0 + 16 * mq + fr;
                u32x2 w; w.x = cvt_pk_bf16(oacc[dt][mq][0], oacc[dt][mq][1]); w.y = cvt_pk_bf16(oacc[dt][mq][2], oacc[dt][mq][3]);
                *(u32x2*)(M3 + (size_t)(tok0 + ql) * 1536 + 1024 + hq * 64 + 16 * dt + 4 * fq) = w;
            }
    }
    __syncthreads();
}

__device__ __forceinline__ void mix1_phase(const Params& p, int l, LAS unsigned char* lds, const int wv) {
    const int tid = tid_(wv), G = gridDim.x;
    for (int item = bid_(); item < 1024; item += G) attn_item(p, l, item, lds, wv);
    const int gt = bid_() * NTHR + tid, NGT = G * NTHR;
    const bf16_t* PRW = (const bf16_t*)(KWS + WS_PRW); const bf16_t* PPOOL = (const bf16_t*)(KWS + WS_PPOOL); const bf16_t* PCONV = (const bf16_t*)(KWS + WS_PCONV);
    bf16_t* M3 = (bf16_t*)(KWS + WS_M3); bf16_t* AL = (bf16_t*)(KWS + WS_ALORA);
    const float* mu = (const float*)karg(4) + l * RWC;
    for (int idx = gt; idx < (MTOK / 32) * 32; idx += NGT) {
        const int run = idx >> 5, c8 = (idx & 31) * 8, m0 = run * 32, t0 = m0 & (SEQ - 1);
        float mm[8], prv[8];
        ld8f(mu + 1536 + c8, mm);
        if (t0 > 0) unpack8(ld16(PRW + (size_t)(m0 - 1) * RWC + 1536 + c8), prv); else { _Pragma("unroll") for (int j = 0; j < 8; ++j) prv[j] = 0.f; }
#pragma unroll 1
        for (int tb = 0; tb < 32; tb += 8) {
            u32x4 raw[8];
#pragma unroll
            for (int i = 0; i < 8; ++i) raw[i] = ld16(PRW + (size_t)(m0 + tb + i) * RWC + 1536 + c8);
#pragma unroll
            for (int i = 0; i < 8; ++i) {
                float cur[8], o[8]; unpack8(raw[i], cur);
#pragma unroll
                for (int j = 0; j < 8; ++j) { const float sft = cur[j] + (prv[j] - cur[j]) * mm[j];
                    o[j] = c8 < 64 ? (1.0f - 2.0f / (__expf(2.0f * sft) + 1.0f)) : (c8 < 128 ? sft : sigmoidf_(sft)); prv[j] = cur[j]; }
                *(u32x4*)(AL + (size_t)(m0 + tb + i) * 256 + c8) = pack8(o);
            }
        }
    }
    const float* cw = (const float*)karg(19) + l * 3 * 512;
    for (int idx = gt; idx < (MTOK / 32) * 64; idx += NGT) {
        const int run = idx >> 6, c8 = (idx & 63) * 8, m0 = run * 32, t0 = m0 & (SEQ - 1);
        float w0[8], w1[8], w2[8], p2[8], p1[8];
        ld8f(cw + c8, w0); ld8f(cw + 512 + c8, w1); ld8f(cw + 1024 + c8, w2);
        if (t0 > 0) { float a[8], bq[8]; unpack8(ld16(PCONV + (size_t)(m0 - 2) * 1536 + 512 + c8), a); unpack8(ld16(PCONV + (size_t)(m0 - 2) * 1536 + 1024 + c8), bq);
#pragma unroll
            for (int j = 0; j < 8; ++j) p2[j] = a[j] * bq[j];
            unpack8(ld16(PCONV + (size_t)(m0 - 1) * 1536 + 512 + c8), a); unpack8(ld16(PCONV + (size_t)(m0 - 1) * 1536 + 1024 + c8), bq);
#pragma unroll
            for (int j = 0; j < 8; ++j) p1[j] = a[j] * bq[j]; }
        else { _Pragma("unroll") for (int j = 0; j < 8; ++j) { p2[j] = 0.f; p1[j] = 0.f; } }
#pragma unroll 1
        for (int tb = 0; tb < 32; tb += 4) {
            u32x4 rb[4], rc[4], ru[4];
#pragma unroll
            for (int i = 0; i < 4; ++i) { const bf16_t* q = PCONV + (size_t)(m0 + tb + i) * 1536 + c8; rb[i] = ld16(q); rc[i] = ld16(q + 512); ru[i] = ld16(q + 1024); }
#pragma unroll
            for (int i = 0; i < 4; ++i) {
                float bg[8], cc[8], uu[8], o[8]; unpack8(rb[i], bg); unpack8(rc[i], cc); unpack8(ru[i], uu);
#pragma unroll
                for (int j = 0; j < 8; ++j) { const float p0 = cc[j] * uu[j]; o[j] = bg[j] * (w0[j] * p2[j] + w1[j] * p1[j] + w2[j] * p0); p2[j] = p1[j]; p1[j] = p0; }
                *(u32x4*)(M3 + (size_t)(m0 + tb + i) * 1536 + 512 + c8) = pack8(o);
            }
        }
    }
    for (int idx = gt; idx < (MTOK / 32) * 64; idx += NGT) {
        const int run = idx >> 6, c8 = (idx & 63) * 8, m0 = run * 32, t0 = m0 & (SEQ - 1);
        const int win = 2 << (c8 >> 7);
        float sw[8];
#pragma unroll
        for (int j = 0; j < 8; ++j) sw[j] = 0.f;
        if (t0 > 0) { for (int d = 1; d < win; ++d) { float uu[8]; unpack8(ld16(PPOOL + (size_t)(m0 - d) * 512 + c8), uu);
#pragma unroll
                for (int j = 0; j < 8; ++j) sw[j] += uu[j]; } }
#pragma unroll 1
        for (int tb = 0; tb < 32; tb += 8) {
            u32x4 rn[8], ro[8];
#pragma unroll
            for (int i = 0; i < 8; ++i) { const int m = m0 + tb + i; rn[i] = ld16(PPOOL + (size_t)m * 512 + c8);
                const bool has = (t0 + tb + i - win + 1) >= 0;
                ro[i] = has ? ld16(PPOOL + (size_t)(m - win + 1) * 512 + c8) : (u32x4){0u, 0u, 0u, 0u}; }
#pragma unroll
            for (int i = 0; i < 8; ++i) {
                float un[8], uo[8], o[8]; unpack8(rn[i], un); unpack8(ro[i], uo);
                const int t = t0 + tb + i; const float ic = 1.0f / (float)(t + 1 < win ? t + 1 : win);
#pragma unroll
                for (int j = 0; j < 8; ++j) { const float full = sw[j] + un[j]; o[j] = full * ic - un[j]; sw[j] = full - uo[j]; }
                *(u32x4*)(M3 + (size_t)(m0 + tb + i) * 1536 + c8) = pack8(o);
            }
        }
    }
}

constexpr int TC = 32, NCH = SEQ / TC, SROW = 352;
__device__ __forceinline__ float dpp_sum16(float v) {
    v += __builtin_bit_cast(float, __builtin_amdgcn_mov_dpp(__builtin_bit_cast(int, v), 0xB1, 0xF, 0xF, true));
    v += __builtin_bit_cast(float, __builtin_amdgcn_mov_dpp(__builtin_bit_cast(int, v), 0x4E, 0xF, 0xF, true));
    v += __builtin_bit_cast(float, __builtin_amdgcn_mov_dpp(__builtin_bit_cast(int, v), 0x141, 0xF, 0xF, true));
    v += __builtin_bit_cast(float, __builtin_amdgcn_mov_dpp(__builtin_bit_cast(int, v), 0x140, 0xF, 0xF, true));
    return v;
}
__device__ __forceinline__ void scan_phase(const Params& p, int l, LAS unsigned char* lds, const int wv) {
    const int tid = tid_(wv), lane = tid & 63, wave = __builtin_amdgcn_readfirstlane(tid >> 6);
    const bf16_t* PRW = (const bf16_t*)(KWS + WS_PRW); const bf16_t* LORA = (const bf16_t*)(KWS + WS_LORA);
    bf16_t* YRAW = (bf16_t*)(KWS + WS_YRAW); float* BONUS = (float*)(KWS + WS_BONUS);
    LAS float* inb = (LAS float*)lds;
    LAS float* yb = inb + 2 * TC * SROW;
    for (int item = bid_(); item < 256; item += gridDim.x) {
        const int chain = item >> 1, half = item & 1, b = chain >> 3, head = chain & 7;
        const int pt = tid - 256, t_l = (pt >> 3) & 31, cgi = pt & 7, c0 = cgi * 8, ch = head * 64 + c0;
        const float* mu = (const float*)karg(4) + l * RWC + ch; const float* ckk = (const float*)karg(10) + l * 512 + ch; const float* cka = (const float*)karg(11) + l * 512 + ch; const float* crk = (const float*)karg(12) + l * 512 + ch;
        u32x4 raw[8], rawb[8];
        const bf16_t* prw0 = PRW + ((size_t)b * SEQ + t_l) * RWC + ch; const bf16_t* lor0 = LORA + ((size_t)b * SEQ + t_l) * 1536 + ch;
#define SCAN_LOAD(dst, n_) do { const bf16_t* q_ = prw0 + (size_t)(n_) * TC * RWC; const bf16_t* lq_ = lor0 + (size_t)(n_) * TC * 1536; \
            dst[0] = ld16(q_); dst[1] = ld16(q_ + 512); dst[2] = ld16(q_ + 1024); \
            if ((n_) * TC + t_l > 0) { dst[3] = ld16(q_ - RWC); dst[4] = ld16(q_ - RWC + 512); dst[5] = ld16(q_ - RWC + 1024); } \
            else { dst[3] = (u32x4){0u, 0u, 0u, 0u}; dst[4] = dst[3]; dst[5] = dst[3]; } \
            dst[6] = ld16(lq_); dst[7] = ld16(lq_ + 512); } while (0)
        if (wave >= 4) {
            SCAN_LOAD(raw, 0);
        }
        const int seg = lane & 15, rg = lane >> 4, rr0 = (wave & 3) * 8 + rg * 2;
        f32x2 Sa0 = (f32x2){0.f, 0.f}, Sa1 = Sa0, Sb0 = Sa0, Sb1 = Sa0;
#pragma unroll 1
        for (int n2 = 0; n2 <= NCH + 1; n2 += 2) {
        { const int n = n2;
            if (wave >= 4) {
                if (n >= 2) {
                    const LAS float* ys = yb + (n & 1) * TC * 32 + t_l * 32 + cgi * 4;
                    const f32x4 yv = *(const LAS f32x4*)ys;
                    u32x2 w; w.x = cvt_pk_bf16(yv[0], yv[1]); w.y = cvt_pk_bf16(yv[2], yv[3]);
                    *(u32x2*)(YRAW + (size_t)(b * SEQ + (n - 2) * TC + t_l) * 512 + head * 64 + half * 32 + cgi * 4) = w;
                }
                if (n < NCH) {
                    if (n + 1 < NCH) SCAN_LOAD(rawb, n + 1);
                    const size_t m = (size_t)b * SEQ + n * TC + t_l;
                    float mur[8], muk[8], muv[8], kkc[8], kac[8], rkc[8];
                    ld8f(mu, mur); ld8f(mu + 512, muk); ld8f(mu + 1024, muv); ld8f(ckk, kkc); ld8f(cka, kac); ld8f(crk, rkc);
                    float r[8], k[8], v[8], rp[8], kp[8], vp[8], sl[8], al[8];
                    unpack8(raw[0], r); unpack8(raw[1], k); unpack8(raw[2], v); unpack8(raw[3], rp); unpack8(raw[4], kp); unpack8(raw[5], vp); unpack8(raw[6], sl); unpack8(raw[7], al);
                    float kkr[8], ss = 0.f, bon = 0.f, dec[8], kpr[8];
#pragma unroll
                    for (int j = 0; j < 8; ++j) {
                        r[j] = r[j] + (rp[j] - r[j]) * mur[j]; k[j] = k[j] + (kp[j] - k[j]) * muk[j]; v[j] = v[j] + (vp[j] - v[j]) * muv[j];
                        dec[j] = __expf(-0.6065306597126334f * sl[j]);
                        kkr[j] = k[j] * kkc[j]; ss += kkr[j] * kkr[j];
                        kpr[j] = k[j] * (1.0f + (al[j] - 1.0f) * kac[j]);
                        bon += r[j] * kpr[j] * rkc[j];
                    }
                    ss = dpp_sum8(ss); bon = dpp_sum8(bon);
                    const float inrm = 1.0f / fmaxf(sqrtf(ss), 1e-12f);
                    LAS float* dst = inb + (n & 1) * TC * SROW + t_l * SROW + c0;
                    f32x4 w0, w1;
                    w0 = (f32x4){kkr[0] * inrm, kkr[1] * inrm, kkr[2] * inrm, kkr[3] * inrm}; w1 = (f32x4){kkr[4] * inrm, kkr[5] * inrm, kkr[6] * inrm, kkr[7] * inrm};
                    *(LAS f32x4*)(dst) = w0; *(LAS f32x4*)(dst + 4) = w1;
                    *(LAS f32x4*)(dst + 192) = (f32x4){w0[0] * al[0], w0[1] * al[1], w0[2] * al[2], w0[3] * al[3]}; *(LAS f32x4*)(dst + 196) = (f32x4){w1[0] * al[4], w1[1] * al[5], w1[2] * al[6], w1[3] * al[7]};
                    *(LAS f32x4*)(dst + 64) = (f32x4){dec[0], dec[1], dec[2], dec[3]}; *(LAS f32x4*)(dst + 68) = (f32x4){dec[4], dec[5], dec[6], dec[7]};
                    *(LAS f32x4*)(dst + 128) = (f32x4){kpr[0], kpr[1], kpr[2], kpr[3]}; *(LAS f32x4*)(dst + 132) = (f32x4){kpr[4], kpr[5], kpr[6], kpr[7]};
                    *(LAS f32x4*)(dst + 256) = (f32x4){r[0], r[1], r[2], r[3]}; *(LAS f32x4*)(dst + 260) = (f32x4){r[4], r[5], r[6], r[7]};
                    if ((cgi >> 2) == half) { LAS float* vd = inb + (n & 1) * TC * SROW + t_l * SROW + 320 + (c0 - 32 * half);
                        *(LAS f32x4*)(vd) = (f32x4){v[0], v[1], v[2], v[3]}; *(LAS f32x4*)(vd + 4) = (f32x4){v[4], v[5], v[6], v[7]}; }
                    if (half == 0 && cgi == 0) BONUS[m * 8 + head] = bon;
                }
            } else if (n >= 1 && n <= NCH) {
                const LAS float* src = inb + ((n - 1) & 1) * TC * SROW + seg * 4;
                const LAS float* vsrc = inb + ((n - 1) & 1) * TC * SROW + 320 + rr0;
                LAS float* yd = yb + ((n - 1) & 1) * TC * 32 + rr0;
#define SCAN_RD2(q_, tl_) do { const LAS float* s_ = src + (tl_) * SROW; kkq[q_] = *(const LAS f32x4*)(s_); dcq[q_] = *(const LAS f32x4*)(s_ + 64); kpq[q_] = *(const LAS f32x4*)(s_ + 128); \
                    bvq[q_] = *(const LAS f32x4*)(s_ + 192); rvq[q_] = *(const LAS f32x4*)(s_ + 256); vvq[q_] = *(const LAS f32x2*)(vsrc + (tl_) * SROW); } while (0)
                f32x4 kkq[4], dcq[4], kpq[4], bvq[4], rvq[4]; f32x2 vvq[4];
                SCAN_RD2(0, 0); SCAN_RD2(1, 1);
#pragma unroll 1
                for (int tl4 = 0; tl4 < TC; tl4 += 4) {
                    float yA[4], yB[4];
#pragma unroll
                    for (int u = 0; u < 4; ++u) {
                        { const int tn = tl4 + u + 2 < TC ? tl4 + u + 2 : TC - 1; SCAN_RD2((u + 2) & 3, tn); }
                        const f32x4 kk = kkq[u], dc = dcq[u], kp = kpq[u], bv = bvq[u], rv = rvq[u]; const f32x2 vv = vvq[u];
                        const f32x2 kk0 = (f32x2){kk[0], kk[1]}, kk1 = (f32x2){kk[2], kk[3]};
                        const f32x2 kp0 = (f32x2){kp[0], kp[1]}, kp1 = (f32x2){kp[2], kp[3]}, bv0 = (f32x2){bv[0], bv[1]}, bv1 = (f32x2){bv[2], bv[3]};
                        const f32x2 dc0 = (f32x2){dc[0], dc[1]}, dc1 = (f32x2){dc[2], dc[3]};
                        const f32x2 r0 = (f32x2){rv[0], rv[1]}, r1 = (f32x2){rv[2], rv[3]};
                        const f32x2 va = (f32x2){vv.x, vv.x}, vb = (f32x2){vv.y, vv.y};
                        f32x2 da = Sa0 * kk0; da += Sa1 * kk1; f32x2 db = Sb0 * kk0; db += Sb1 * kk1;
                        const float saa = dpp_sum16(da.x + da.y), sab = dpp_sum16(db.x + db.y);
                        const f32x2 na = (f32x2){-saa, -saa}, nb = (f32x2){-sab, -sab};
                        Sa0 = Sa0 * dc0 + (va * kp0 + na * bv0); Sa1 = Sa1 * dc1 + (va * kp1 + na * bv1);
                        Sb0 = Sb0 * dc0 + (vb * kp0 + nb * bv0); Sb1 = Sb1 * dc1 + (vb * kp1 + nb * bv1);
                        f32x2 ya = Sa0 * r0; ya += Sa1 * r1; f32x2 yb2 = Sb0 * r0; yb2 += Sb1 * r1;
                        yA[u] = dpp_sum16(ya.x + ya.y); yB[u] = dpp_sum16(yb2.x + yb2.y);
                    }
                    const float y0 = seg == 0 ? yA[0] : seg == 1 ? yA[1] : seg == 2 ? yA[2] : yA[3];
                    const float y1 = seg == 0 ? yB[0] : seg == 1 ? yB[1] : seg == 2 ? yB[2] : yB[3];
                    if (seg < 4) *(LAS f32x2*)(yd + (tl4 + seg) * 32) = (f32x2){y0, y1};
                }
#undef SCAN_RD2
            }
            __syncthreads();
        }
        { const int n = n2 + 1;
            if (wave >= 4) {
                if (n >= 2) {
                    const LAS float* ys = yb + (n & 1) * TC * 32 + t_l * 32 + cgi * 4;
                    const f32x4 yv = *(const LAS f32x4*)ys;
                    u32x2 w; w.x = cvt_pk_bf16(yv[0], yv[1]); w.y = cvt_pk_bf16(yv[2], yv[3]);
                    *(u32x2*)(YRAW + (size_t)(b * SEQ + (n - 2) * TC + t_l) * 512 + head * 64 + half * 32 + cgi * 4) = w;
                }
                if (n < NCH) {
                    if (n + 1 < NCH) SCAN_LOAD(raw, n + 1);
                    const size_t m = (size_t)b * SEQ + n * TC + t_l;
                    float mur[8], muk[8], muv[8], kkc[8], kac[8], rkc[8];
                    ld8f(mu, mur); ld8f(mu + 512, muk); ld8f(mu + 1024, muv); ld8f(ckk, kkc); ld8f(cka, kac); ld8f(crk, rkc);
                    float r[8], k[8], v[8], rp[8], kp[8], vp[8], sl[8], al[8];
                    unpack8(rawb[0], r); unpack8(rawb[1], k); unpack8(rawb[2], v); unpack8(rawb[3], rp); unpack8(rawb[4], kp); unpack8(rawb[5], vp); unpack8(rawb[6], sl); unpack8(rawb[7], al);
                    float kkr[8], ss = 0.f, bon = 0.f, dec[8], kpr[8];
#pragma unroll
                    for (int j = 0; j < 8; ++j) {
                        r[j] = r[j] + (rp[j] - r[j]) * mur[j]; k[j] = k[j] + (kp[j] - k[j]) * muk[j]; v[j] = v[j] + (vp[j] - v[j]) * muv[j];
                        dec[j] = __expf(-0.6065306597126334f * sl[j]);
                        kkr[j] = k[j] * kkc[j]; ss += kkr[j] * kkr[j];
                        kpr[j] = k[j] * (1.0f + (al[j] - 1.0f) * kac[j]);
                        bon += r[j] * kpr[j] * rkc[j];
                    }
                    ss = dpp_sum8(ss); bon = dpp_sum8(bon);
                    const float inrm = 1.0f / fmaxf(sqrtf(ss), 1e-12f);
                    LAS float* dst = inb + (n & 1) * TC * SROW + t_l * SROW + c0;
                    f32x4 w0, w1;
                    w0 = (f32x4){kkr[0] * inrm, kkr[1] * inrm, kkr[2] * inrm, kkr[3] * inrm}; w1 = (f32x4){kkr[4] * inrm, kkr[5] * inrm, kkr[6] * inrm, kkr[7] * inrm};
                    *(LAS f32x4*)(dst) = w0; *(LAS f32x4*)(dst + 4) = w1;
                    *(LAS f32x4*)(dst + 192) = (f32x4){w0[0] * al[0], w0[1] * al[1], w0[2] * al[2], w0[3] * al[3]}; *(LAS f32x4*)(dst + 196) = (f32x4){w1[0] * al[4], w1[1] * al[5], w1[2] * al[6], w1[3] * al[7]};
                    *(LAS f32x4*)(dst + 64) = (f32x4){dec[0], dec[1], dec[2], dec[3]}; *(LAS f32x4*)(dst + 68) = (f32x4){dec[4], dec[5], dec[6], dec[7]};
                    *(LAS f32x4*)(dst + 128) = (f32x4){kpr[0], kpr[1], kpr[2], kpr[3]}; *(LAS f32x4*)(dst + 132) = (f32x4){kpr[4], kpr[5], kpr[6], kpr[7]};
                    *(LAS f32x4*)(dst + 256) = (f32x4){r[0], r[1], r[2], r[3]}; *(LAS f32x4*)(dst + 260) = (f32x4){r[4], r[5], r[6], r[7]};
                    if ((cgi >> 2) == half) { LAS float* vd = inb + (n & 1) * TC * SROW + t_l * SROW + 320 + (c0 - 32 * half);
                        *(LAS f32x4*)(vd) = (f32x4){v[0], v[1], v[2], v[3]}; *(LAS f32x4*)(vd + 4) = (f32x4){v[4], v[5], v[6], v[7]}; }
                    if (half == 0 && cgi == 0) BONUS[m * 8 + head] = bon;
                }
            } else if (n >= 1 && n <= NCH) {
                const LAS float* src = inb + ((n - 1) & 1) * TC * SROW + seg * 4;
                const LAS float* vsrc = inb + ((n - 1) & 1) * TC * SROW + 320 + rr0;
                LAS float* yd = yb + ((n - 1) & 1) * TC * 32 + rr0;
#define SCAN_RD2(q_, tl_) do { const LAS float* s_ = src + (tl_) * SROW; kkq[q_] = *(const LAS f32x4*)(s_); dcq[q_] = *(const LAS f32x4*)(s_ + 64); kpq[q_] = *(const LAS f32x4*)(s_ + 128); \
                    bvq[q_] = *(const LAS f32x4*)(s_ + 192); rvq[q_] = *(const LAS f32x4*)(s_ + 256); vvq[q_] = *(const LAS f32x2*)(vsrc + (tl_) * SROW); } while (0)
                f32x4 kkq[4], dcq[4], kpq[4], bvq[4], rvq[4]; f32x2 vvq[4];
                SCAN_RD2(0, 0); SCAN_RD2(1, 1);
#pragma unroll 1
                for (int tl4 = 0; tl4 < TC; tl4 += 4) {
                    float yA[4], yB[4];
#pragma unroll
                    for (int u = 0; u < 4; ++u) {
                        { const int tn = tl4 + u + 2 < TC ? tl4 + u + 2 : TC - 1; SCAN_RD2((u + 2) & 3, tn); }
                        const f32x4 kk = kkq[u], dc = dcq[u], kp = kpq[u], bv = bvq[u], rv = rvq[u]; const f32x2 vv = vvq[u];
                        const f32x2 kk0 = (f32x2){kk[0], kk[1]}, kk1 = (f32x2){kk[2], kk[3]};
                        const f32x2 kp0 = (f32x2){kp[0], kp[1]}, kp1 = (f32x2){kp[2], kp[3]}, bv0 = (f32x2){bv[0], bv[1]}, bv1 = (f32x2){bv[2], bv[3]};
                        const f32x2 dc0 = (f32x2){dc[0], dc[1]}, dc1 = (f32x2){dc[2], dc[3]};
                        const f32x2 r0 = (f32x2){rv[0], rv[1]}, r1 = (f32x2){rv[2], rv[3]};
                        const f32x2 va = (f32x2){vv.x, vv.x}, vb = (f32x2){vv.y, vv.y};
                        f32x2 da = Sa0 * kk0; da += Sa1 * kk1; f32x2 db = Sb0 * kk0; db += Sb1 * kk1;
                        const float saa = dpp_sum16(da.x + da.y), sab = dpp_sum16(db.x + db.y);
                        const f32x2 na = (f32x2){-saa, -saa}, nb = (f32x2){-sab, -sab};
                        Sa0 = Sa0 * dc0 + (va * kp0 + na * bv0); Sa1 = Sa1 * dc1 + (va * kp1 + na * bv1);
                        Sb0 = Sb0 * dc0 + (vb * kp0 + nb * bv0); Sb1 = Sb1 * dc1 + (vb * kp1 + nb * bv1);
                        f32x2 ya = Sa0 * r0; ya += Sa1 * r1; f32x2 yb2 = Sb0 * r0; yb2 += Sb1 * r1;
                        yA[u] = dpp_sum16(ya.x + ya.y); yB[u] = dpp_sum16(yb2.x + yb2.y);
                    }
                    const float y0 = seg == 0 ? yA[0] : seg == 1 ? yA[1] : seg == 2 ? yA[2] : yA[3];
                    const float y1 = seg == 0 ? yB[0] : seg == 1 ? yB[1] : seg == 2 ? yB[2] : yB[3];
                    if (seg < 4) *(LAS f32x2*)(yd + (tl4 + seg) * 32) = (f32x2){y0, y1};
                }
#undef SCAN_RD2
            }
            __syncthreads();
        }
        }
#undef SCAN_LOAD
    }
}

__device__ __forceinline__ void post_phase(const Params& p, int l, const int wv) {
    const int gt = bid_() * NTHR + tid_(wv), NGT = gridDim.x * NTHR;
    const bf16_t* PRW = (const bf16_t*)(KWS + WS_PRW); const bf16_t* LORA = (const bf16_t*)(KWS + WS_LORA); const bf16_t* YRAW = (const bf16_t*)(KWS + WS_YRAW);
    const float* BONUS = (const float*)(KWS + WS_BONUS); bf16_t* MA = (bf16_t*)(KWS + WS_MA);
    const float* muv = (const float*)karg(4) + l * RWC + 1024; const float* lg = (const float*)karg(13) + l * 512; const float* lb = (const float*)karg(14) + l * 512;
    for (int idx = gt; idx < MTOK * 64; idx += NGT) {
        const int m = idx >> 6, c = (idx & 63) * 8, head = c >> 6, t = m & (SEQ - 1);
        float y[8], cur[8], prv[8], mm[8], g[8], gg[8], bb[8], o[8];
        unpack8(ld16(YRAW + (size_t)m * 512 + c), y);
        float s = 0.f;
#pragma unroll
        for (int j = 0; j < 8; ++j) s += y[j];
        const float mean = dpp_sum8(s) * (1.0f / 64.0f);
        float q = 0.f;
#pragma unroll
        for (int j = 0; j < 8; ++j) { y[j] -= mean; q += y[j] * y[j]; }
        const float rstd = 1.0f / sqrtf(dpp_sum8(q) * (1.0f / 64.0f) + 64e-5f);
        unpack8(ld16(PRW + (size_t)m * RWC + 1024 + c), cur);
        if (t > 0) unpack8(ld16(PRW + (size_t)(m - 1) * RWC + 1024 + c), prv); else { _Pragma("unroll") for (int j = 0; j < 8; ++j) prv[j] = 0.f; }
        ld8f(muv + c, mm); ld8f(lg + c, gg); ld8f(lb + c, bb);
        unpack8(ld16(LORA + (size_t)m * 1536 + 1024 + c), g);
        const float bon = BONUS[(size_t)m * 8 + head];
#pragma unroll
        for (int j = 0; j < 8; ++j) { const float vs = cur[j] + (prv[j] - cur[j]) * mm[j]; o[j] = (y[j] * rstd * gg[j] + bb[j] + bon * vs) * g[j]; }
        *(u32x4*)(MA + (size_t)m * 512 + c) = pack8(o);
    }
}


#define XB_TMO      128
#define XB_XCNT(j)  (256  + 64 * (j))
#define XB_XSUB(j)  (1280 + 64 * (j))
#define XB_XGEN(j)  (2304 + 64 * (j))
#define XB_TOP      3328
#define XB_TOPGEN   3392
#define XCD_BAR_WORDS 3456
#define XB_SPIN_CAP (1u << 18)
__device__ __forceinline__ unsigned xb_ld(unsigned* p)              { return __hip_atomic_load(p, __ATOMIC_RELAXED, __HIP_MEMORY_SCOPE_AGENT); }
__device__ __forceinline__ unsigned xb_add(unsigned* p, unsigned v) { return __hip_atomic_fetch_add(p, v, __ATOMIC_RELAXED, __HIP_MEMORY_SCOPE_AGENT); }
__device__ __forceinline__ unsigned xb_xcc_id() { return (unsigned)__builtin_amdgcn_s_getreg((3 << 11) | 20) & 0xFu; }
#define XB_SPIN(cond, bar) do { unsigned _sp = 0; while (cond) { __builtin_amdgcn_s_sleep(1); \
    if ((++_sp & 255u) == 0u) { if (xb_ld(&(bar)[XB_TMO])) break; if (_sp > XB_SPIN_CAP) { atomicAdd(&(bar)[XB_TMO], 1u); break; } } } } while (0)
struct XcdBarrier { unsigned* bar; unsigned x; volatile LAS unsigned* st; };
__device__ __forceinline__ void xcd_barrier_complete(unsigned* bar, unsigned x, unsigned& nloc, unsigned& nx) {
    const unsigned G = gridDim.x * gridDim.y * gridDim.z;
    unsigned sum, cnt, mine, sp = 0u;
    for (;;) {
        sum = 0u; cnt = 0u; mine = 0u;
#pragma unroll
        for (unsigned j = 0; j < 16; ++j) { const unsigned c = xb_ld(&bar[XB_XCNT(j)]); sum += c; cnt += (c > 0u) ? 1u : 0u; mine = (j == x) ? c : mine; }
        if (sum == G) break;
        __builtin_amdgcn_s_sleep(1);
        if ((++sp & 255u) == 0u) { if (xb_ld(&bar[XB_TMO])) break; if (sp > XB_SPIN_CAP) { atomicAdd(&bar[XB_TMO], 1u); break; } }
    }
    nloc = mine > 0u ? mine : 1u; nx = cnt > 0u ? cnt : 1u;
}
__device__ __forceinline__ void xcd_barrier(const XcdBarrier& b, const int wv) {
    asm volatile("s_waitcnt vmcnt(0)" ::: "memory");
    __syncthreads();
    if (tid_(wv) == 0) {
        unsigned* bar = b.bar;
        __builtin_amdgcn_s_waitcnt(0);
        unsigned nloc = b.st[0], nx = b.st[1];
        if (nloc == 0u) { xcd_barrier_complete(bar, b.x, nloc, nx); b.st[0] = nloc; b.st[1] = nx; }
        const unsigned old = xb_add(&bar[XB_XSUB(b.x)], 1u);
        const unsigned gen = old / nloc;
        if (old + 1u == (gen + 1u) * nloc) {
            __builtin_amdgcn_fence(__ATOMIC_RELEASE, "agent");
            asm volatile("s_waitcnt vmcnt(0)" ::: "memory");
            const unsigned og = xb_add(&bar[XB_TOP], 1u);
            const unsigned tg = og / nx;
            if (og + 1u == (tg + 1u) * nx) xb_add(&bar[XB_TOPGEN], 1u);
            else XB_SPIN(xb_ld(&bar[XB_TOPGEN]) == tg, bar);
            __builtin_amdgcn_fence(__ATOMIC_ACQUIRE, "agent");
            xb_add(&bar[XB_XGEN(b.x)], 1u);
            asm volatile("s_waitcnt vmcnt(0)" ::: "memory");
        } else {
            XB_SPIN(xb_ld(&bar[XB_XGEN(b.x)]) == gen, bar);
            __builtin_amdgcn_fence(__ATOMIC_ACQUIRE, "agent");
            asm volatile("s_waitcnt vmcnt(0)" ::: "memory");
        }
    }
    __syncthreads();
}

__global__ void __launch_bounds__(NTHR, 2) hybrid_fwd(Params p) {
    extern __shared__ __attribute__((aligned(16))) unsigned char lds_raw[];
    LAS unsigned char* lds = (LAS unsigned char*)lds_raw;
    cg::grid_group grid = cg::this_grid();
    const int wv = __builtin_amdgcn_readfirstlane((int)threadIdx.x >> 6);
    const int G = gridDim.x;
    const int lo = p.ph_lo, hi = p.ph_hi;
#define RUN(k) (lo <= (k) && (k) < hi)
#ifndef REPEAT_MASK
#define REPEAT_MASK 0
#endif
#define REP(k) _Pragma("unroll 1") for (int rep_ = 0; rep_ < 1 + ((REPEAT_MASK >> (k)) & 1); ++rep_)
#define SYNC(k) do { if (RUN(k) && RUN((k) + 1)) xcd_barrier(xbar, wv); } while (0)
    XcdBarrier xbar; xbar.bar = (unsigned*)(KWS + WS_CTL); xbar.x = xb_xcc_id(); xbar.st = (volatile LAS unsigned*)(lds + LDS_BYTES - 16);
    { const int t0 = tid_(wv); if (t0 < 2) xbar.st[t0] = 0u;
      if (bid_() == 0) for (int i = t0; i < XCD_BAR_WORDS; i += NTHR) xbar.bar[i] = 0u; }
    if (RUN(0)) {
        prologue_phase(p, lds, wv);
        norm_phase((const float*)karg(0), (const float*)karg(2), (bf16_t*)(KWS + WS_H), wv);
    }
    if (RUN(0) && RUN(1)) { grid.sync(); if (tid_(wv) == 0) (void)xb_add(&xbar.bar[XB_XCNT(xbar.x)], 1u); }
#pragma unroll 1
    for (int l = 0; l < NL; ++l) {
        const int pb = 1 + 9 * l;
        const char* wl = (const char*)(KWS + WS_W) + (size_t)l * LW_ELEMS * 2;
        if (RUN(pb + 0)) REP(0) {
            pg::DenseSched S{(const char*)(KWS + WS_H), wl + OW_IN * 2, 2048u, 2048u, 16, 256, 18, G, bid_()};
            pg::EpiIn E{(bf16_t*)(KWS + WS_PRW), (bf16_t*)(KWS + WS_PPOOL), (bf16_t*)(KWS + WS_PCONV), (bf16_t*)(KWS + WS_PATT), l == 0 ? (const float*)nullptr : (const float*)(KWS + WS_SSQ) + 1 * MTOK};
            pg::gemm_phase(lds, S, E, wv);
        }
        SYNC(pb + 0);
        if (RUN(pb + 1)) REP(1) mix1_phase(p, l, lds, wv);
        SYNC(pb + 1);
        if (RUN(pb + 2)) REP(2) {
            pg::DenseSched S{(const char*)(KWS + WS_ALORA), wl + OW_LORA * 2, 512u, 512u, 4, 256, 6, G, bid_()};
            pg::EpiLora E{(bf16_t*)(KWS + WS_LORA), (const float*)karg(6) + l * 512, (const float*)karg(8) + l * 512};
            pg::gemm_phase(lds, S, E, wv);
        }
        SYNC(pb + 2);
        if (RUN(pb + 3)) REP(3) scan_phase(p, l, lds, wv);
        SYNC(pb + 3);
        if (RUN(pb + 4)) REP(4) post_phase(p, l, wv);
        SYNC(pb + 4);
        if (RUN(pb + 5)) REP(5) {
            const int c = bid_();
            pg::BRSched S{(const char*)(KWS + WS_H), wl + OW_IN * 2, (const char*)(KWS + WS_MA), (const char*)(KWS + WS_M3), wl + OW_BR * 2, G, c};
            pg::EpiBR E{(u32x4*)(KWS + WS_GSCR + (size_t)c * 131072), (bf16_t*)(KWS + WS_MIXED), l == 0 ? (const float*)nullptr : (const float*)(KWS + WS_SSQ) + 1 * MTOK};
            pg::gemm_phase(lds, S, E, wv);
        }
        SYNC(pb + 5);
        if (RUN(pb + 6)) {
            pg::DenseSched S{(const char*)(KWS + WS_MIXED), wl + OW_O * 2, 2048u, 2048u, 16, 256, 4, G, bid_()};
            pg::EpiRes E{l == 0 ? (const float*)karg(0) : (const float*)KOUT, KOUT, (bf16_t*)(KWS + WS_H), (const float*)karg(26) + l * DM, (float*)(KWS + WS_SSQ) + (l == 0 ? 0 : 2) * MTOK};
            pg::gemm_phase(lds, S, E, wv);
        }
        SYNC(pb + 6);
        if (RUN(pb + 7)) REP(8) {
            pg::DenseSched S{(const char*)(KWS + WS_H), wl + OW_GU * 2, 2048u, 2048u, 16, 256, 22, G, bid_()};
            pg::EpiGU E{(bf16_t*)(KWS + WS_ACT), (const float*)(KWS + WS_SSQ) + (l == 0 ? 0 : 2) * MTOK};
            pg::gemm_phase(lds, S, E, wv);
        }
        SYNC(pb + 7);
        if (RUN(pb + 8)) {
            pg::DenseSched S{(const char*)(KWS + WS_ACT), wl + OW_D * 2, (unsigned)(DFF * 2), (unsigned)(DFF * 2), 44, 256, 4, G, bid_()};
            pg::EpiRes E{(const float*)KOUT, KOUT, l + 1 < NL ? (bf16_t*)(KWS + WS_H) : (bf16_t*)nullptr, (const float*)karg(2) + (l + 1 < NL ? l + 1 : 0) * DM, (float*)(KWS + WS_SSQ) + 1 * MTOK};
            pg::gemm_phase(lds, S, E, wv);
        }
        SYNC(pb + 8);
    }
#undef RUN
#undef SYNC
}

constexpr int N_PHASES = 1 + 9 * NL;

extern "C" void kernel_launch(void* const* d_in, const int* in_sizes, int n_in, void* d_out, int out_size, void* d_ws, size_t ws_size, hipStream_t stream) {
    static int grid = 0;
    if (grid == 0) {
        if (n_in != 30 || out_size != MTOK * DM || ws_size < WS_END) { fprintf(stderr, "kernel_launch: unexpected shapes (n_in %d out %d ws %zu)\n", n_in, out_size, ws_size); grid = -1; return; }
        int dev = 0, cus = 0, per_cu = 0;
        (void)hipGetDevice(&dev); (void)hipDeviceGetAttribute(&cus, hipDeviceAttributeMultiprocessorCount, dev);
        (void)hipFuncSetAttribute((const void*)hybrid_fwd, hipFuncAttributeMaxDynamicSharedMemorySize, LDS_BYTES);
        (void)hipOccupancyMaxActiveBlocksPerMultiprocessor(&per_cu, (const void*)hybrid_fwd, NTHR, LDS_BYTES);
        if (per_cu < 1) { fprintf(stderr, "kernel_launch: occupancy query says %d blocks/CU\n", per_cu); per_cu = 1; }
        (void)hipGetLastError();
        grid = cus;
    }
    if (grid < 0) return;
    Params p{};
    for (int i = 0; i < 30; ++i) p.in[i] = d_in[i];
    p.out = (float*)d_out; p.ws = (unsigned char*)d_ws;
#ifdef MULTI_LAUNCH
    for (int ph = 0; ph < N_PHASES; ++ph) { p.ph_lo = ph; p.ph_hi = ph + 1; hipLaunchKernelGGL(hybrid_fwd, dim3(grid), dim3(NTHR), LDS_BYTES, stream, p); }
#else
    p.ph_lo = 0; p.ph_hi = N_PHASES;
    void* args[] = {&p};
    hipError_t e = hipLaunchCooperativeKernel((const void*)hybrid_fwd, dim3(grid), dim3(NTHR), args, LDS_BYTES, stream);
    if (e != hipSuccess) fprintf(stderr, "cooperative launch failed: %s (grid %d)\n", hipGetErrorString(e), grid);
#endif
}
```

```cpp
#include <hip/hip_runtime.h>
#include <hip/hip_cooperative_groups.h>
#include <cstdio>
#include <cstdint>
namespace cg = cooperative_groups;

#define LAS __attribute__((address_space(3)))
typedef unsigned short bf16_t;
typedef short bf16x8 __attribute__((ext_vector_type(8)));
typedef float f32x4 __attribute__((ext_vector_type(4)));
typedef float f32x2 __attribute__((ext_vector_type(2)));
typedef unsigned u32x4 __attribute__((ext_vector_type(4)));
typedef unsigned u32x2 __attribute__((ext_vector_type(2)));

constexpr int MTOK = 65536, SEQ = 4096, DM = 1024, NL = 2;
constexpr int RWC = 1792, INC = 8704, DFF = 2816;
constexpr int NTHR = 512;
constexpr size_t MiB = 1u << 20;
constexpr size_t OW_IN = 0, OW_LORA = 8912896, OW_BR = OW_LORA + 393216, OW_O = OW_BR + 2097152, OW_GU = OW_O + 1048576, OW_D = OW_GU + 5767168, LW_ELEMS = OW_D + 2883584;
constexpr size_t WS_W = 0, WS_BONUS = 82 * MiB, WS_ROPE = 84 * MiB, WS_H = 92 * MiB, WS_M3 = 220 * MiB, WS_PRW = 412 * MiB, WS_PPOOL = 636 * MiB,
                 WS_PCONV = 700 * MiB, WS_PATT = 892 * MiB, WS_ALORA = 988 * MiB, WS_END = 1020 * MiB;
constexpr size_t WS_CTL = 81 * MiB;
constexpr size_t WS_SSQ = 81 * MiB + 65536;
constexpr size_t WS_LORA = 636 * MiB, WS_YRAW = 828 * MiB, WS_MA = 892 * MiB, WS_GSCR = 956 * MiB, WS_MIXED = 412 * MiB, WS_ACT = 220 * MiB;
static_assert(2 * LW_ELEMS * 2 <= 81 * MiB, "weights fit below the control words");
constexpr int LDS_BYTES = 147456;

struct Params { const void* in[30]; float* out; unsigned char* ws; int ph_lo, ph_hi; };

__device__ __forceinline__ unsigned cvt_pk_bf16(float lo, float hi) { unsigned r; asm volatile("v_cvt_pk_bf16_f32 %0, %1, %2" : "=v"(r) : "v"(lo), "v"(hi)); return r; }
__device__ __forceinline__ void unpack8(const u32x4 w, float (&f)[8]) {
    f[0] = __uint_as_float(w.x << 16); f[1] = __uint_as_float(w.x & 0xffff0000u); f[2] = __uint_as_float(w.y << 16); f[3] = __uint_as_float(w.y & 0xffff0000u);
    f[4] = __uint_as_float(w.z << 16); f[5] = __uint_as_float(w.z & 0xffff0000u); f[6] = __uint_as_float(w.w << 16); f[7] = __uint_as_float(w.w & 0xffff0000u);
}
__device__ __forceinline__ u32x4 pack8(const float (&f)[8]) { u32x4 w; w.x = cvt_pk_bf16(f[0], f[1]); w.y = cvt_pk_bf16(f[2], f[3]); w.z = cvt_pk_bf16(f[4], f[5]); w.w = cvt_pk_bf16(f[6], f[7]); return w; }
__device__ __forceinline__ u32x4 ld16(const bf16_t* p) { return *(const u32x4*)p; }
__device__ __forceinline__ void ld8f(const float* p, float (&f)[8]) { const f32x4 a = *(const f32x4*)p, b = *(const f32x4*)(p + 4); f[0] = a.x; f[1] = a.y; f[2] = a.z; f[3] = a.w; f[4] = b.x; f[5] = b.y; f[6] = b.z; f[7] = b.w; }
__device__ __forceinline__ float sigmoidf_(float x) { return 1.0f / (1.0f + __expf(-x)); }
__device__ __forceinline__ const void* karg(int idx) {
    const __attribute__((address_space(4))) unsigned long long* kp = (const __attribute__((address_space(4))) unsigned long long*)__builtin_amdgcn_kernarg_segment_ptr();
    asm volatile("" : "+s"(kp));
    return (const void*)kp[idx];
}
#define KWS ((unsigned char*)karg(31))
#define KOUT ((float*)karg(30))
__device__ __forceinline__ int tid_(int wv) { int t; asm volatile("v_mbcnt_lo_u32_b32 %0, -1, 0\n\tv_mbcnt_hi_u32_b32 %0, -1, %0" : "=v"(t)); return (wv << 6) | t; }
__device__ __forceinline__ int bid_() { int b = blockIdx.x; asm volatile("" : "+s"(b)); return b; }
__device__ __forceinline__ float dpp_sum8(float v) {
    v += __builtin_bit_cast(float, __builtin_amdgcn_mov_dpp(__builtin_bit_cast(int, v), 0xB1, 0xF, 0xF, true));
    v += __builtin_bit_cast(float, __builtin_amdgcn_mov_dpp(__builtin_bit_cast(int, v), 0x4E, 0xF, 0xF, true));
    v += __builtin_bit_cast(float, __builtin_amdgcn_mov_dpp(__builtin_bit_cast(int, v), 0x141, 0xF, 0xF, true));
    return v;
}

namespace pg {
constexpr int BM = 256, BK = 64, HALF = 128, HTB = HALF * BK * 2, NXCD = 8, WGM = 8;
__device__ __forceinline__ int lds_byte(int r, int c) { const int st = (r >> 4) * 2 + (c >> 5), rr = r & 15, cc = c & 31, ob = rr * 64 + cc * 2; return st * 1024 + (ob ^ (((ob >> 9) & 1) << 5)); }
__device__ __forceinline__ void stage_rc(int b, int& R, int& C) { const int st = b / 1024, sb = b % 1024, swz = sb ^ (((sb >> 9) & 1) << 5); R = (st >> 1) * 16 + swz / 64; C = (st & 1) * 32 + (swz % 64) / 2; }
__device__ __forceinline__ int perm32(int rho) { const int n = rho >> 4, i = rho & 15; return 8 * (i >> 2) + 4 * n + (i & 3); }

struct GUnit { const char* A; const char* B; unsigned lda2, ldb2; int nt, pm, pn, aux; };

__device__ __forceinline__ bool tile_order(int i, int G, int c, int nM, int nN, int& pm, int& pn) {
    const int nwg = nM * nN; const long L = (long)i * G + c; if (L >= nwg) return false;
    int wgid = (int)L; { const int q = nwg / NXCD, r = nwg % NXCD, xcd = wgid % NXCD, off = wgid / NXCD; wgid = (xcd < r ? xcd * (q + 1) : r * (q + 1) + (xcd - r) * q) + off; }
    const int nig = WGM * nN, gid = wgid / nig, fm = gid * WGM, gsz = (nM - fm) < WGM ? (nM - fm) : WGM;
    pm = fm + ((wgid % nig) % gsz); pn = (wgid % nig) / gsz; return true;
}
struct DenseSched {
    const char* A; const char* B; unsigned lda2, ldb2; int nt, nM, nN, G, c;
    __device__ __forceinline__ bool next(int i, GUnit& u) const {
        int pm, pn; if (!tile_order(i, G, c, nM, nN, pm, pn)) return false;
        u.A = A + (size_t)pm * 256 * lda2; u.B = B + (size_t)pn * 256 * ldb2; u.lda2 = lda2; u.ldb2 = ldb2; u.nt = nt; u.pm = pm; u.pn = pn; u.aux = 0; return true;
    }
};
struct BRSched {
    const char* H; const char* WIN; const char* MA; const char* M3; const char* WBR; int G, c;
    __device__ __forceinline__ bool next(int i, GUnit& u) const {
        int pm, pn; if (!tile_order(i >> 3, G, c, 256, 4, pm, pn)) return false;
        const int sub = i & 7, b = sub >> 1;
        if ((sub & 1) == 0) { u.A = H + (size_t)pm * 256 * 2048; u.lda2 = 2048; u.B = WIN + (size_t)(4608 + b * 1024 + pn * 256) * 2048; u.ldb2 = 2048; u.nt = 16; }
        else { if (b == 0) { u.A = MA + (size_t)pm * 256 * 1024; u.lda2 = 1024; } else { u.A = M3 + (size_t)(b - 1) * 1024 + (size_t)pm * 256 * 3072; u.lda2 = 3072; }
               u.B = WBR + (size_t)b * (1024 * 512 * 2) + (size_t)pn * 256 * 1024; u.ldb2 = 1024; u.nt = 8; }
        u.pm = pm; u.pn = pn; u.aux = sub; return true;
    }
};

template <class Epi, class Sched>
__device__ __forceinline__ void gemm_phase(LAS unsigned char* lds, const Sched& S, const Epi& E, const int wv) {
    const int tid = tid_(wv), wid = __builtin_amdgcn_readfirstlane(tid >> 6), lane = tid & 63, wr = wid >> 2, wc = wid & 3, fr = lane & 15, fq = lane >> 4;
    const size_t kstep = (size_t)(BK * 2);
    const unsigned ldsw = (unsigned)wid * 1024u;
    const int aoff = lds_byte(wr * 64 + fr, fq * 8), boff = lds_byte(wc * 32 + fr, fq * 8);
#define PG_SA(b, h) (((b) * 2 + (h)) * HTB)
#define PG_SB(b, h) ((4 + (b) * 2 + (h)) * HTB)
#define PG_STAGE(bufoff, gbase, voff, ld2) do { \
        __builtin_amdgcn_global_load_lds((const unsigned*)((const char*)(gbase) + (voff)), (LAS unsigned*)(lds + (bufoff) + ldsw), 16, 0, 0); \
        __builtin_amdgcn_global_load_lds((const unsigned*)((const char*)(gbase) + (size_t)64 * (ld2) + (voff)), (LAS unsigned*)(lds + (bufoff) + ldsw + 8192), 16, 0, 0); } while (0)
#define PG_LDA(dst, b, h) do { _Pragma("unroll") for (int m = 0; m < 4; ++m) _Pragma("unroll") for (int k = 0; k < 2; ++k) dst[m][k] = *(const LAS bf16x8*)(lds + PG_SA(b, h) + aoff + m * 2048 + k * 1024); } while (0)
#define PG_LDB(dst, b, h) do { _Pragma("unroll") for (int n = 0; n < 2; ++n) _Pragma("unroll") for (int k = 0; k < 2; ++k) dst[n][k] = *(const LAS bf16x8*)(lds + PG_SB(b, h) + boff + n * 2048 + k * 1024); } while (0)
#define PG_MMA(ai, bj, At, Bt) do { __builtin_amdgcn_s_setprio(1); _Pragma("unroll") for (int m = 0; m < 4; ++m) _Pragma("unroll") for (int n = 0; n < 2; ++n) _Pragma("unroll") for (int k = 0; k < 2; ++k) \
        acc[ai][bj][m][n] = __builtin_amdgcn_mfma_f32_16x16x32_bf16(Bt[n][k], At[m][k], acc[ai][bj][m][n], 0, 0, 0); __builtin_amdgcn_s_setprio(0); } while (0)
#define PG_WAIT_V(n) asm volatile("s_waitcnt vmcnt(" #n ")" ::: "memory")
#define PG_WAIT_L(n) asm volatile("s_waitcnt lgkmcnt(" #n ")" ::: "memory")
#define PG_BAR __builtin_amdgcn_s_barrier()
#define PG_SCHED __builtin_amdgcn_sched_barrier(0)
#define PG_BODY(a1, vA1, la1, a2, b2, vA2, vB2, la2, lb2) do { \
            const size_t hA1 = (size_t)128 * (la1), hA2 = (size_t)128 * (la2), hB2 = (size_t)128 * (lb2); \
            const char* a3 = (a2) + kstep; const char* b3 = (b2) + kstep; \
            PG_LDB(B0, 0, 0); PG_LDB(B1, 0, 1); PG_SCHED; PG_LDA(At, 0, 0); PG_STAGE(PG_SA(1, 1), (a1) + hA1, vA1, la1); \
            PG_WAIT_V(8); PG_WAIT_L(0); PG_BAR; PG_MMA(0, 0, At, B0); PG_MMA(0, 1, At, B1); PG_BAR; PG_SCHED; \
            PG_LDA(At, 0, 1); PG_STAGE(PG_SB(0, 0), (b2), vB2, lb2); PG_STAGE(PG_SB(0, 1), (b2) + hB2, vB2, lb2); PG_STAGE(PG_SA(0, 0), (a2), vA2, la2); \
            PG_WAIT_V(8); PG_WAIT_L(0); PG_BAR; PG_MMA(1, 0, At, B0); PG_MMA(1, 1, At, B1); PG_BAR; PG_SCHED; \
            PG_LDB(B0, 1, 0); PG_LDB(B1, 1, 1); PG_SCHED; PG_LDA(At, 1, 0); PG_STAGE(PG_SA(0, 1), (a2) + hA2, vA2, la2); \
            PG_WAIT_V(8); PG_WAIT_L(0); PG_BAR; PG_MMA(0, 0, At, B0); PG_MMA(0, 1, At, B1); PG_BAR; PG_SCHED; \
            PG_LDA(At, 1, 1); PG_STAGE(PG_SB(1, 0), b3, vB2, lb2); PG_STAGE(PG_SB(1, 1), b3 + hB2, vB2, lb2); PG_STAGE(PG_SA(1, 0), a3, vA2, la2); \
            PG_WAIT_V(8); PG_WAIT_L(0); PG_BAR; PG_MMA(1, 0, At, B0); PG_MMA(1, 1, At, B1); PG_BAR; PG_SCHED; } while (0)
    GUnit cur, nxt; int ui = 0;
    if (!S.next(0, cur)) return;
    f32x4 acc[2][2][4][2];
#pragma unroll
    for (int a = 0; a < 2; ++a)
#pragma unroll
        for (int b = 0; b < 2; ++b)
#pragma unroll
            for (int m = 0; m < 4; ++m)
#pragma unroll
                for (int n = 0; n < 2; ++n) acc[a][b][m][n] = (f32x4){0.f, 0.f, 0.f, 0.f};
    bf16x8 At[4][2], B0[2][2], B1[2][2];
    unsigned vAc, vBc;
    { int R0, C0; stage_rc(tid * 16, R0, C0); const int Rb0 = (R0 & ~31) + perm32(R0 & 31); vAc = (unsigned)R0 * cur.lda2 + (unsigned)C0 * 2u; vBc = (unsigned)Rb0 * cur.ldb2 + (unsigned)C0 * 2u; }
    {
        const char* cA = cur.A; const char* cB = cur.B; const size_t hA = (size_t)128 * cur.lda2, hB = (size_t)128 * cur.ldb2;
        PG_STAGE(PG_SB(0, 0), cB, vBc, cur.ldb2); PG_STAGE(PG_SB(0, 1), cB + hB, vBc, cur.ldb2); PG_STAGE(PG_SA(0, 0), cA, vAc, cur.lda2); PG_STAGE(PG_SA(0, 1), cA + hA, vAc, cur.lda2);
        if (wr == 1) PG_BAR;
        PG_WAIT_V(2); PG_BAR;
        PG_STAGE(PG_SB(1, 0), cB + kstep, vBc, cur.ldb2); PG_STAGE(PG_SA(1, 0), cA + kstep, vAc, cur.lda2); PG_STAGE(PG_SB(1, 1), cB + hB + kstep, vBc, cur.ldb2);
        PG_WAIT_V(6); PG_BAR;
    }
    for (;;) {
        const bool has_next = S.next(ui + 1, nxt);
        if (!has_next) nxt = cur;
        const int nt = cur.nt;
        const char* cA = cur.A; const char* cB = cur.B;
        for (int t = 0; t < nt - 2; t += 2)
            PG_BODY(cA + (size_t)(t + 1) * kstep, vAc, cur.lda2, cA + (size_t)(t + 2) * kstep, cB + (size_t)(t + 2) * kstep, vAc, vBc, cur.lda2, cur.ldb2);
        unsigned vAn, vBn;
        { const int t2 = tid_(wv); int R0, C0; stage_rc(t2 * 16, R0, C0); const int Rb0 = (R0 & ~31) + perm32(R0 & 31);
          vAn = (unsigned)R0 * nxt.lda2 + (unsigned)C0 * 2u; vBn = (unsigned)Rb0 * nxt.ldb2 + (unsigned)C0 * 2u; }
        PG_BODY(cA + (size_t)(nt - 1) * kstep, vAc, cur.lda2, nxt.A, nxt.B, vAn, vBn, nxt.lda2, nxt.ldb2);
        if (wr == 0) PG_BAR;
        { const int te = tid_(wv); E(acc, cur, wr, wc, te & 15, (te >> 4) & 3); }
        if (!has_next) break;
#pragma unroll
        for (int a = 0; a < 2; ++a)
#pragma unroll
            for (int b = 0; b < 2; ++b)
#pragma unroll
                for (int m = 0; m < 4; ++m)
#pragma unroll
                    for (int n = 0; n < 2; ++n) acc[a][b][m][n] = (f32x4){0.f, 0.f, 0.f, 0.f};
        cur = nxt; vAc = vAn; vBc = vBn; ++ui;
        if (wr == 1) PG_BAR;
    }
    PG_WAIT_V(0);
    PG_BAR;
#undef PG_SA
#undef PG_SB
#undef PG_STAGE
#undef PG_LDA
#undef PG_LDB
#undef PG_MMA
#undef PG_WAIT_V
#undef PG_WAIT_L
#undef PG_BAR
#undef PG_SCHED
#undef PG_BODY
}

#define EPI_LOOP(...) \
    _Pragma("unroll") for (int ai = 0; ai < 2; ++ai) _Pragma("unroll") for (int m = 0; m < 4; ++m) _Pragma("unroll") for (int bj = 0; bj < 2; ++bj) { \
        const int row = u.pm * 256 + ai * 128 + wr * 64 + m * 16 + fr; const int tcol = bj * 128 + wc * 32 + 8 * fq; \
        const f32x4 v0 = acc[ai][bj][m][0], v1 = acc[ai][bj][m][1]; float v[8] = {v0[0], v0[1], v0[2], v0[3], v1[0], v1[1], v1[2], v1[3]}; __VA_ARGS__ }

struct EpiIn {
    bf16_t *prw, *ppool, *pconv, *patt; const float* ssq;
    __device__ __forceinline__ void operator()(const f32x4 (&acc)[2][2][4][2], const GUnit& u, int wr, int wc, int fr, int fq) const {
        asm volatile("" : "+v"(fr), "+v"(fq));
        bf16_t* base; int ld, ct;
        if (u.pn < 7) { base = prw; ld = 1792; ct = u.pn; } else if (u.pn < 9) { base = ppool; ld = 512; ct = u.pn - 7; }
        else if (u.pn < 15) { base = pconv; ld = 1536; ct = u.pn - 9; } else { base = patt; ld = 768; ct = u.pn - 15; }
        EPI_LOOP({ if (ssq) { const float rs = 1.0f / sqrtf(ssq[row] * (1.0f / 1024.0f) + 1e-6f); _Pragma("unroll") for (int j = 0; j < 8; ++j) v[j] *= rs; }
                   *(u32x4*)(base + (size_t)row * ld + ct * 256 + tcol) = pack8(v); })
    }
};
struct EpiLora {
    bf16_t* out; const float* w0; const float* a0;
    __device__ __forceinline__ void operator()(const f32x4 (&acc)[2][2][4][2], const GUnit& u, int wr, int wc, int fr, int fq) const {
        asm volatile("" : "+v"(fr), "+v"(fq));
        const float* bias = u.pn < 2 ? w0 + u.pn * 256 : a0 + (u.pn - 2) * 256;
        const bool sg = u.pn < 4;
        float bv0[8], bv1[8];
        if (sg) { ld8f(bias + wc * 32 + 8 * fq, bv0); ld8f(bias + 128 + wc * 32 + 8 * fq, bv1); }
        EPI_LOOP({ if (sg) { _Pragma("unroll") for (int j = 0; j < 8; ++j) v[j] = sigmoidf_(v[j] + (bj ? bv1[j] : bv0[j])); }
                   *(u32x4*)(out + (size_t)row * 1536 + u.pn * 256 + tcol) = pack8(v); })
    }
};
struct EpiBR {
    u32x4* scr; bf16_t* mixed; const float* ssq;
    __device__ __forceinline__ void operator()(const f32x4 (&acc)[2][2][4][2], const GUnit& u, int wr, int wc, int fr, int fq) const {
        asm volatile("" : "+v"(fr), "+v"(fq));
        const bool gate = (u.aux & 1) == 0; const bool first = (u.aux >> 1) == 0;
        const int tix = (wr * 4 + wc) * 64 + fq * 16 + fr;
        if (gate) {
            EPI_LOOP({ const float rs = ssq ? 1.0f / sqrtf(ssq[row] * (1.0f / 1024.0f) + 1e-6f) : 1.0f;
                       _Pragma("unroll") for (int j = 0; j < 8; ++j) v[j] = sigmoidf_(v[j] * rs); scr[((ai * 4 + m) * 2 + bj) * 512 + tix] = pack8(v); })
        } else {
#pragma unroll
            for (int aq = 0; aq < 4; ++aq) {
                const int ai = aq >> 1, m0 = (aq & 1) * 2;
                u32x4 gq[4][2], oq[4][2];
#pragma unroll
                for (int m = m0; m < m0 + 2; ++m)
#pragma unroll
                    for (int bj = 0; bj < 2; ++bj) {
                        gq[m][bj] = scr[((ai * 4 + m) * 2 + bj) * 512 + tix];
                        const int row = u.pm * 256 + ai * 128 + wr * 64 + m * 16 + fr; const int tcol = bj * 128 + wc * 32 + 8 * fq;
                        if (!first) oq[m][bj] = *(const u32x4*)(mixed + (size_t)row * 1024 + u.pn * 256 + tcol);
                    }
#pragma unroll
                for (int m = m0; m < m0 + 2; ++m)
#pragma unroll
                    for (int bj = 0; bj < 2; ++bj) {
                        const int row = u.pm * 256 + ai * 128 + wr * 64 + m * 16 + fr; const int tcol = bj * 128 + wc * 32 + 8 * fq;
                        const f32x4 v0 = acc[ai][bj][m][0], v1 = acc[ai][bj][m][1]; float v[8] = {v0[0], v0[1], v0[2], v0[3], v1[0], v1[1], v1[2], v1[3]};
                        float g[8]; unpack8(gq[m][bj], g);
#pragma unroll
                        for (int j = 0; j < 8; ++j) v[j] *= g[j];
                        if (!first) { float o[8]; unpack8(oq[m][bj], o); _Pragma("unroll") for (int j = 0; j < 8; ++j) v[j] += o[j]; }
                        *(u32x4*)(mixed + (size_t)row * 1024 + u.pn * 256 + tcol) = pack8(v);
                    }
            }
        }
    }
};
struct EpiRes {
    const float* base; float* out; bf16_t* xg; const float* g; float* ssq;
    __device__ __forceinline__ void operator()(const f32x4 (&acc)[2][2][4][2], const GUnit& u, int wr, int wc, int fr, int fq) const {
        asm volatile("" : "+v"(fr), "+v"(fq));
        float gq[2][8], sqv[8];
        if (xg) { ld8f(g + u.pn * 256 + wc * 32 + 8 * fq, gq[0]); ld8f(g + u.pn * 256 + 128 + wc * 32 + 8 * fq, gq[1]); }
#pragma unroll
        for (int aq = 0; aq < 4; ++aq) {
            const int ai = aq >> 1, m0 = (aq & 1) * 2;
            f32x4 b0[4][2], b1[4][2];
#pragma unroll
            for (int m = m0; m < m0 + 2; ++m)
#pragma unroll
                for (int bj = 0; bj < 2; ++bj) {
                    const size_t off = (size_t)(u.pm * 256 + ai * 128 + wr * 64 + m * 16 + fr) * 1024 + u.pn * 256 + bj * 128 + wc * 32 + 8 * fq;
                    b0[m][bj] = *(const f32x4*)(base + off); b1[m][bj] = *(const f32x4*)(base + off + 4);
                }
#pragma unroll
            for (int m = m0; m < m0 + 2; ++m) {
                float sq = 0.f;
#pragma unroll
                for (int bj = 0; bj < 2; ++bj) {
                    const int row = u.pm * 256 + ai * 128 + wr * 64 + m * 16 + fr;
                    const size_t off = (size_t)row * 1024 + u.pn * 256 + bj * 128 + wc * 32 + 8 * fq;
                    const f32x4 o0 = b0[m][bj] + acc[ai][bj][m][0], o1 = b1[m][bj] + acc[ai][bj][m][1];
                    *(f32x4*)(out + off) = o0; *(f32x4*)(out + off + 4) = o1;
                    if (xg) {
                        sq += (o0[0] * o0[0] + o0[1] * o0[1]) + (o0[2] * o0[2] + o0[3] * o0[3]) + (o1[0] * o1[0] + o1[1] * o1[1]) + (o1[2] * o1[2] + o1[3] * o1[3]);
                        float xv[8] = {o0[0] * gq[bj][0], o0[1] * gq[bj][1], o0[2] * gq[bj][2], o0[3] * gq[bj][3], o1[0] * gq[bj][4], o1[1] * gq[bj][5], o1[2] * gq[bj][6], o1[3] * gq[bj][7]};
                        *(u32x4*)(xg + off) = pack8(xv);
                    }
                }
                sqv[ai * 4 + m] = sq;
            }
        }
        if (xg) {
#pragma unroll
            for (int q = 0; q < 8; ++q) { sqv[q] += __shfl_xor(sqv[q], 16); sqv[q] += __shfl_xor(sqv[q], 32); }
            if (fq == 0) {
#pragma unroll
                for (int q = 0; q < 8; ++q) {
                    __attribute__((address_space(1))) float* ap = (__attribute__((address_space(1))) float*)(ssq + (u.pm * 256 + (q >> 2) * 128 + wr * 64 + (q & 3) * 16 + fr));
                    (void)__hip_atomic_fetch_add(ap, sqv[q], __ATOMIC_RELAXED, __HIP_MEMORY_SCOPE_AGENT);
                }
            }
        }
    }
};
struct EpiGU {
    bf16_t* act; const float* ssq;
    __device__ __forceinline__ void operator()(const f32x4 (&acc)[2][2][4][2], const GUnit& u, int wr, int wc, int fr, int fq) const {
        asm volatile("" : "+v"(fr), "+v"(fq));
#pragma unroll
        for (int ai = 0; ai < 2; ++ai)
#pragma unroll
            for (int m = 0; m < 4; ++m) {
                const int row = u.pm * 256 + ai * 128 + wr * 64 + m * 16 + fr; const int col = u.pn * 128 + wc * 32 + 8 * fq;
                const float rs = 1.0f / sqrtf(ssq[row] * (1.0f / 1024.0f) + 1e-6f);
                const f32x4 g0 = acc[ai][0][m][0] * rs, g1 = acc[ai][0][m][1] * rs, u0 = acc[ai][1][m][0] * rs, u1 = acc[ai][1][m][1] * rs;
                float v[8];
#pragma unroll
                for (int j = 0; j < 4; ++j) { v[j] = g0[j] * sigmoidf_(g0[j]) * u0[j]; v[4 + j] = g1[j] * sigmoidf_(g1[j]) * u1[j]; }
                *(u32x4*)(act + (size_t)row * DFF + col) = pack8(v);
            }
    }
};
}

__device__ __forceinline__ float wave_sum(float v) {
#pragma unroll
    for (int o = 1; o < 64; o <<= 1) v += __shfl_xor(v, o);
    return v;
}
__device__ __forceinline__ void transpose_item(const float* W, int ldw, int k0, int n0, bf16_t* WT, int drow0, int ldd, int dk0, LAS float* scr, int lane) {
#pragma unroll 8
    for (int i = 0; i < 32; ++i) { const int kk = 2 * i + (lane >> 5); scr[kk * 33 + (lane & 31)] = W[(size_t)(k0 + kk) * ldw + n0 + (lane & 31)]; }
    asm volatile("s_waitcnt lgkmcnt(0)" ::: "memory");
    const int c = lane & 7;
#pragma unroll
    for (int j = 0; j < 4; ++j) { const int n = (lane >> 3) + 8 * j; const LAS float* s = scr + (8 * c) * 33 + n;
        u32x4 o; o.x = cvt_pk_bf16(s[0 * 33], s[1 * 33]); o.y = cvt_pk_bf16(s[2 * 33], s[3 * 33]); o.z = cvt_pk_bf16(s[4 * 33], s[5 * 33]); o.w = cvt_pk_bf16(s[6 * 33], s[7 * 33]);
        *(u32x4*)(WT + (size_t)(drow0 + n) * ldd + dk0 + k0 + 8 * c) = o; }
    asm volatile("s_waitcnt lgkmcnt(0)" ::: "memory");
}

__device__ __forceinline__ void prologue_phase(const Params& p, LAS unsigned char* lds, const int wv) {
    const int tid = tid_(wv), lane = tid & 63, wave = __builtin_amdgcn_readfirstlane(tid >> 6);
    const int G = gridDim.x; const int gw = bid_() * 8 + wave, NGW = G * 8;
    LAS float* scr = (LAS float*)(lds + wave * 8448);
    bf16_t* Wb = (bf16_t*)(KWS + WS_W);
    constexpr int PER_LAYER = 4352 + 16 + 16 + 32 + 256 * 3 + 512 + 1408 * 3;
    for (int it = gw; it < NL * PER_LAYER; it += NGW) {
        const int l = it / PER_LAYER; int r = it % PER_LAYER;
        bf16_t* wl = Wb + (size_t)l * LW_ELEMS;
        const float* src; int K, N, ldd, dk0 = 0, mode = 0; bf16_t* dst; int rowoff = 0;
        if (r < 4352) { src = (const float*)karg(3) + (size_t)l * 1024 * INC; K = 1024; N = INC; dst = wl + OW_IN; ldd = 1024; }
        else if ((r -= 4352) < 16) { src = (const float*)karg(5) + (size_t)l * 64 * 512; K = 64; N = 512; dst = wl + OW_LORA; ldd = 256; }
        else if ((r -= 16) < 16) { src = (const float*)karg(7) + (size_t)l * 64 * 512; K = 64; N = 512; dst = wl + OW_LORA; ldd = 256; rowoff = 512; dk0 = 64; }
        else if ((r -= 16) < 32) { src = (const float*)karg(9) + (size_t)l * 128 * 512; K = 128; N = 512; dst = wl + OW_LORA; ldd = 256; rowoff = 1024; dk0 = 128; }
        else if ((r -= 32) < 256) { src = (const float*)karg(15) + (size_t)l * 512 * 1024; K = 512; N = 1024; dst = wl + OW_BR; ldd = 512; }
        else if ((r -= 256) < 256) { src = (const float*)karg(20) + (size_t)l * 512 * 1024; K = 512; N = 1024; dst = wl + OW_BR + 2 * 524288; ldd = 512; }
        else if ((r -= 256) < 256) { src = (const float*)karg(24) + (size_t)l * 512 * 1024; K = 512; N = 1024; dst = wl + OW_BR + 3 * 524288; ldd = 512; }
        else if ((r -= 256) < 512) { src = (const float*)karg(25) + (size_t)l * 1024 * 1024; K = 1024; N = 1024; dst = wl + OW_O; ldd = 1024; }
        else if ((r -= 512) < 1408) { src = (const float*)karg(27) + (size_t)l * 1024 * DFF; K = 1024; N = DFF; dst = wl + OW_GU; ldd = 1024; mode = 1; }
        else if ((r -= 1408) < 1408) { src = (const float*)karg(28) + (size_t)l * 1024 * DFF; K = 1024; N = DFF; dst = wl + OW_GU; ldd = 1024; mode = 2; }
        else { r -= 1408; src = (const float*)karg(29) + (size_t)l * DFF * 1024; K = DFF; N = 1024; dst = wl + OW_D; ldd = DFF; }
        const int nblk = N / 32, kb = r / nblk, nb = r % nblk, n0 = nb * 32;
        int drow0 = rowoff + n0;
        if (mode) drow0 = (n0 >> 7) * 256 + (n0 & 127) + (mode == 2 ? 128 : 0);
        transpose_item(src, N, kb * 64, n0, dst, drow0, ldd, dk0, scr, lane);
    }
    const int gt = bid_() * NTHR + tid, NGT = G * NTHR;
    for (int idx = gt; idx < 3 * MTOK; idx += NGT) ((float*)(KWS + WS_SSQ))[idx] = 0.f;
    for (int idx = gt; idx < NL * 1536 * 32; idx += NGT) {
        const int l = idx / (1536 * 32), r = idx % (1536 * 32), row = r >> 5, kc = (r & 31) * 8;
        const bool diag = row < 512 ? (kc < 64) : row < 1024 ? (kc >= 64 && kc < 128) : (kc >= 128);
        if (!diag) *(u32x4*)(Wb + (size_t)l * LW_ELEMS + OW_LORA + (size_t)row * 256 + kc) = (u32x4){0u, 0u, 0u, 0u};
    }
    for (int idx = gt; idx < NL * 1024 * 64; idx += NGT) {
        const int l = idx >> 16, r = idx & 65535, n = r & 1023, k0 = (r >> 10) * 8, g = k0 >> 7;
        const float* pw = (const float*)karg(16) + (size_t)l * 65536 + (size_t)g * 16384 + (size_t)(k0 & 127) * 128;
        const float* sc = (const float*)karg(17) + l * 512 + g * 128;
        const float* wo = (const float*)karg(18) + (size_t)l * 512 * 1024 + (size_t)g * 128 * 1024 + n;
        float a[8] = {0.f, 0.f, 0.f, 0.f, 0.f, 0.f, 0.f, 0.f};
        for (int j = 0; j < 128; ++j) { const float w = sc[j] * wo[(size_t)j * 1024];
#pragma unroll
            for (int i = 0; i < 8; ++i) a[i] += pw[i * 128 + j] * w; }
        *(u32x4*)(Wb + (size_t)l * LW_ELEMS + OW_BR + 524288 + (size_t)n * 512 + k0) = pack8(a);
    }
    _Float16* rope = (_Float16*)(KWS + WS_ROPE);
    const int* pos = (const int*)karg(1);
    for (int idx = gt; idx < MTOK * 32; idx += NGT) {
        const int m = idx >> 5, i = idx & 31;
        const float inv = powf(10000.0f, -(float)i * 2.0f / 64.0f);
        const float ang = (float)pos[m] * inv;
        rope[(size_t)m * 64 + i] = (_Float16)cosf(ang); rope[(size_t)m * 64 + 32 + i] = (_Float16)sinf(ang);
    }
}

__device__ __forceinline__ void norm_phase(const float* x, const float* g, bf16_t* out, const int wv) {
    const int tid = tid_(wv), lane = tid & 63, wave = tid >> 6;
    f32x4 gv[4];
#pragma unroll
    for (int j = 0; j < 4; ++j) gv[j] = *((const f32x4*)g + lane + 64 * j);
    for (int m = bid_() * 8 + wave; m < MTOK; m += gridDim.x * 8) {
        const f32x4* xr = (const f32x4*)(x + (size_t)m * DM) + lane;
        f32x4 v[4]; float s = 0.f;
#pragma unroll
        for (int j = 0; j < 4; ++j) { v[j] = xr[64 * j]; s += (v[j].x * v[j].x + v[j].y * v[j].y) + (v[j].z * v[j].z + v[j].w * v[j].w); }
        const float rstd = 1.0f / sqrtf(wave_sum(s) * (1.0f / DM) + 1e-6f);
        u32x2* o = (u32x2*)(out + (size_t)m * DM) + lane;
#pragma unroll
        for (int j = 0; j < 4; ++j) { u32x2 w; w.x = cvt_pk_bf16(v[j].x * rstd * gv[j].x, v[j].y * rstd * gv[j].y); w.y = cvt_pk_bf16(v[j].z * rstd * gv[j].z, v[j].w * rstd * gv[j].w); o[64 * j] = w; }
    }
}

typedef _Float16 h16x8 __attribute__((ext_vector_type(8)));
__device__ __forceinline__ u32x4 qk_prep(const u32x4 raw, const float* g, const u32x4 cs8, const u32x4 sn8, int c, float scale) {
    float x[8]; unpack8(raw, x);
    float ss = 0.f;
#pragma unroll
    for (int j = 0; j < 8; ++j) ss += x[j] * x[j];
    ss = dpp_sum8(ss);
    const float rstd = 1.0f / sqrtf(ss * (1.0f / 64.0f) + 1e-6f);
    float gg[8]; ld8f(g + c * 8, gg);
    const h16x8 ch = __builtin_bit_cast(h16x8, cs8), sh = __builtin_bit_cast(h16x8, sn8);
    float o[8];
#pragma unroll
    for (int j = 0; j < 8; ++j) {
        const float y = x[j] * rstd * gg[j];
        const float pr = __shfl_xor(y, 4);
        const float cs = (float)ch[j], sn = (float)sh[j];
        o[j] = (c < 4 ? y * cs - pr * sn : y * cs + pr * sn) * scale;
    }
    return pack8(o);
}

__device__ __forceinline__ void attn_item(const Params& p, int l, int item, LAS unsigned char* lds, const int wv) {
    const int tid = tid_(wv), lane = tid & 63, wave = __builtin_amdgcn_readfirstlane(tid >> 6), fr = lane & 15, fq = lane >> 4;
    const int b = item >> 6, kvh = (item >> 5) & 1, nbk = item & 31;
    const int tok0 = b * SEQ + nbk * 128;
    const bf16_t* PATT = (const bf16_t*)(KWS + WS_PATT);
    bf16_t* M3 = (bf16_t*)(KWS + WS_M3);
    const _Float16* rope = (const _Float16*)(KWS + WS_ROPE);
    const float* qg = (const float*)karg(21) + l * 64; const float* kg = (const float*)karg(22) + l * 64;
    LAS bf16_t* Ks = (LAS bf16_t*)lds;
    LAS bf16_t* Vt = (LAS bf16_t*)(lds + 36864);
    LAS bf16_t* Qs = (LAS bf16_t*)(lds + 70656);
    const int c = tid & 7;
    const int ci = (c & 3) * 8;
    {
        u32x4 kraw[4], vraw[4], kcs[4], ksn[4];
#pragma unroll
        for (int pass = 0; pass < 4; ++pass) {
            const int row = pass * 64 + (tid >> 3); const int tokk = tok0 - 128 + row; const bool valid = (nbk > 0) || (row >= 128);
            const int tk = valid ? tokk : tok0;
            kraw[pass] = ld16(PATT + (size_t)tk * 768 + 512 + kvh * 64 + c * 8); vraw[pass] = ld16(PATT + (size_t)tk * 768 + 640 + kvh * 64 + c * 8);
            kcs[pass] = *(const u32x4*)(rope + (size_t)tk * 64 + ci); ksn[pass] = *(const u32x4*)(rope + (size_t)tk * 64 + 32 + ci);
            if (!valid) { kraw[pass] = (u32x4){0u, 0u, 0u, 0u}; vraw[pass] = kraw[pass]; }
        }
#pragma unroll
        for (int pass = 0; pass < 4; ++pass) {
            const int row = pass * 64 + (tid >> 3);
            *(LAS u32x4*)(Ks + row * 72 + c * 8) = qk_prep(kraw[pass], kg, kcs[pass], ksn[pass], c, 1.0f);
            LAS bf16_t* vp = Vt + (c * 8) * 264 + row; const u32x4 vr = vraw[pass];
            vp[0 * 264] = (bf16_t)(vr.x & 0xffffu); vp[1 * 264] = (bf16_t)(vr.x >> 16); vp[2 * 264] = (bf16_t)(vr.y & 0xffffu); vp[3 * 264] = (bf16_t)(vr.y >> 16);
            vp[4 * 264] = (bf16_t)(vr.z & 0xffffu); vp[5 * 264] = (bf16_t)(vr.z >> 16); vp[6 * 264] = (bf16_t)(vr.w & 0xffffu); vp[7 * 264] = (bf16_t)(vr.w >> 16);
        }
    }
#pragma unroll 1
    for (int ph2 = 0; ph2 < 2; ++ph2) {
        u32x4 qraw[4], qcs[4], qsn[4];
#pragma unroll
        for (int i = 0; i < 4; ++i) {
            const int row = (ph2 * 4 + i) * 64 + (tid >> 3); const int g = row >> 7, ql = row & 127; const int tokq = tok0 + ql; const int hq = kvh * 4 + g;
            qraw[i] = ld16(PATT + (size_t)tokq * 768 + hq * 64 + c * 8);
            qcs[i] = *(const u32x4*)(rope + (size_t)tokq * 64 + ci); qsn[i] = *(const u32x4*)(rope + (size_t)tokq * 64 + 32 + ci);
        }
#pragma unroll
        for (int i = 0; i < 4; ++i) {
            const int row = (ph2 * 4 + i) * 64 + (tid >> 3);
            *(LAS u32x4*)(Qs + row * 72 + c * 8) = qk_prep(qraw[i], qg, qcs[i], qsn[i], c, 0.125f);
        }
    }
    __syncthreads();
    const int g = wave >> 1; const int hq = kvh * 4 + g;
    const float sink = ((const float*)karg(23))[l * 8 + hq];
#pragma unroll 1
    for (int pp = 0; pp < 2; ++pp) {
        const int ql0 = (wave & 1) * 64 + pp * 32;
        f32x4 sacc[10][2];
#pragma unroll
        for (int n = 0; n < 10; ++n) { sacc[n][0] = (f32x4){0.f, 0.f, 0.f, 0.f}; sacc[n][1] = sacc[n][0]; }
#pragma unroll
        for (int kk2 = 0; kk2 < 2; ++kk2) {
            const bf16x8 q0 = *(const LAS bf16x8*)(Qs + (g * 128 + ql0 + fr) * 72 + 32 * kk2 + 8 * fq);
            const bf16x8 q1 = *(const LAS bf16x8*)(Qs + (g * 128 + ql0 + 16 + fr) * 72 + 32 * kk2 + 8 * fq);
#pragma unroll
            for (int n = 0; n < 10; ++n) {
                const bf16x8 kf = *(const LAS bf16x8*)(Ks + (ql0 + 16 * n + fr) * 72 + 32 * kk2 + 8 * fq);
                sacc[n][0] = __builtin_amdgcn_mfma_f32_16x16x32_bf16(kf, q0, sacc[n][0], 0, 0, 0);
                sacc[n][1] = __builtin_amdgcn_mfma_f32_16x16x32_bf16(kf, q1, sacc[n][1], 0, 0, 0);
            }
        }
        u32x2 pb[10][2];
#pragma unroll
        for (int mq = 0; mq < 2; ++mq) {
            const int qi = 128 + ql0 + 16 * mq + fr;
            float mx = -__builtin_inff();
#pragma unroll
            for (int n = 0; n < 10; ++n)
#pragma unroll
                for (int j = 0; j < 4; ++j) {
                    const int kj = ql0 + 16 * n + 4 * fq + j; const int dist = qi - kj;
                    const bool ok = (dist >= 0) && (dist < 128) && ((nbk > 0) || (kj >= 128));
                    const float s = ok ? sacc[n][mq][j] : -__builtin_inff();
                    sacc[n][mq][j] = s; mx = fmaxf(mx, s);
                }
            mx = fmaxf(mx, __shfl_xor(mx, 16)); mx = fmaxf(mx, __shfl_xor(mx, 32));
            const float mf = fmaxf(mx, sink);
            float sum = 0.f;
#pragma unroll
            for (int n = 0; n < 10; ++n)
#pragma unroll
                for (int j = 0; j < 4; ++j) { const float e = __expf(sacc[n][mq][j] - mf); sacc[n][mq][j] = e; sum += e; }
            sum += __shfl_xor(sum, 16); sum += __shfl_xor(sum, 32);
            const float inv = 1.0f / (sum + __expf(sink - mf));
#pragma unroll
            for (int n = 0; n < 10; ++n) { pb[n][mq].x = cvt_pk_bf16(sacc[n][mq][0] * inv, sacc[n][mq][1] * inv); pb[n][mq].y = cvt_pk_bf16(sacc[n][mq][2] * inv, sacc[n][mq][3] * inv); }
        }
        f32x4 oacc[4][2];
#pragma unroll
        for (int dt = 0; dt < 4; ++dt) { oacc[dt][0] = (f32x4){0.f, 0.f, 0.f, 0.f}; oacc[dt][1] = oacc[dt][0]; }
#pragma unroll
        for (int kc = 0; kc < 5; ++kc) {
            const u32x4 p0 = (u32x4){pb[2 * kc][0].x, pb[2 * kc][0].y, pb[2 * kc + 1][0].x, pb[2 * kc + 1][0].y};
            const u32x4 p1 = (u32x4){pb[2 * kc][1].x, pb[2 * kc][1].y, pb[2 * kc + 1][1].x, pb[2 * kc + 1][1].y};
#pragma unroll
            for (int dt = 0; dt < 4; ++dt) {
                const LAS bf16_t* vrow = Vt + (16 * dt + fr) * 264 + ql0 + 32 * kc + 4 * fq;
                const u32x2 va = *(const LAS u32x2*)vrow, vb = *(const LAS u32x2*)(vrow + 16);
                const u32x4 vv = (u32x4){va.x, va.y, vb.x, vb.y};
                oacc[dt][0] = __builtin_amdgcn_mfma_f32_16x16x32_bf16(__builtin_bit_cast(bf16x8, vv), __builtin_bit_cast(bf16x8, p0), oacc[dt][0], 0, 0, 0);
                oacc[dt][1] = __builtin_amdgcn_mfma_f32_16x16x32_bf16(__builtin_bit_cast(bf16x8, vv), __builtin_bit_cast(bf16x8, p1), oacc[dt][1], 0, 0, 0);
            }
        }
#pragma unroll
        for (int mq = 0; mq < 2; ++mq)
#pragma unroll
            for (int dt = 0; dt < 4; ++dt) {
                const int ql = ql0 + 16 * mq + fr;
                u32x2 w; w.x = cvt_pk_bf16(oacc[dt][mq][0], oacc[dt][mq][1]); w.y = cvt_pk_bf16(oacc[dt][mq][2], oacc[dt][mq][3]);
                *(u32x2*)(M3 + (size_t)(tok0 + ql) * 1536 + 1024 + hq * 64 + 16 * dt + 4 * fq) = w;
            }
    }
    __syncthreads();
}

__device__ __forceinline__ void mix1_phase(const Params& p, int l, LAS unsigned char* lds, const int wv) {
    const int tid = tid_(wv), G = gridDim.x;
    for (int item = bid_(); item < 1024; item += G) attn_item(p, l, item, lds, wv);
    const int gt = bid_() * NTHR + tid, NGT = G * NTHR;
    const bf16_t* PRW = (const bf16_t*)(KWS + WS_PRW); const bf16_t* PPOOL = (const bf16_t*)(KWS + WS_PPOOL); const bf16_t* PCONV = (const bf16_t*)(KWS + WS_PCONV);
    bf16_t* M3 = (bf16_t*)(KWS + WS_M3); bf16_t* AL = (bf16_t*)(KWS + WS_ALORA);
    const float* mu = (const float*)karg(4) + l * RWC;
    for (int idx = gt; idx < (MTOK / 32) * 32; idx += NGT) {
        const int run = idx >> 5, c8 = (idx & 31) * 8, m0 = run * 32, t0 = m0 & (SEQ - 1);
        float mm[8], prv[8];
        ld8f(mu + 1536 + c8, mm);
        if (t0 > 0) unpack8(ld16(PRW + (size_t)(m0 - 1) * RWC + 1536 + c8), prv); else { _Pragma("unroll") for (int j = 0; j < 8; ++j) prv[j] = 0.f; }
#pragma unroll 1
        for (int tb = 0; tb < 32; tb += 8) {
            u32x4 raw[8];
#pragma unroll
            for (int i = 0; i < 8; ++i) raw[i] = ld16(PRW + (size_t)(m0 + tb + i) * RWC + 1536 + c8);
#pragma unroll
            for (int i = 0; i < 8; ++i) {
                float cur[8], o[8]; unpack8(raw[i], cur);
#pragma unroll
                for (int j = 0; j < 8; ++j) { const float sft = cur[j] + (prv[j] - cur[j]) * mm[j];
                    o[j] = c8 < 64 ? (1.0f - 2.0f / (__expf(2.0f * sft) + 1.0f)) : (c8 < 128 ? sft : sigmoidf_(sft)); prv[j] = cur[j]; }
                *(u32x4*)(AL + (size_t)(m0 + tb + i) * 256 + c8) = pack8(o);
            }
        }
    }
    const float* cw = (const float*)karg(19) + l * 3 * 512;
    for (int idx = gt; idx < (MTOK / 32) * 64; idx += NGT) {
        const int run = idx >> 6, c8 = (idx & 63) * 8, m0 = run * 32, t0 = m0 & (SEQ - 1);
        float w0[8], w1[8], w2[8], p2[8], p1[8];
        ld8f(cw + c8, w0); ld8f(cw + 512 + c8, w1); ld8f(cw + 1024 + c8, w2);
        if (t0 > 0) { float a[8], bq[8]; unpack8(ld16(PCONV + (size_t)(m0 - 2) * 1536 + 512 + c8), a); unpack8(ld16(PCONV + (size_t)(m0 - 2) * 1536 + 1024 + c8), bq);
#pragma unroll
            for (int j = 0; j < 8; ++j) p2[j] = a[j] * bq[j];
            unpack8(ld16(PCONV + (size_t)(m0 - 1) * 1536 + 512 + c8), a); unpack8(ld16(PCONV + (size_t)(m0 - 1) * 1536 + 1024 + c8), bq);
#pragma unroll
            for (int j = 0; j < 8; ++j) p1[j] = a[j] * bq[j]; }
        else { _Pragma("unroll") for (int j = 0; j < 8; ++j) { p2[j] = 0.f; p1[j] = 0.f; } }
#pragma unroll 1
        for (int tb = 0; tb < 32; tb += 4) {
            u32x4 rb[4], rc[4], ru[4];
#pragma unroll
            for (int i = 0; i < 4; ++i) { const bf16_t* q = PCONV + (size_t)(m0 + tb + i) * 1536 + c8; rb[i] = ld16(q); rc[i] = ld16(q + 512); ru[i] = ld16(q + 1024); }
#pragma unroll
            for (int i = 0; i < 4; ++i) {
                float bg[8], cc[8], uu[8], o[8]; unpack8(rb[i], bg); unpack8(rc[i], cc); unpack8(ru[i], uu);
#pragma unroll
                for (int j = 0; j < 8; ++j) { const float p0 = cc[j] * uu[j]; o[j] = bg[j] * (w0[j] * p2[j] + w1[j] * p1[j] + w2[j] * p0); p2[j] = p1[j]; p1[j] = p0; }
                *(u32x4*)(M3 + (size_t)(m0 + tb + i) * 1536 + 512 + c8) = pack8(o);
            }
        }
    }
    for (int idx = gt; idx < (MTOK / 32) * 64; idx += NGT) {
        const int run = idx >> 6, c8 = (idx & 63) * 8, m0 = run * 32, t0 = m0 & (SEQ - 1);
        const int win = 2 << (c8 >> 7);
        float sw[8];
#pragma unroll
        for (int j = 0; j < 8; ++j) sw[j] = 0.f;
        if (t0 > 0) { for (int d = 1; d < win; ++d) { float uu[8]; unpack8(ld16(PPOOL + (size_t)(m0 - d) * 512 + c8), uu);
#pragma unroll
                for (int j = 0; j < 8; ++j) sw[j] += uu[j]; } }
#pragma unroll 1
        for (int tb = 0; tb < 32; tb += 8) {
            u32x4 rn[8], ro[8];
#pragma unroll
            for (int i = 0; i < 8; ++i) { const int m = m0 + tb + i; rn[i] = ld16(PPOOL + (size_t)m * 512 + c8);
                const bool has = (t0 + tb + i - win + 1) >= 0;
                ro[i] = has ? ld16(PPOOL + (size_t)(m - win + 1) * 512 + c8) : (u32x4){0u, 0u, 0u, 0u}; }
#pragma unroll
            for (int i = 0; i < 8; ++i) {
                float un[8], uo[8], o[8]; unpack8(rn[i], un); unpack8(ro[i], uo);
                const int t = t0 + tb + i; const float ic = 1.0f / (float)(t + 1 < win ? t + 1 : win);
#pragma unroll
                for (int j = 0; j < 8; ++j) { const float full = sw[j] + un[j]; o[j] = full * ic - un[j]; sw[j] = full - uo[j]; }
                *(u32x4*)(M3 + (size_t)(m0 + tb + i) * 1536 + c8) = pack8(o);
            }
        }
    }
}

constexpr int TC = 32, NCH = SEQ / TC, SROW = 352;
__device__ __forceinline__ float dpp_sum16(float v) {
    v += __builtin_bit_cast(float, __builtin_amdgcn_mov_dpp(__builtin_bit_cast(int, v), 0xB1, 0xF, 0xF, true));
    v += __builtin_bit_cast(float, __builtin_amdgcn_mov_dpp(__builtin_bit_cast(int, v), 0x4E, 0xF, 0xF, true));
    v += __builtin_bit_cast(float, __builtin_amdgcn_mov_dpp(__builtin_bit_cast(int, v), 0x141, 0xF, 0xF, true));
    v += __builtin_bit_cast(float, __builtin_amdgcn_mov_dpp(__builtin_bit_cast(int, v), 0x140, 0xF, 0xF, true));
    return v;
}
__device__ __forceinline__ void scan_phase(const Params& p, int l, LAS unsigned char* lds, const int wv) {
    const int tid = tid_(wv), lane = tid & 63, wave = __builtin_amdgcn_readfirstlane(tid >> 6);
    const bf16_t* PRW = (const bf16_t*)(KWS + WS_PRW); const bf16_t* LORA = (const bf16_t*)(KWS + WS_LORA);
    bf16_t* YRAW = (bf16_t*)(KWS + WS_YRAW); float* BONUS = (float*)(KWS + WS_BONUS);
    LAS float* inb = (LAS float*)lds;
    LAS float* yb = inb + 2 * TC * SROW;
    for (int item = bid_(); item < 256; item += gridDim.x) {
        const int chain = item >> 1, half = item & 1, b = chain >> 3, head = chain & 7;
        const int pt = tid - 256, t_l = (pt >> 3) & 31, cgi = pt & 7, c0 = cgi * 8, ch = head * 64 + c0;
        const float* mu = (const float*)karg(4) + l * RWC + ch; const float* ckk = (const float*)karg(10) + l * 512 + ch; const float* cka = (const float*)karg(11) + l * 512 + ch; const float* crk = (const float*)karg(12) + l * 512 + ch;
        u32x4 raw[8], rawb[8];
        const bf16_t* prw0 = PRW + ((size_t)b * SEQ + t_l) * RWC + ch; const bf16_t* lor0 = LORA + ((size_t)b * SEQ + t_l) * 1536 + ch;
#define SCAN_LOAD(dst, n_) do { const bf16_t* q_ = prw0 + (size_t)(n_) * TC * RWC; const bf16_t* lq_ = lor0 + (size_t)(n_) * TC * 1536; \
            dst[0] = ld16(q_); dst[1] = ld16(q_ + 512); dst[2] = ld16(q_ + 1024); \
            if ((n_) * TC + t_l > 0) { dst[3] = ld16(q_ - RWC); dst[4] = ld16(q_ - RWC + 512); dst[5] = ld16(q_ - RWC + 1024); } \
            else { dst[3] = (u32x4){0u, 0u, 0u, 0u}; dst[4] = dst[3]; dst[5] = dst[3]; } \
            dst[6] = ld16(lq_); dst[7] = ld16(lq_ + 512); } while (0)
        if (wave >= 4) {
            SCAN_LOAD(raw, 0);
        }
        const int seg = lane & 15, rg = lane >> 4, rr0 = (wave & 3) * 8 + rg * 2;
        f32x2 Sa0 = (f32x2){0.f, 0.f}, Sa1 = Sa0, Sb0 = Sa0, Sb1 = Sa0;
#pragma unroll 1
        for (int n2 = 0; n2 <= NCH + 1; n2 += 2) {
        { const int n = n2;
            if (wave >= 4) {
                if (n >= 2) {
                    const LAS float* ys = yb + (n & 1) * TC * 32 + t_l * 32 + cgi * 4;
                    const f32x4 yv = *(const LAS f32x4*)ys;
                    u32x2 w; w.x = cvt_pk_bf16(yv[0], yv[1]); w.y = cvt_pk_bf16(yv[2], yv[3]);
                    *(u32x2*)(YRAW + (size_t)(b * SEQ + (n - 2) * TC + t_l) * 512 + head * 64 + half * 32 + cgi * 4) = w;
                }
                if (n < NCH) {
                    if (n + 1 < NCH) SCAN_LOAD(rawb, n + 1);
                    const size_t m = (size_t)b * SEQ + n * TC + t_l;
                    float mur[8], muk[8], muv[8], kkc[8], kac[8], rkc[8];
                    ld8f(mu, mur); ld8f(mu + 512, muk); ld8f(mu + 1024, muv); ld8f(ckk, kkc); ld8f(cka, kac); ld8f(crk, rkc);
                    float r[8], k[8], v[8], rp[8], kp[8], vp[8], sl[8], al[8];
                    unpack8(raw[0], r); unpack8(raw[1], k); unpack8(raw[2], v); unpack8(raw[3], rp); unpack8(raw[4], kp); unpack8(raw[5], vp); unpack8(raw[6], sl); unpack8(raw[7], al);
                    float kkr[8], ss = 0.f, bon = 0.f, dec[8], kpr[8];
#pragma unroll
                    for (int j = 0; j < 8; ++j) {
                        r[j] = r[j] + (rp[j] - r[j]) * mur[j]; k[j] = k[j] + (kp[j] - k[j]) * muk[j]; v[j] = v[j] + (vp[j] - v[j]) * muv[j];
                        dec[j] = __expf(-0.6065306597126334f * sl[j]);
                        kkr[j] = k[j] * kkc[j]; ss += kkr[j] * kkr[j];
                        kpr[j] = k[j] * (1.0f + (al[j] - 1.0f) * kac[j]);
                        bon += r[j] * kpr[j] * rkc[j];
                    }
                    ss = dpp_sum8(ss); bon = dpp_sum8(bon);
                    const float inrm = 1.0f / fmaxf(sqrtf(ss), 1e-12f);
                    LAS float* dst = inb + (n & 1) * TC * SROW + t_l * SROW + c0;
                    f32x4 w0, w1;
                    w0 = (f32x4){kkr[0] * inrm, kkr[1] * inrm, kkr[2] * inrm, kkr[3] * inrm}; w1 = (f32x4){kkr[4] * inrm, kkr[5] * inrm, kkr[6] * inrm, kkr[7] * inrm};
                    *(LAS f32x4*)(dst) = w0; *(LAS f32x4*)(dst + 4) = w1;
                    *(LAS f32x4*)(dst + 192) = (f32x4){w0[0] * al[0], w0[1] * al[1], w0[2] * al[2], w0[3] * al[3]}; *(LAS f32x4*)(dst + 196) = (f32x4){w1[0] * al[4], w1[1] * al[5], w1[2] * al[6], w1[3] * al[7]};
                    *(LAS f32x4*)(dst + 64) = (f32x4){dec[0], dec[1], dec[2], dec[3]}; *(LAS f32x4*)(dst + 68) = (f32x4){dec[4], dec[5], dec[6], dec[7]};
                    *(LAS f32x4*)(dst + 128) = (f32x4){kpr[0], kpr[1], kpr[2], kpr[3]}; *(LAS f32x4*)(dst + 132) = (f32x4){kpr[4], kpr[5], kpr[6], kpr[7]};
                    *(LAS f32x4*)(dst + 256) = (f32x4){r[0], r[1], r[2], r[3]}; *(LAS f32x4*)(dst + 260) = (f32x4){r[4], r[5], r[6], r[7]};
                    if ((cgi >> 2) == half) { LAS float* vd = inb + (n & 1) * TC * SROW + t_l * SROW + 320 + (c0 - 32 * half);
                        *(LAS f32x4*)(vd) = (f32x4){v[0], v[1], v[2], v[3]}; *(LAS f32x4*)(vd + 4) = (f32x4){v[4], v[5], v[6], v[7]}; }
                    if (half == 0 && cgi == 0) BONUS[m * 8 + head] = bon;
                }
            } else if (n >= 1 && n <= NCH) {
                const LAS float* src = inb + ((n - 1) & 1) * TC * SROW + seg * 4;
                const LAS float* vsrc = inb + ((n - 1) & 1) * TC * SROW + 320 + rr0;
                LAS float* yd = yb + ((n - 1) & 1) * TC * 32 + rr0;
#define SCAN_RD2(q_, tl_) do { const LAS float* s_ = src + (tl_) * SROW; kkq[q_] = *(const LAS f32x4*)(s_); dcq[q_] = *(const LAS f32x4*)(s_ + 64); kpq[q_] = *(const LAS f32x4*)(s_ + 128); \
                    bvq[q_] = *(const LAS f32x4*)(s_ + 192); rvq[q_] = *(const LAS f32x4*)(s_ + 256); vvq[q_] = *(const LAS f32x2*)(vsrc + (tl_) * SROW); } while (0)
                f32x4 kkq[4], dcq[4], kpq[4], bvq[4], rvq[4]; f32x2 vvq[4];
                SCAN_RD2(0, 0); SCAN_RD2(1, 1);
#pragma unroll 1
                for (int tl4 = 0; tl4 < TC; tl4 += 4) {
                    float yA[4], yB[4];
#pragma unroll
                    for (int u = 0; u < 4; ++u) {
                          { const int tn = tl4 + u + 2 < TC ? tl4 + u + 2 : TC - 1; SCAN_RD2((u + 2) & 3, tn); }
                        const f32x4 kk = kkq[u], dc = dcq[u], kp = kpq[u], bv = bvq[u], rp = rvq[(u + 3) & 3]; const f32x2 vv = vvq[u];
                        const f32x2 kk0 = (f32x2){kk[0], kk[1]}, kk1 = (f32x2){kk[2], kk[3]};
                        const f32x2 kp0 = (f32x2){kp[0], kp[1]}, kp1 = (f32x2){kp[2], kp[3]}, bv0 = (f32x2){bv[0], bv[1]}, bv1 = (f32x2){bv[2], bv[3]};
                        const f32x2 dc0 = (f32x2){dc[0], dc[1]}, dc1 = (f32x2){dc[2], dc[3]};
                        const f32x2 r0 = (f32x2){rp[0], rp[1]}, r1 = (f32x2){rp[2], rp[3]};
                        const f32x2 va = (f32x2){vv.x, vv.x}, vb = (f32x2){vv.y, vv.y};
                        f32x2 da = Sa0 * kk0; da += Sa1 * kk1; f32x2 db = Sb0 * kk0; db += Sb1 * kk1;
                        f32x2 ya = Sa0 * r0; ya += Sa1 * r1; f32x2 yb2 = Sb0 * r0; yb2 += Sb1 * r1;
                        const float saa = dpp_sum16(da.x + da.y), sab = dpp_sum16(db.x + db.y);
                        yA[u] = dpp_sum16(ya.x + ya.y); yB[u] = dpp_sum16(yb2.x + yb2.y);
                        const f32x2 na = (f32x2){-saa, -saa}, nb = (f32x2){-sab, -sab};
                        Sa0 = Sa0 * dc0 + (va * kp0 + na * bv0); Sa1 = Sa1 * dc1 + (va * kp1 + na * bv1);
                        Sb0 = Sb0 * dc0 + (vb * kp0 + nb * bv0); Sb1 = Sb1 * dc1 + (vb * kp1 + nb * bv1);
                    }
                    const float y0 = seg == 0 ? yA[0] : seg == 1 ? yA[1] : seg == 2 ? yA[2] : yA[3];
                    const float y1 = seg == 0 ? yB[0] : seg == 1 ? yB[1] : seg == 2 ? yB[2] : yB[3];
                    if (seg < 4 && tl4 + seg >= 1) *(LAS f32x2*)(yd + (tl4 + seg - 1) * 32) = (f32x2){y0, y1};
                }
                {
                    const f32x4 rl = rvq[(TC - 1) & 3];
                    f32x2 ya = Sa0 * (f32x2){rl[0], rl[1]}; ya += Sa1 * (f32x2){rl[2], rl[3]}; f32x2 yb2 = Sb0 * (f32x2){rl[0], rl[1]}; yb2 += Sb1 * (f32x2){rl[2], rl[3]};
                    const float y0 = dpp_sum16(ya.x + ya.y), y1 = dpp_sum16(yb2.x + yb2.y);
                    if (seg == 0) *(LAS f32x2*)(yd + (TC - 1) * 32) = (f32x2){y0, y1};
                }
#undef SCAN_RD2
            }
            __syncthreads();
        }
        { const int n = n2 + 1;
            if (wave >= 4) {
                if (n >= 2) {
                    const LAS float* ys = yb + (n & 1) * TC * 32 + t_l * 32 + cgi * 4;
                    const f32x4 yv = *(const LAS f32x4*)ys;
                    u32x2 w; w.x = cvt_pk_bf16(yv[0], yv[1]); w.y = cvt_pk_bf16(yv[2], yv[3]);
                    *(u32x2*)(YRAW + (size_t)(b * SEQ + (n - 2) * TC + t_l) * 512 + head * 64 + half * 32 + cgi * 4) = w;
                }
                if (n < NCH) {
                    if (n + 1 < NCH) SCAN_LOAD(raw, n + 1);
                    const size_t m = (size_t)b * SEQ + n * TC + t_l;
                    float mur[8], muk[8], muv[8], kkc[8], kac[8], rkc[8];
                    ld8f(mu, mur); ld8f(mu + 512, muk); ld8f(mu + 1024, muv); ld8f(ckk, kkc); ld8f(cka, kac); ld8f(crk, rkc);
                    float r[8], k[8], v[8], rp[8], kp[8], vp[8], sl[8], al[8];
                    unpack8(rawb[0], r); unpack8(rawb[1], k); unpack8(rawb[2], v); unpack8(rawb[3], rp); unpack8(rawb[4], kp); unpack8(rawb[5], vp); unpack8(rawb[6], sl); unpack8(rawb[7], al);
                    float kkr[8], ss = 0.f, bon = 0.f, dec[8], kpr[8];
#pragma unroll
                    for (int j = 0; j < 8; ++j) {
                        r[j] = r[j] + (rp[j] - r[j]) * mur[j]; k[j] = k[j] + (kp[j] - k[j]) * muk[j]; v[j] = v[j] + (vp[j] - v[j]) * muv[j];
                        dec[j] = __expf(-0.6065306597126334f * sl[j]);
                        kkr[j] = k[j] * kkc[j]; ss += kkr[j] * kkr[j];
                        kpr[j] = k[j] * (1.0f + (al[j] - 1.0f) * kac[j]);
                        bon += r[j] * kpr[j] * rkc[j];
                    }
                    ss = dpp_sum8(ss); bon = dpp_sum8(bon);
                    const float inrm = 1.0f / fmaxf(sqrtf(ss), 1e-12f);
                    LAS float* dst = inb + (n & 1) * TC * SROW + t_l * SROW + c0;
                    f32x4 w0, w1;
                    w0 = (f32x4){kkr[0] * inrm, kkr[1] * inrm, kkr[2] * inrm, kkr[3] * inrm}; w1 = (f32x4){kkr[4] * inrm, kkr[5] * inrm, kkr[6] * inrm, kkr[7] * inrm};
                    *(LAS f32x4*)(dst) = w0; *(LAS f32x4*)(dst + 4) = w1;
                    *(LAS f32x4*)(dst + 192) = (f32x4){w0[0] * al[0], w0[1] * al[1], w0[2] * al[2], w0[3] * al[3]}; *(LAS f32x4*)(dst + 196) = (f32x4){w1[0] * al[4], w1[1] * al[5], w1[2] * al[6], w1[3] * al[7]};
                    *(LAS f32x4*)(dst + 64) = (f32x4){dec[0], dec[1], dec[2], dec[3]}; *(LAS f32x4*)(dst + 68) = (f32x4){dec[4], dec[5], dec[6], dec[7]};
                    *(LAS f32x4*)(dst + 128) = (f32x4){kpr[0], kpr[1], kpr[2], kpr[3]}; *(LAS f32x4*)(dst + 132) = (f32x4){kpr[4], kpr[5], kpr[6], kpr[7]};
                    *(LAS f32x4*)(dst + 256) = (f32x4){r[0], r[1], r[2], r[3]}; *(LAS f32x4*)(dst + 260) = (f32x4){r[4], r[5], r[6], r[7]};
                    if ((cgi >> 2) == half) { LAS float* vd = inb + (n & 1) * TC * SROW + t_l * SROW + 320 + (c0 - 32 * half);
                        *(LAS f32x4*)(vd) = (f32x4){v[0], v[1], v[2], v[3]}; *(LAS f32x4*)(vd + 4) = (f32x4){v[4], v[5], v[6], v[7]}; }
                    if (half == 0 && cgi == 0) BONUS[m * 8 + head] = bon;
                }
            } else if (n >= 1 && n <= NCH) {
                const LAS float* src = inb + ((n - 1) & 1) * TC * SROW + seg * 4;
                const LAS float* vsrc = inb + ((n - 1) & 1) * TC * SROW + 320 + rr0;
                LAS float* yd = yb + ((n - 1) & 1) * TC * 32 + rr0;
#define SCAN_RD2(q_, tl_) do { const LAS float* s_ = src + (tl_) * SROW; kkq[q_] = *(const LAS f32x4*)(s_); dcq[q_] = *(const LAS f32x4*)(s_ + 64); kpq[q_] = *(const LAS f32x4*)(s_ + 128); \
                    bvq[q_] = *(const LAS f32x4*)(s_ + 192); rvq[q_] = *(const LAS f32x4*)(s_ + 256); vvq[q_] = *(const LAS f32x2*)(vsrc + (tl_) * SROW); } while (0)
                f32x4 kkq[4], dcq[4], kpq[4], bvq[4], rvq[4]; f32x2 vvq[4];
                SCAN_RD2(0, 0); SCAN_RD2(1, 1);
#pragma unroll 1
                for (int tl4 = 0; tl4 < TC; tl4 += 4) {
                    float yA[4], yB[4];
#pragma unroll
                    for (int u = 0; u < 4; ++u) {
                          { const int tn = tl4 + u + 2 < TC ? tl4 + u + 2 : TC - 1; SCAN_RD2((u + 2) & 3, tn); }
                        const f32x4 kk = kkq[u], dc = dcq[u], kp = kpq[u], bv = bvq[u], rp = rvq[(u + 3) & 3]; const f32x2 vv = vvq[u];
                        const f32x2 kk0 = (f32x2){kk[0], kk[1]}, kk1 = (f32x2){kk[2], kk[3]};
                        const f32x2 kp0 = (f32x2){kp[0], kp[1]}, kp1 = (f32x2){kp[2], kp[3]}, bv0 = (f32x2){bv[0], bv[1]}, bv1 = (f32x2){bv[2], bv[3]};
                        const f32x2 dc0 = (f32x2){dc[0], dc[1]}, dc1 = (f32x2){dc[2], dc[3]};
                        const f32x2 r0 = (f32x2){rp[0], rp[1]}, r1 = (f32x2){rp[2], rp[3]};
                        const f32x2 va = (f32x2){vv.x, vv.x}, vb = (f32x2){vv.y, vv.y};
                        f32x2 da = Sa0 * kk0; da += Sa1 * kk1; f32x2 db = Sb0 * kk0; db += Sb1 * kk1;
                        f32x2 ya = Sa0 * r0; ya += Sa1 * r1; f32x2 yb2 = Sb0 * r0; yb2 += Sb1 * r1;
                        const float saa = dpp_sum16(da.x + da.y), sab = dpp_sum16(db.x + db.y);
                        yA[u] = dpp_sum16(ya.x + ya.y); yB[u] = dpp_sum16(yb2.x + yb2.y);
                        const f32x2 na = (f32x2){-saa, -saa}, nb = (f32x2){-sab, -sab};
                        Sa0 = Sa0 * dc0 + (va * kp0 + na * bv0); Sa1 = Sa1 * dc1 + (va * kp1 + na * bv1);
                        Sb0 = Sb0 * dc0 + (vb * kp0 + nb * bv0); Sb1 = Sb1 * dc1 + (vb * kp1 + nb * bv1);
                    }
                    const float y0 = seg == 0 ? yA[0] : seg == 1 ? yA[1] : seg == 2 ? yA[2] : yA[3];
                    const float y1 = seg == 0 ? yB[0] : seg == 1 ? yB[1] : seg == 2 ? yB[2] : yB[3];
                    if (seg < 4 && tl4 + seg >= 1) *(LAS f32x2*)(yd + (tl4 + seg - 1) * 32) = (f32x2){y0, y1};
                }
                {
                    const f32x4 rl = rvq[(TC - 1) & 3];
                    f32x2 ya = Sa0 * (f32x2){rl[0], rl[1]}; ya += Sa1 * (f32x2){rl[2], rl[3]}; f32x2 yb2 = Sb0 * (f32x2){rl[0], rl[1]}; yb2 += Sb1 * (f32x2){rl[2], rl[3]};
                    const float y0 = dpp_sum16(ya.x + ya.y), y1 = dpp_sum16(yb2.x + yb2.y);
                    if (seg == 0) *(LAS f32x2*)(yd + (TC - 1) * 32) = (f32x2){y0, y1};
                }
#undef SCAN_RD2
            }
            __syncthreads();
        }
        }
#undef SCAN_LOAD
    }
}

__device__ __forceinline__ void post_phase(const Params& p, int l, const int wv) {
    const int gt = bid_() * NTHR + tid_(wv), NGT = gridDim.x * NTHR;
    const bf16_t* PRW = (const bf16_t*)(KWS + WS_PRW); const bf16_t* LORA = (const bf16_t*)(KWS + WS_LORA); const bf16_t* YRAW = (const bf16_t*)(KWS + WS_YRAW);
    const float* BONUS = (const float*)(KWS + WS_BONUS); bf16_t* MA = (bf16_t*)(KWS + WS_MA);
    const float* muv = (const float*)karg(4) + l * RWC + 1024; const float* lg = (const float*)karg(13) + l * 512; const float* lb = (const float*)karg(14) + l * 512;
    for (int idx = gt; idx < MTOK * 64; idx += NGT) {
        const int m = idx >> 6, c = (idx & 63) * 8, head = c >> 6, t = m & (SEQ - 1);
        float y[8], cur[8], prv[8], mm[8], g[8], gg[8], bb[8], o[8];
        unpack8(ld16(YRAW + (size_t)m * 512 + c), y);
        float s = 0.f;
#pragma unroll
        for (int j = 0; j < 8; ++j) s += y[j];
        const float mean = dpp_sum8(s) * (1.0f / 64.0f);
        float q = 0.f;
#pragma unroll
        for (int j = 0; j < 8; ++j) { y[j] -= mean; q += y[j] * y[j]; }
        const float rstd = 1.0f / sqrtf(dpp_sum8(q) * (1.0f / 64.0f) + 64e-5f);
        unpack8(ld16(PRW + (size_t)m * RWC + 1024 + c), cur);
        if (t > 0) unpack8(ld16(PRW + (size_t)(m - 1) * RWC + 1024 + c), prv); else { _Pragma("unroll") for (int j = 0; j < 8; ++j) prv[j] = 0.f; }
        ld8f(muv + c, mm); ld8f(lg + c, gg); ld8f(lb + c, bb);
        unpack8(ld16(LORA + (size_t)m * 1536 + 1024 + c), g);
        const float bon = BONUS[(size_t)m * 8 + head];
#pragma unroll
        for (int j = 0; j < 8; ++j) { const float vs = cur[j] + (prv[j] - cur[j]) * mm[j]; o[j] = (y[j] * rstd * gg[j] + bb[j] + bon * vs) * g[j]; }
        *(u32x4*)(MA + (size_t)m * 512 + c) = pack8(o);
    }
}


#define XB_TMO      128
#define XB_XCNT(j)  (256  + 64 * (j))
#define XB_XSUB(j)  (1280 + 64 * (j))
#define XB_XGEN(j)  (2304 + 64 * (j))
#define XB_TOP      3328
#define XB_TOPGEN   3392
#define XCD_BAR_WORDS 3456
#define XB_SPIN_CAP (1u << 18)
__device__ __forceinline__ unsigned xb_ld(unsigned* p)              { return __hip_atomic_load(p, __ATOMIC_RELAXED, __HIP_MEMORY_SCOPE_AGENT); }
__device__ __forceinline__ unsigned xb_add(unsigned* p, unsigned v) { return __hip_atomic_fetch_add(p, v, __ATOMIC_RELAXED, __HIP_MEMORY_SCOPE_AGENT); }
__device__ __forceinline__ unsigned xb_xcc_id() { return (unsigned)__builtin_amdgcn_s_getreg((3 << 11) | 20) & 0xFu; }
#define XB_SPIN(cond, bar) do { unsigned _sp = 0; while (cond) { __builtin_amdgcn_s_sleep(1); \
    if ((++_sp & 255u) == 0u) { if (xb_ld(&(bar)[XB_TMO])) break; if (_sp > XB_SPIN_CAP) { atomicAdd(&(bar)[XB_TMO], 1u); break; } } } } while (0)
struct XcdBarrier { unsigned* bar; unsigned x; volatile LAS unsigned* st; };
__device__ __forceinline__ void xcd_barrier_complete(unsigned* bar, unsigned x, unsigned& nloc, unsigned& nx) {
    const unsigned G = gridDim.x * gridDim.y * gridDim.z;
    unsigned sum, cnt, mine, sp = 0u;
    for (;;) {
        sum = 0u; cnt = 0u; mine = 0u;
#pragma unroll
        for (unsigned j = 0; j < 16; ++j) { const unsigned c = xb_ld(&bar[XB_XCNT(j)]); sum += c; cnt += (c > 0u) ? 1u : 0u; mine = (j == x) ? c : mine; }
        if (sum == G) break;
        __builtin_amdgcn_s_sleep(1);
        if ((++sp & 255u) == 0u) { if (xb_ld(&bar[XB_TMO])) break; if (sp > XB_SPIN_CAP) { atomicAdd(&bar[XB_TMO], 1u); break; } }
    }
    nloc = mine > 0u ? mine : 1u; nx = cnt > 0u ? cnt : 1u;
}
__device__ __forceinline__ void xcd_barrier(const XcdBarrier& b, const int wv) {
    asm volatile("s_waitcnt vmcnt(0)" ::: "memory");
    __syncthreads();
    if (tid_(wv) == 0) {
        unsigned* bar = b.bar;
        __builtin_amdgcn_s_waitcnt(0);
        unsigned nloc = b.st[0], nx = b.st[1];
        if (nloc == 0u) { xcd_barrier_complete(bar, b.x, nloc, nx); b.st[0] = nloc; b.st[1] = nx; }
        const unsigned old = xb_add(&bar[XB_XSUB(b.x)], 1u);
        const unsigned gen = old / nloc;
        if (old + 1u == (gen + 1u) * nloc) {
            __builtin_amdgcn_fence(__ATOMIC_RELEASE, "agent");
            asm volatile("s_waitcnt vmcnt(0)" ::: "memory");
            const unsigned og = xb_add(&bar[XB_TOP], 1u);
            const unsigned tg = og / nx;
            if (og + 1u == (tg + 1u) * nx) xb_add(&bar[XB_TOPGEN], 1u);
            else XB_SPIN(xb_ld(&bar[XB_TOPGEN]) == tg, bar);
            __builtin_amdgcn_fence(__ATOMIC_ACQUIRE, "agent");
            xb_add(&bar[XB_XGEN(b.x)], 1u);
            asm volatile("s_waitcnt vmcnt(0)" ::: "memory");
        } else {
            XB_SPIN(xb_ld(&bar[XB_XGEN(b.x)]) == gen, bar);
            __builtin_amdgcn_fence(__ATOMIC_ACQUIRE, "agent");
            asm volatile("s_waitcnt vmcnt(0)" ::: "memory");
        }
    }
    __syncthreads();
}

__global__ void __launch_bounds__(NTHR, 2) hybrid_fwd(Params p) {
    extern __shared__ __attribute__((aligned(16))) unsigned char lds_raw[];
    LAS unsigned char* lds = (LAS unsigned char*)lds_raw;
    cg::grid_group grid = cg::this_grid();
    const int wv = __builtin_amdgcn_readfirstlane((int)threadIdx.x >> 6);
    const int G = gridDim.x;
    const int lo = p.ph_lo, hi = p.ph_hi;
#define RUN(k) (lo <= (k) && (k) < hi)
#ifndef REPEAT_MASK
#define REPEAT_MASK 0
#endif
#define REP(k) _Pragma("unroll 1") for (int rep_ = 0; rep_ < 1 + ((REPEAT_MASK >> (k)) & 1); ++rep_)
#define SYNC(k) do { if (RUN(k) && RUN((k) + 1)) xcd_barrier(xbar, wv); } while (0)
    XcdBarrier xbar; xbar.bar = (unsigned*)(KWS + WS_CTL); xbar.x = xb_xcc_id(); xbar.st = (volatile LAS unsigned*)(lds + LDS_BYTES - 16);
    { const int t0 = tid_(wv); if (t0 < 2) xbar.st[t0] = 0u;
      if (bid_() == 0) for (int i = t0; i < XCD_BAR_WORDS; i += NTHR) xbar.bar[i] = 0u; }
    if (RUN(0)) {
        prologue_phase(p, lds, wv);
        norm_phase((const float*)karg(0), (const float*)karg(2), (bf16_t*)(KWS + WS_H), wv);
    }
    if (RUN(0) && RUN(1)) { grid.sync(); if (tid_(wv) == 0) (void)xb_add(&xbar.bar[XB_XCNT(xbar.x)], 1u); }
#pragma unroll 1
    for (int l = 0; l < NL; ++l) {
        const int pb = 1 + 9 * l;
        const char* wl = (const char*)(KWS + WS_W) + (size_t)l * LW_ELEMS * 2;
        if (RUN(pb + 0)) REP(0) {
            pg::DenseSched S{(const char*)(KWS + WS_H), wl + OW_IN * 2, 2048u, 2048u, 16, 256, 18, G, bid_()};
            pg::EpiIn E{(bf16_t*)(KWS + WS_PRW), (bf16_t*)(KWS + WS_PPOOL), (bf16_t*)(KWS + WS_PCONV), (bf16_t*)(KWS + WS_PATT), l == 0 ? (const float*)nullptr : (const float*)(KWS + WS_SSQ) + 1 * MTOK};
            pg::gemm_phase(lds, S, E, wv);
        }
        SYNC(pb + 0);
        if (RUN(pb + 1)) REP(1) mix1_phase(p, l, lds, wv);
        SYNC(pb + 1);
        if (RUN(pb + 2)) REP(2) {
            pg::DenseSched S{(const char*)(KWS + WS_ALORA), wl + OW_LORA * 2, 512u, 512u, 4, 256, 6, G, bid_()};
            pg::EpiLora E{(bf16_t*)(KWS + WS_LORA), (const float*)karg(6) + l * 512, (const float*)karg(8) + l * 512};
            pg::gemm_phase(lds, S, E, wv);
        }
        SYNC(pb + 2);
        if (RUN(pb + 3)) REP(3) scan_phase(p, l, lds, wv);
        SYNC(pb + 3);
        if (RUN(pb + 4)) REP(4) post_phase(p, l, wv);
        SYNC(pb + 4);
        if (RUN(pb + 5)) REP(5) {
            const int c = bid_();
            pg::BRSched S{(const char*)(KWS + WS_H), wl + OW_IN * 2, (const char*)(KWS + WS_MA), (const char*)(KWS + WS_M3), wl + OW_BR * 2, G, c};
            pg::EpiBR E{(u32x4*)(KWS + WS_GSCR + (size_t)c * 131072), (bf16_t*)(KWS + WS_MIXED), l == 0 ? (const float*)nullptr : (const float*)(KWS + WS_SSQ) + 1 * MTOK};
            pg::gemm_phase(lds, S, E, wv);
        }
        SYNC(pb + 5);
        if (RUN(pb + 6)) {
            pg::DenseSched S{(const char*)(KWS + WS_MIXED), wl + OW_O * 2, 2048u, 2048u, 16, 256, 4, G, bid_()};
            pg::EpiRes E{l == 0 ? (const float*)karg(0) : (const float*)KOUT, KOUT, (bf16_t*)(KWS + WS_H), (const float*)karg(26) + l * DM, (float*)(KWS + WS_SSQ) + (l == 0 ? 0 : 2) * MTOK};
            pg::gemm_phase(lds, S, E, wv);
        }
        SYNC(pb + 6);
        if (RUN(pb + 7)) REP(8) {
            pg::DenseSched S{(const char*)(KWS + WS_H), wl + OW_GU * 2, 2048u, 2048u, 16, 256, 22, G, bid_()};
            pg::EpiGU E{(bf16_t*)(KWS + WS_ACT), (const float*)(KWS + WS_SSQ) + (l == 0 ? 0 : 2) * MTOK};
            pg::gemm_phase(lds, S, E, wv);
        }
        SYNC(pb + 7);
        if (RUN(pb + 8)) {
            pg::DenseSched S{(const char*)(KWS + WS_ACT), wl + OW_D * 2, (unsigned)(DFF * 2), (unsigned)(DFF * 2), 44, 256, 4, G, bid_()};
            pg::EpiRes E{(const float*)KOUT, KOUT, l + 1 < NL ? (bf16_t*)(KWS + WS_H) : (bf16_t*)nullptr, (const float*)karg(2) + (l + 1 < NL ? l + 1 : 0) * DM, (float*)(KWS + WS_SSQ) + 1 * MTOK};
            pg::gemm_phase(lds, S, E, wv);
        }
        SYNC(pb + 8);
    }
#undef RUN
#undef SYNC
}

constexpr int N_PHASES = 1 + 9 * NL;

extern "C" void kernel_launch(void* const* d_in, const int* in_sizes, int n_in, void* d_out, int out_size, void* d_ws, size_t ws_size, hipStream_t stream) {
    static int grid = 0;
    if (grid == 0) {
        if (n_in != 30 || out_size != MTOK * DM || ws_size < WS_END) { fprintf(stderr, "kernel_launch: unexpected shapes (n_in %d out %d ws %zu)\n", n_in, out_size, ws_size); grid = -1; return; }
        int dev = 0, cus = 0, per_cu = 0;
        (void)hipGetDevice(&dev); (void)hipDeviceGetAttribute(&cus, hipDeviceAttributeMultiprocessorCount, dev);
        (void)hipFuncSetAttribute((const void*)hybrid_fwd, hipFuncAttributeMaxDynamicSharedMemorySize, LDS_BYTES);
        (void)hipOccupancyMaxActiveBlocksPerMultiprocessor(&per_cu, (const void*)hybrid_fwd, NTHR, LDS_BYTES);
        if (per_cu < 1) { fprintf(stderr, "kernel_launch: occupancy query says %d blocks/CU\n", per_cu); per_cu = 1; }
        (void)hipGetLastError();
        grid = cus;
    }
    if (grid < 0) return;
    Params p{};
    for (int i = 0; i < 30; ++i) p.in[i] = d_in[i];
    p.out = (float*)d_out; p.ws = (unsigned char*)d_ws;
#ifdef MULTI_LAUNCH
    for (int ph = 0; ph < N_PHASES; ++ph) { p.ph_lo = ph; p.ph_hi = ph + 1; hipLaunchKernelGGL(hybrid_fwd, dim3(grid), dim3(NTHR), LDS_BYTES, stream, p); }
#else
    p.ph_lo = 0; p.ph_hi = N_PHASES;
    void* args[] = {&p};
    hipError_t e = hipLaunchCooperativeKernel((const void*)hybrid_fwd, dim3(grid), dim3(NTHR), args, LDS_BYTES, stream);
    if (e != hipSuccess) fprintf(stderr, "cooperative launch failed: %s (grid %d)\n", hipGetErrorString(e), grid);
#endif
}
```
